# Optimizing an MI355X kernel written in HIP

```python
import jax
import jax.numpy as jnp
from jax import lax
import numpy as np


D_MODEL = 1024
BATCH = 4
SEQ = 4096
DEPTH = 2

HEAD_DIM = 64
GROUP_HEADS = 4
GROUP_WIDTH = GROUP_HEADS * HEAD_DIM
N_GROUPS = 4
D_MIX = N_GROUPS * GROUP_WIDTH
ROPE_THETA = 500000.0
EPS = 1e-6
Q_BLOCK = 128
N_MEM = 256
XA_HEADS = 4
XA_WIDTH = XA_HEADS * HEAD_DIM
HG_CHUNK = 64
DSA_LATENT = 128
IDX_HEADS = 8
IDX_DIM = 32
DSA_TOPK_MAX = 256
CMP_BLOCK = 32
CMP_STRIDE = 16
CMP_HIDDEN = 256
SLC_BLOCK = 64
SLC_TOPN = 16
WINDOW = 512
ML_CHUNK = 64
CONV_WIDTH = 4
D_FF = -(-8 * D_MODEL // (3 * 256)) * 256

HG_SPLITS = (GROUP_WIDTH,) * 4
DSA_SPLITS = (GROUP_WIDTH, DSA_LATENT, IDX_HEADS * IDX_DIM, IDX_DIM, IDX_HEADS)
NSA_SPLITS = (GROUP_WIDTH,) + (HEAD_DIM,) * 6 + (3 * GROUP_HEADS,)
ML_SPLITS = (2 * GROUP_WIDTH, GROUP_WIDTH, GROUP_WIDTH, GROUP_HEADS, GROUP_HEADS)
GROUP_COLS = (sum(HG_SPLITS), sum(DSA_SPLITS), sum(NSA_SPLITS), sum(ML_SPLITS))
IN_COLS = sum(GROUP_COLS)

kernel_name = "hybrid_parallel_heads_decoder"

F32 = jnp.float32


def split_cols(t, sizes):
    return jnp.split(t, [int(s) for s in np.cumsum(sizes)[:-1]], axis=-1)


def split_heads(t, n):
    return t.reshape(t.shape[:-1] + (n, t.shape[-1] // n))


def rms_norm(t, g):
    t32 = t.astype(F32)
    y = t32 * lax.rsqrt(jnp.mean(t32 * t32, axis=-1, keepdims=True) + EPS)
    return (y * g.astype(F32)).astype(t.dtype)


def partial_rope(t, pos):
    d = t.shape[-1]
    rd = d // 4
    half = rd // 2
    inv = ROPE_THETA ** (-jnp.arange(half, dtype=F32) * 2.0 / rd)
    ang = pos.astype(F32)[:, None] * inv[None, :]
    cos = jnp.cos(ang)[:, None, :].astype(t.dtype)
    sin = jnp.sin(ang)[:, None, :].astype(t.dtype)
    x1, x2 = t[..., :half], t[..., half:rd]
    return jnp.concatenate([x1 * cos - x2 * sin, x2 * cos + x1 * sin, t[..., rd:]], axis=-1)


def masked_softmax(s, mask):
    s = jnp.where(mask, s.astype(F32), -jnp.inf)
    m = jnp.max(s, axis=-1, keepdims=True)
    m = jnp.where(jnp.isfinite(m), m, 0.0)
    e = jnp.exp(s - m)
    den = jnp.sum(e, axis=-1, keepdims=True)
    return e / jnp.where(den > 0, den, 1.0)


def gather_rows(table, idx):
    return jax.vmap(lambda tb, ix: tb[ix])(table, idx)


def causal_conv(t, w, b):
    y = lax.conv_general_dilated(t, w[:, None, :].astype(t.dtype), window_strides=(1,),
                                 padding=[(CONV_WIDTH - 1, 0)],
                                 dimension_numbers=('NWC', 'WIO', 'NWC'),
                                 feature_group_count=t.shape[-1])
    return y + b.astype(t.dtype)


def to_chunks(t, c):
    b_, l_, h_ = t.shape[:3]
    t = t.reshape((b_, l_ // c, c, h_) + t.shape[3:])
    return jnp.moveaxis(t, (1, 3), (0, 2))


def from_chunks(t):
    t = jnp.moveaxis(t, (0, 2), (1, 3))
    return t.reshape((t.shape[0], t.shape[1] * t.shape[2], t.shape[3]) + t.shape[4:])


def unblock(o):
    o = jnp.moveaxis(o, 0, 1)
    return o.reshape((o.shape[0], o.shape[1] * o.shape[2]) + o.shape[3:])


def hgrn2_mixer(cols, lb, o_gain):
    b_, l_ = cols.shape[:2]
    q, f, i, g = split_cols(cols, HG_SPLITS)
    q = split_heads(jax.nn.silu(q), GROUP_HEADS).astype(F32) * HEAD_DIM ** -0.5
    forget = lb + (1.0 - lb) * jax.nn.sigmoid(f.astype(F32))
    k = split_heads(1.0 - forget, GROUP_HEADS)
    logf = split_heads(jnp.log(forget), GROUP_HEADS)
    v = split_heads(i, GROUP_HEADS).astype(F32)
    tri = jnp.tril(jnp.ones((HG_CHUNK, HG_CHUNK), bool))[:, :, None]

    def step(state, inp):
        qc, kc, vc, gc = inp
        bcum = jnp.cumsum(gc, axis=2)
        o_inter = jnp.einsum('bhtk,bhkv->bhtv', qc * jnp.exp(bcum), state)
        diff = bcum[:, :, :, None, :] - bcum[:, :, None, :, :]
        decay = jnp.exp(jnp.where(tri, diff, -jnp.inf))
        attn = jnp.einsum('bhtk,bhsk,bhtsk->bhts', qc, kc, decay)
        out = o_inter + jnp.einsum('bhts,bhsv->bhtv', attn, vc)
        b_last = bcum[:, :, -1:, :]
        state = (jnp.exp(b_last[:, :, 0, :])[..., None] * state
                 + jnp.einsum('bhsk,bhsv->bhkv', kc * jnp.exp(b_last - bcum), vc))
        return state, out

    s0 = jnp.zeros((b_, GROUP_HEADS, HEAD_DIM, HEAD_DIM), F32)
    xs = (to_chunks(q, HG_CHUNK), to_chunks(k, HG_CHUNK), to_chunks(v, HG_CHUNK), to_chunks(logf, HG_CHUNK))
    _, o = lax.scan(step, s0, xs)
    o = rms_norm(from_chunks(o), o_gain).astype(cols.dtype)
    o = o * jax.nn.silu(split_heads(g, GROUP_HEADS))
    return o.reshape(b_, l_, GROUP_WIDTH)


def dsa_mixer(cols, pos, kv_gain, w_uk, w_uv, q_gain, k_gain, idxk_gain):
    b_, l_ = cols.shape[:2]
    q, ckv, iq, ik, iw = split_cols(cols, DSA_SPLITS)
    q = partial_rope(rms_norm(split_heads(q, GROUP_HEADS), q_gain), pos)
    ckv = rms_norm(ckv, kv_gain)
    k = partial_rope(rms_norm(ckv @ w_uk, k_gain)[:, :, None, :], pos)[:, :, 0]
    v = ckv @ w_uv
    iq = partial_rope(split_heads(iq, IDX_HEADS), pos)
    ik = partial_rope(rms_norm(ik, idxk_gain)[:, :, None, :], pos)[:, :, 0]
    iw = iw * (IDX_HEADS ** -0.5 * IDX_DIM ** -0.5)
    topk = min(DSA_TOPK_MAX, l_ // 4)
    key_pos = jnp.arange(l_)

    def block(bi):
        t0 = bi * Q_BLOCK
        qpos = t0 + jnp.arange(Q_BLOCK)
        qb = lax.dynamic_slice_in_dim(q, t0, Q_BLOCK, axis=1)
        iqb = lax.dynamic_slice_in_dim(iq, t0, Q_BLOCK, axis=1)
        iwb = lax.dynamic_slice_in_dim(iw, t0, Q_BLOCK, axis=1)
        rel = jax.nn.relu(jnp.einsum('bthd,bsd->bhts', iqb, ik))
        score = jnp.einsum('bhts,bth->bts', rel, iwb).astype(F32)
        causal = key_pos[None, :] <= qpos[:, None]
        score = jnp.where(causal[None], score, -jnp.inf)
        _, idx = lax.top_k(score, topk)
        k_sel = gather_rows(k, idx)
        v_sel = gather_rows(v, idx)
        s = jnp.einsum('bthd,btkd->bhtk', qb, k_sel) * HEAD_DIM ** -0.5
        p = masked_softmax(s, (idx <= qpos[None, :, None])[:, None]).astype(v.dtype)
        return jnp.einsum('bhtk,btkd->bthd', p, v_sel)

    o = unblock(lax.map(block, jnp.arange(l_ // Q_BLOCK)))
    return o.reshape(b_, l_, GROUP_WIDTH)


def nsa_mixer(cols, pos, pos_k, pos_v, k_w1, k_w2, v_w1, v_w2, q_gain, k_gains):
    b_, l_ = cols.shape[:2]
    scale = HEAD_DIM ** -0.5
    q, kc, vc, ks, vs, kw, vw, gates = split_cols(cols, NSA_SPLITS)
    q = rms_norm(split_heads(q, GROUP_HEADS), q_gain)
    q_rot = partial_rope(q, pos)
    gates = jax.nn.sigmoid(gates.reshape(b_, l_, 3, GROUP_HEADS, 1))

    n_cmp = (l_ - CMP_BLOCK) // CMP_STRIDE + 1
    cmp_idx = np.arange(n_cmp)[:, None] * CMP_STRIDE + np.arange(CMP_BLOCK)[None, :]

    def compress(t, pe, w1, w2):
        blk = (t[:, cmp_idx] + pe).reshape(b_, n_cmp, CMP_BLOCK * HEAD_DIM)
        return jax.nn.relu(blk @ w1) @ w2

    k_cmp = rms_norm(compress(kc, pos_k, k_w1, k_w2), k_gains[0])
    v_cmp = compress(vc, pos_v, v_w1, v_w2)
    cmp_vis = cmp_idx[:, -1][None, :] <= np.arange(l_)[:, None]
    p_cmp = masked_softmax(jnp.einsum('bthd,bjd->bhtj', q, k_cmp) * scale, cmp_vis)
    o_cmp = jnp.einsum('bhtj,bjd->bthd', p_cmp.astype(v_cmp.dtype), v_cmp)

    n_slc = l_ // SLC_BLOCK
    n_sel = min(SLC_TOPN, n_slc)
    st_c = np.arange(n_cmp) * CMP_STRIDE
    st_s = np.arange(n_slc) * SLC_BLOCK
    overlap = ((st_c[:, None] < st_s[None, :] + SLC_BLOCK)
               & (st_c[:, None] + CMP_BLOCK > st_s[None, :])).astype(np.float32)
    imp = jnp.einsum('bhtj,jn->btn', p_cmp, overlap)
    cur = np.arange(l_)[:, None] // SLC_BLOCK
    blk_id = np.arange(n_slc)[None, :]
    forced = (blk_id == 0) | (blk_id == cur) | (blk_id == cur - 1)
    imp = jnp.where(forced, jnp.inf, jnp.where(blk_id > cur, -jnp.inf, imp))
    _, sel = lax.top_k(imp, n_sel)

    k_s = partial_rope(rms_norm(ks, k_gains[1])[:, :, None], pos)[:, :, 0]
    k_blocks = k_s.reshape(b_, n_slc, SLC_BLOCK, HEAD_DIM)
    v_blocks = vs.reshape(b_, n_slc, SLC_BLOCK, HEAD_DIM)
    k_w = partial_rope(rms_norm(kw, k_gains[2])[:, :, None], pos)[:, :, 0]
    k_pad = jnp.pad(k_w, ((0, 0), (WINDOW, 0), (0, 0)))
    v_pad = jnp.pad(vw, ((0, 0), (WINDOW, 0), (0, 0)))

    def block(bi):
        t0 = bi * Q_BLOCK
        qpos = t0 + jnp.arange(Q_BLOCK)
        qb = lax.dynamic_slice_in_dim(q_rot, t0, Q_BLOCK, axis=1)
        sb = lax.dynamic_slice_in_dim(sel, t0, Q_BLOCK, axis=1)
        kb = gather_rows(k_blocks, sb)
        vb = gather_rows(v_blocks, sb)
        kpos = sb[..., None] * SLC_BLOCK + jnp.arange(SLC_BLOCK)
        s = jnp.einsum('bthd,btnsd->bhtns', qb, kb) * scale
        valid = (kpos <= qpos[None, :, None, None])[:, None]
        p = masked_softmax(s.reshape(b_, GROUP_HEADS, Q_BLOCK, n_sel * SLC_BLOCK),
                           valid.reshape(b_, 1, Q_BLOCK, n_sel * SLC_BLOCK))
        p = p.reshape(b_, GROUP_HEADS, Q_BLOCK, n_sel, SLC_BLOCK).astype(vb.dtype)
        o_slc = jnp.einsum('bhtns,btnsd->bthd', p, vb)
        kwb = lax.dynamic_slice_in_dim(k_pad, t0, WINDOW + Q_BLOCK, axis=1)
        vwb = lax.dynamic_slice_in_dim(v_pad, t0, WINDOW + Q_BLOCK, axis=1)
        wpos = t0 - WINDOW + jnp.arange(WINDOW + Q_BLOCK)
        dist = qpos[:, None] - wpos[None, :]
        wvalid = (dist >= 0) & (dist < WINDOW) & (wpos[None, :] >= 0)
        sw = jnp.einsum('bthd,bsd->bhts', qb, kwb) * scale
        pw = masked_softmax(sw, wvalid[None, None]).astype(vwb.dtype)
        o_swa = jnp.einsum('bhts,bsd->bthd', pw, vwb)
        return o_slc, o_swa

    o_slc, o_swa = lax.map(block, jnp.arange(l_ // Q_BLOCK))
    o = gates[:, :, 0] * o_cmp + gates[:, :, 1] * unblock(o_slc) + gates[:, :, 2] * unblock(o_swa)
    return o.reshape(b_, l_, GROUP_WIDTH)


def mlstm_mixer(cols, conv_w, conv_b, i_bias, f_bias, o_gain):
    b_, l_ = cols.shape[:2]
    qk, v, og, ig, fg = split_cols(cols, ML_SPLITS)
    qk = jax.nn.silu(causal_conv(qk, conv_w, conv_b))
    q, k = jnp.split(qk, 2, axis=-1)
    q = split_heads(q, GROUP_HEADS).astype(F32)
    k = split_heads(k, GROUP_HEADS).astype(F32) * HEAD_DIM ** -0.5
    v = split_heads(v, GROUP_HEADS).astype(F32)
    log_i = (ig + i_bias).astype(F32)
    log_f = jax.nn.log_sigmoid((fg + f_bias).astype(F32))
    tri = jnp.tril(jnp.ones((ML_CHUNK, ML_CHUNK), bool))

    def step(carry, inp):
        cmat, nvec, m = carry
        qc, kc, vc, li, lf = inp
        bcum = jnp.cumsum(lf, axis=-1)
        log_d = jnp.where(tri, bcum[..., :, None] - bcum[..., None, :] + li[..., None, :], -jnp.inf)
        inter = bcum + m[..., None]
        m_t = jnp.maximum(inter, jnp.max(log_d, axis=-1))
        d_mat = jnp.exp(log_d - m_t[..., None])
        w_inter = jnp.exp(inter - m_t)
        s = jnp.einsum('bhtd,bhsd->bhts', qc, kc) * d_mat
        num = (w_inter[..., None] * jnp.einsum('bhtd,bhdv->bhtv', qc, cmat)
               + jnp.einsum('bhts,bhsv->bhtv', s, vc))
        den = w_inter * jnp.einsum('bhtd,bhd->bht', qc, nvec) + jnp.sum(s, axis=-1)
        h = num / jnp.maximum(jnp.abs(den), jnp.exp(-m_t))[..., None]
        b_last = bcum[..., -1]
        log_w = b_last[..., None] - bcum + li
        m_new = jnp.maximum(b_last + m, jnp.max(log_w, axis=-1))
        w_s = jnp.exp(log_w - m_new[..., None])
        decay = jnp.exp(b_last + m - m_new)
        cmat = decay[..., None, None] * cmat + jnp.einsum('bhs,bhsd,bhsv->bhdv', w_s, kc, vc)
        nvec = decay[..., None] * nvec + jnp.einsum('bhs,bhsd->bhd', w_s, kc)
        return (cmat, nvec, m_new), h

    init = (jnp.zeros((b_, GROUP_HEADS, HEAD_DIM, HEAD_DIM), F32),
            jnp.zeros((b_, GROUP_HEADS, HEAD_DIM), F32),
            jnp.full((b_, GROUP_HEADS), -1e30, F32))
    xs = (to_chunks(q, ML_CHUNK), to_chunks(k, ML_CHUNK), to_chunks(v, ML_CHUNK),
          to_chunks(log_i, ML_CHUNK), to_chunks(log_f, ML_CHUNK))
    _, h = lax.scan(step, init, xs)
    h = rms_norm(from_chunks(h), o_gain).astype(cols.dtype)
    h = h * jax.nn.sigmoid(split_heads(og, GROUP_HEADS))
    return h.reshape(b_, l_, GROUP_WIDTH)


def cross_attention(h, m, wq, wkv, wo, q_gain, k_gain):
    b_, l_ = h.shape[:2]
    q = rms_norm(split_heads(h @ wq, XA_HEADS), q_gain)
    k, v = jnp.split(m @ wkv, 2, axis=-1)
    k = rms_norm(split_heads(k, XA_HEADS), k_gain)
    v = split_heads(v, XA_HEADS)
    s = jnp.einsum('bthd,bmhd->bhtm', q, k) * HEAD_DIM ** -0.5
    p = jax.nn.softmax(s.astype(F32), axis=-1).astype(v.dtype)
    o = jnp.einsum('bhtm,bmhd->bthd', p, v).reshape(b_, l_, XA_WIDTH)
    return o @ wo


def swiglu(h, w13, w2):
    a, b = jnp.split(h @ w13, 2, axis=-1)
    return (jax.nn.silu(a) * b) @ w2


def setup_inputs(seed: int = 0) -> dict:
    key = jax.random.key(seed)
    keys = iter(jax.random.split(key, 48))

    def nrm(shape, scale):
        return jax.random.normal(next(keys), shape, F32) * scale

    def gain(shape):
        return 1.0 + nrm(shape, 0.02)

    L = DEPTH
    return {
        'x': nrm((BATCH, SEQ, D_MODEL), 1.0),
        'mem': nrm((BATCH, N_MEM, D_MODEL), 1.0),
        'lb_param': nrm((L, GROUP_WIDTH), 0.5),
        'norm_mix': gain((L, D_MODEL)),
        'w_in': nrm((L, D_MODEL, IN_COLS), D_MODEL ** -0.5),
        'w_out': nrm((L, D_MIX, D_MODEL), D_MIX ** -0.5),
        'hg_o_gain': gain((L, HEAD_DIM)),
        'dsa_kv_gain': gain((L, DSA_LATENT)),
        'dsa_w_uk': nrm((L, DSA_LATENT, HEAD_DIM), DSA_LATENT ** -0.5),
        'dsa_w_uv': nrm((L, DSA_LATENT, HEAD_DIM), DSA_LATENT ** -0.5),
        'dsa_q_gain': gain((L, HEAD_DIM)),
        'dsa_k_gain': gain((L, HEAD_DIM)),
        'dsa_idxk_gain': gain((L, IDX_DIM)),
        'nsa_pos_k': nrm((L, CMP_BLOCK, HEAD_DIM), 0.1),
        'nsa_pos_v': nrm((L, CMP_BLOCK, HEAD_DIM), 0.1),
        'nsa_k_w1': nrm((L, CMP_BLOCK * HEAD_DIM, CMP_HIDDEN), (CMP_BLOCK * HEAD_DIM) ** -0.5),
        'nsa_k_w2': nrm((L, CMP_HIDDEN, HEAD_DIM), CMP_HIDDEN ** -0.5),
        'nsa_v_w1': nrm((L, CMP_BLOCK * HEAD_DIM, CMP_HIDDEN), (CMP_BLOCK * HEAD_DIM) ** -0.5),
        'nsa_v_w2': nrm((L, CMP_HIDDEN, HEAD_DIM), CMP_HIDDEN ** -0.5),
        'nsa_q_gain': gain((L, HEAD_DIM)),
        'nsa_k_gains': gain((L, 3, HEAD_DIM)),
        'ml_conv_w': nrm((L, CONV_WIDTH, 2 * GROUP_WIDTH), CONV_WIDTH ** -0.5),
        'ml_conv_b': nrm((L, 2 * GROUP_WIDTH), 0.02),
        'ml_i_bias': nrm((L, GROUP_HEADS), 0.1),
        'ml_f_bias': jnp.linspace(3.0, 6.0, GROUP_HEADS, dtype=F32)[None, :] + nrm((L, GROUP_HEADS), 0.1),
        'ml_o_gain': gain((L, HEAD_DIM)),
        'norm_xa': gain((L, D_MODEL)),
        'norm_mem': gain((L, D_MODEL)),
        'xa_wq': nrm((L, D_MODEL, XA_WIDTH), D_MODEL ** -0.5),
        'xa_wkv': nrm((L, D_MODEL, 2 * XA_WIDTH), D_MODEL ** -0.5),
        'xa_wo': nrm((L, XA_WIDTH, D_MODEL), XA_WIDTH ** -0.5),
        'xa_q_gain': gain((L, HEAD_DIM)),
        'xa_k_gain': gain((L, HEAD_DIM)),
        'norm_ffn': gain((L, D_MODEL)),
        'ffn_w13': nrm((L, D_MODEL, 2 * D_FF), D_MODEL ** -0.5),
        'ffn_w2': nrm((L, D_FF, D_MODEL), D_FF ** -0.5),
    }


def reference(x, mem, lb_param, norm_mix, w_in, w_out, hg_o_gain,
              dsa_kv_gain, dsa_w_uk, dsa_w_uv, dsa_q_gain, dsa_k_gain, dsa_idxk_gain,
              nsa_pos_k, nsa_pos_v, nsa_k_w1, nsa_k_w2, nsa_v_w1, nsa_v_w2, nsa_q_gain, nsa_k_gains,
              ml_conv_w, ml_conv_b, ml_i_bias, ml_f_bias, ml_o_gain,
              norm_xa, norm_mem, xa_wq, xa_wkv, xa_wo, xa_q_gain, xa_k_gain,
              norm_ffn, ffn_w13, ffn_w2):
    pos = jnp.arange(x.shape[1])
    lb_all = jnp.cumsum(jax.nn.softmax(lb_param.astype(F32), axis=0), axis=0)
    lb_all = lb_all - lb_all[:1]
    for l in range(DEPTH):
        h = rms_norm(x, norm_mix[l])
        c_hg, c_dsa, c_nsa, c_ml = split_cols(h @ w_in[l], GROUP_COLS)
        mixed = jnp.concatenate([
            hgrn2_mixer(c_hg, lb_all[l], hg_o_gain[l]),
            dsa_mixer(c_dsa, pos, dsa_kv_gain[l], dsa_w_uk[l], dsa_w_uv[l],
                      dsa_q_gain[l], dsa_k_gain[l], dsa_idxk_gain[l]),
            nsa_mixer(c_nsa, pos, nsa_pos_k[l], nsa_pos_v[l], nsa_k_w1[l], nsa_k_w2[l],
                      nsa_v_w1[l], nsa_v_w2[l], nsa_q_gain[l], nsa_k_gains[l]),
            mlstm_mixer(c_ml, ml_conv_w[l], ml_conv_b[l], ml_i_bias[l], ml_f_bias[l], ml_o_gain[l]),
        ], axis=-1)
        x = x + mixed @ w_out[l]
        x = x + cross_attention(rms_norm(x, norm_xa[l]), rms_norm(mem, norm_mem[l]),
                                xa_wq[l], xa_wkv[l], xa_wo[l], xa_q_gain[l], xa_k_gain[l])
        x = x + swiglu(rms_norm(x, norm_ffn[l]), ffn_w13[l], ffn_w2[l])
    return x
```

```cpp
#include <hip/hip_runtime.h>
#include <hip/hip_bf16.h>
#include <hip/hip_cooperative_groups.h>
#include <cstdio>
namespace cg = cooperative_groups;

#define DI __device__ __forceinline__
typedef unsigned short u16;
typedef unsigned long long u64;
typedef __attribute__((ext_vector_type(8))) short bf16x8;
typedef __attribute__((ext_vector_type(4))) short s16x4;
typedef __attribute__((ext_vector_type(16))) float f32x16;
typedef __attribute__((ext_vector_type(2))) float f32x2;
typedef __attribute__((ext_vector_type(4))) unsigned u32x4;
typedef __attribute__((ext_vector_type(2))) __bf16 bf16x2v;

constexpr int T_TOK = 16384, SEQL = 4096, NBATCH = 4, DM = 1024;
constexpr int NC = 3456;
constexpr int C_HGQ = 0, C_HGF = 256, C_HGI = 512, C_HGG = 768;
constexpr int C_DQ = 1024, C_CKV = 1280, C_IQ = 1408;
constexpr int C_NQ = 1664, C_KC = 1920, C_VC = 1984, C_KS = 2048, C_VS = 2112, C_KW = 2176, C_VW = 2240;
constexpr int C_MQ = 2304, C_MK = 2560, C_MV = 2816, C_MOG = 3072;
constexpr int C_IK = 3328, C_IW = 3360, C_GATES = 3368, C_IG = 3380, C_FG = 3384;
constexpr int IN_COLS = 3388, DFF = 2816;

constexpr size_t WO_IN = 0;
constexpr size_t WO_OUT = WO_IN + (size_t)NC * 1024;
constexpr size_t WO_Q = WO_OUT + 1024 * 1024;
constexpr size_t WO_KV = WO_Q + 256 * 1024;
constexpr size_t WO_O = WO_KV + 512 * 1024;
constexpr size_t WO_13 = WO_O + 1024 * 256;
constexpr size_t WO_2 = WO_13 + (size_t)5632 * 1024;
constexpr size_t WO_KW1 = WO_2 + (size_t)1024 * 2816;
constexpr size_t WO_VW1 = WO_KW1 + 256 * 2048;
constexpr size_t W_LAYER = WO_VW1 + 256 * 2048;

constexpr size_t al256(size_t x) { return (x + 255) & ~(size_t)255; }
constexpr size_t OFF_CTR = 0;
constexpr size_t OFF_ROPE64 = 4096;
constexpr size_t OFF_ROPE32 = OFF_ROPE64 + 4096 * 8 * 8;
constexpr size_t OFF_BIAS1 = OFF_ROPE32 + 4096 * 4 * 8;
constexpr size_t OFF_WB = al256(OFF_BIAS1 + 4096);
constexpr size_t OFF_COLS = al256(OFF_WB + 2 * W_LAYER * 2);
constexpr size_t OFF_H = al256(OFF_COLS + (size_t)T_TOK * NC * 2);
constexpr size_t OFF_HGST = al256(OFF_H + (size_t)T_TOK * 1024 * 2);
constexpr size_t OFF_MLST = al256(OFF_HGST + (size_t)1024 * 4096 * 4);
constexpr size_t OFF_HGD = al256(OFF_MLST + (size_t)1024 * 4096 * 4);
constexpr size_t OFF_MLN = al256(OFF_HGD + 1024 * 64 * 4);
constexpr size_t OFF_MLSC = al256(OFF_MLN + 1024 * 64 * 4);
constexpr size_t OFF_DK = al256(OFF_MLSC + 3 * 1024 * 4);
constexpr size_t OFF_DVT = al256(OFF_DK + (size_t)T_TOK * 64 * 2);
constexpr size_t OFF_VST = al256(OFF_DVT + (size_t)T_TOK * 64 * 2);
constexpr size_t OFF_VWT = al256(OFF_VST + (size_t)T_TOK * 64 * 2);
constexpr size_t OFF_KCMP = al256(OFF_VWT + (size_t)T_TOK * 64 * 2);
constexpr size_t OFF_VCMPT = al256(OFF_KCMP + 4 * 256 * 64 * 2);
constexpr size_t OFF_HID = al256(OFF_VCMPT + 4 * 256 * 64 * 2);
constexpr size_t OFF_MEMH = al256(OFF_HID + 1024 * 512 * 2);
constexpr size_t OFF_MEMKV = al256(OFF_MEMH + 2 * 1024 * 1024 * 2);
constexpr size_t OFF_MEMVT = al256(OFF_MEMKV + 2 * 1024 * 512 * 2);
constexpr size_t OFF_END = al256(OFF_MEMVT + 2 * 4 * 256 * 256 * 2);
static_assert(OFF_END <= (size_t)256 * 1024 * 1024, "workspace overflow");
constexpr size_t OFF_XQ = OFF_HGST;
constexpr size_t OFF_XO = OFF_MLST;
constexpr size_t OFF_G = OFF_COLS;

constexpr int SMEM_BYTES = 75776;
constexpr int NPHASE = 28;
#define DBG_SKIP 0
#define DBG_MK0 0
#define DBG_MK1 16

struct Params {
  const float* x; const float* mem; const float* lb_param; const float* norm_mix; const float* w_in; const float* w_out;
  const float* hg_o_gain; const float* dsa_kv_gain; const float* dsa_w_uk; const float* dsa_w_uv; const float* dsa_q_gain;
  const float* dsa_k_gain; const float* dsa_idxk_gain; const float* nsa_pos_k; const float* nsa_pos_v; const float* nsa_k_w1;
  const float* nsa_k_w2; const float* nsa_v_w1; const float* nsa_v_w2; const float* nsa_q_gain; const float* nsa_k_gains;
  const float* ml_conv_w; const float* ml_conv_b; const float* ml_i_bias; const float* ml_f_bias; const float* ml_o_gain;
  const float* norm_xa; const float* norm_mem; const float* xa_wq; const float* xa_wkv; const float* xa_wo; const float* xa_q_gain;
  const float* xa_k_gain; const float* norm_ffn; const float* ffn_w13; const float* ffn_w2;
  float* out; char* ws;
};

DI int otid() { int t = __builtin_amdgcn_workitem_id_x(); asm volatile("" : "+v"(t)); return t; }
DI char* oq(char* x) { asm volatile("" : "+s"(x)); return x; }
#define PWS (oq(p.ws))
DI float bf2f(u16 v) { return __uint_as_float(((unsigned)v) << 16); }
DI unsigned pack2(float a, float b) { f32x2 v = {a, b}; return __builtin_bit_cast(unsigned, __builtin_convertvector(v, bf16x2v)); }
DI u16 f2bf(float a) { return (u16)(pack2(a, 0.f) & 0xffffu); }
DI float sigmoidf_(float x) { return 1.f / (1.f + expf(-x)); }
DI float siluf_(float x) { return x / (1.f + expf(-x)); }
DI int crow(int reg, int h) { return (reg & 3) + 8 * (reg >> 2) + 4 * h; }
DI f32x16 zero16() { f32x16 z; for (int i = 0; i < 16; ++i) z[i] = 0.f; return z; }
#define MFMA_BF(a, b, c) __builtin_amdgcn_mfma_f32_32x32x16_bf16((a), (b), (c), 0, 0, 0)
#define MFMA_F32(a, b, c) __builtin_amdgcn_mfma_f32_32x32x2f32((a), (b), (c), 0, 0, 0)
DI float wave_sum(float v) { for (int o = 32; o; o >>= 1) v += __shfl_xor(v, o); return v; }
DI float wave_max(float v) { for (int o = 32; o; o >>= 1) v = fmaxf(v, __shfl_xor(v, o)); return v; }
DI void load4bf(const u16* p, float (&x)[4]) { uint2 v = *(const uint2*)p; x[0] = __uint_as_float(v.x << 16); x[1] = __uint_as_float(v.x & 0xffff0000u); x[2] = __uint_as_float(v.y << 16); x[3] = __uint_as_float(v.y & 0xffff0000u); }
DI void store4bf(u16* p, const float (&x)[4]) { uint2 v; v.x = pack2(x[0], x[1]); v.y = pack2(x[2], x[3]); *(uint2*)p = v; }

template <int W>
DI void rowop(float (&x)[4], int lg, const float* gain, bool do_norm, bool do_rope, int pos, const float2* ropetab) {
  if (do_norm) {
    float ss = x[0] * x[0] + x[1] * x[1] + x[2] * x[2] + x[3] * x[3];
#pragma unroll
    for (int o = W / 8; o >= 1; o >>= 1) ss += __shfl_xor(ss, o);
    float rstd = rsqrtf(ss * (1.f / W) + 1e-6f);
#pragma unroll
    for (int i = 0; i < 4; ++i) x[i] = x[i] * rstd * gain[lg * 4 + i];
  }
  if (do_rope) {
    constexpr int HALF = W / 8, LPH = HALF / 4;
    float xp[4];
#pragma unroll
    for (int i = 0; i < 4; ++i) xp[i] = __shfl_xor(x[i], LPH);
    if (lg < 2 * LPH) {
      bool isx2 = lg >= LPH;
#pragma unroll
      for (int i = 0; i < 4; ++i) {
        int f = (lg % LPH) * 4 + i;
        float2 cs = ropetab[pos * HALF + f];
        x[i] = isx2 ? (x[i] * cs.x + xp[i] * cs.y) : (x[i] * cs.x - xp[i] * cs.y);
      }
    }
  }
}

DI int map_in(int n) {
  if (n < 1664) return n;
  if (n < 2304) return n + 40;
  if (n < 3328) return n + 52;
  if (n < 3360) return 1664 + (n - 3328);
  if (n < 3368) return 1696 + (n - 3360);
  if (n < 3380) return 2344 + (n - 3368);
  if (n < 3388) return n;
  return -1;
}
DI int map_w13(int n) { int blk = n >> 6, w = n & 63; return w < 32 ? blk * 32 + w : 2816 + blk * 32 + (w - 32); }

DI void job_convert(const float* src, int K, int Nsrc, u16* dst, int mode, int tile_n, int tile_k, float* sm) {
  const int tid = otid(), tx = tid & 63, ty = tid >> 6;
  int n = tile_n * 64 + tx;
  int sn = mode == 0 ? n : (mode == 1 ? map_in(n) : map_w13(n));
#pragma unroll 4
  for (int i = 0; i < 16; ++i) {
    int kl = ty * 16 + i;
    float v = sn >= 0 ? src[(size_t)(tile_k * 64 + kl) * Nsrc + sn] : 0.f;
    sm[kl * 65 + tx] = v;
  }
  __syncthreads();
  int row = tid >> 2, seg = tid & 3;
  unsigned pk[8];
#pragma unroll
  for (int i = 0; i < 8; ++i) pk[i] = pack2(sm[(seg * 16 + 2 * i) * 65 + row], sm[(seg * 16 + 2 * i + 1) * 65 + row]);
  uint4* d = (uint4*)(dst + (size_t)(tile_n * 64 + row) * K + tile_k * 64 + seg * 16);
  d[0] = make_uint4(pk[0], pk[1], pk[2], pk[3]);
  d[1] = make_uint4(pk[4], pk[5], pk[6], pk[7]);
}

DI void job_rmsnorm(const float* X, const float* gain, u16* H, float* copy_out, int row0) {
  const int tid = otid(), lane = tid & 63, w = tid >> 6;
  for (int i = 0; i < 4; ++i) {
    int row = row0 + w * 4 + i;
    const float4* xr = (const float4*)(X + (size_t)row * 1024);
    float4 v[4];
    float ss = 0.f;
#pragma unroll
    for (int j = 0; j < 4; ++j) { v[j] = xr[lane + 64 * j]; ss += v[j].x * v[j].x + v[j].y * v[j].y + v[j].z * v[j].z + v[j].w * v[j].w; }
    ss = wave_sum(ss);
    float rstd = rsqrtf(ss * (1.f / 1024.f) + 1e-6f);
#pragma unroll
    for (int j = 0; j < 4; ++j) {
      float4 g = ((const float4*)gain)[lane + 64 * j];
      uint2 o; o.x = pack2(v[j].x * rstd * g.x, v[j].y * rstd * g.y); o.y = pack2(v[j].z * rstd * g.z, v[j].w * rstd * g.w);
      *(uint2*)(H + (size_t)row * 1024 + (lane + 64 * j) * 4) = o;
      if (copy_out) ((float4*)(copy_out + (size_t)row * 1024))[lane + 64 * j] = v[j];
    }
  }
}

template <int EPI, int AMODE>
DI void gemm_tile(const u16* __restrict__ A, int lda, const u16* __restrict__ Bt, int K, int tm, int tn, char* smem,
                  void* Cp, int ldc, const float* bias, int coff, int kt0 = 0, int kt1 = -1) {
  u16* As = (u16*)smem;
  u16* Bs = As + 2 * 128 * 72;
  const int tid = otid(), lane = tid & 63, w = tid >> 6;
  const int r = lane & 31, h = lane >> 5, wm = w >> 1, wn = w & 1;
  const int lrow = tid >> 3, lseg = tid & 7;
  const u16* ap[4];
  const u16* bp[4];
#pragma unroll
  for (int i = 0; i < 4; ++i) {
    int row = tm * 128 + lrow + 32 * i;
    if (AMODE == 0) ap[i] = A + (size_t)row * lda + lseg * 8;
    else { int m = row < 1019 ? row : 1019; int b = m / 255, j = m % 255; ap[i] = A + ((size_t)(b * 4096 + 16 * j)) * NC + coff + lseg * 8; }
    bp[i] = Bt + (size_t)(tn * 128 + lrow + 32 * i) * K + lseg * 8;
  }
  const size_t akstep = AMODE == 0 ? 64 : NC;
  f32x16 acc[2][2];
#pragma unroll
  for (int a = 0; a < 2; ++a)
#pragma unroll
    for (int b = 0; b < 2; ++b) acc[a][b] = zero16();
  u32x4 ra[4], rb[4];
#pragma unroll
  for (int i = 0; i < 4; ++i) { ra[i] = *(const u32x4*)(ap[i] + (size_t)kt0 * akstep); rb[i] = *(const u32x4*)(bp[i] + (size_t)kt0 * 64); }
#pragma unroll
  for (int i = 0; i < 4; ++i) {
    *(u32x4*)(As + (lrow + 32 * i) * 72 + lseg * 8) = ra[i];
    *(u32x4*)(Bs + (lrow + 32 * i) * 72 + lseg * 8) = rb[i];
  }
  __syncthreads();
  const int nk = kt1 < 0 ? K / 64 : kt1;
  for (int kt = kt0; kt < nk; ++kt) {
    const int cur = (kt - kt0) & 1;
    if (kt + 1 < nk) {
#pragma unroll
      for (int i = 0; i < 4; ++i) { ra[i] = *(const u32x4*)(ap[i] + (size_t)(kt + 1) * akstep); rb[i] = *(const u32x4*)(bp[i] + (size_t)(kt + 1) * 64); }
    }
    const u16* Ac = As + cur * 128 * 72;
    const u16* Bc = Bs + cur * 128 * 72;
#pragma unroll
    for (int s = 0; s < 4; ++s) {
      bf16x8 af[2], bfr[2];
#pragma unroll
      for (int mt = 0; mt < 2; ++mt) af[mt] = *(const bf16x8*)(Ac + (wm * 64 + mt * 32 + r) * 72 + s * 16 + h * 8);
#pragma unroll
      for (int nt = 0; nt < 2; ++nt) bfr[nt] = *(const bf16x8*)(Bc + (wn * 64 + nt * 32 + r) * 72 + s * 16 + h * 8);
#pragma unroll
      for (int mt = 0; mt < 2; ++mt)
#pragma unroll
        for (int nt = 0; nt < 2; ++nt) acc[mt][nt] = MFMA_BF(af[mt], bfr[nt], acc[mt][nt]);
    }
    if (kt + 1 < nk) {
      u16* An = As + (cur ^ 1) * 128 * 72;
      u16* Bn = Bs + (cur ^ 1) * 128 * 72;
#pragma unroll
      for (int i = 0; i < 4; ++i) {
        *(u32x4*)(An + (lrow + 32 * i) * 72 + lseg * 8) = ra[i];
        *(u32x4*)(Bn + (lrow + 32 * i) * 72 + lseg * 8) = rb[i];
      }
    }
    __syncthreads();
  }
#pragma unroll
  for (int mt = 0; mt < 2; ++mt) {
#pragma unroll
    for (int reg = 0; reg < 16; ++reg) {
      int row = tm * 128 + wm * 64 + mt * 32 + crow(reg, h);
      if (EPI == 0) {
        u16* C = (u16*)Cp;
#pragma unroll
        for (int nt = 0; nt < 2; ++nt) C[(size_t)row * ldc + tn * 128 + wn * 64 + nt * 32 + r] = f2bf(acc[mt][nt][reg]);
      } else if (EPI == 1) {
        float* C = (float*)Cp;
#pragma unroll
        for (int nt = 0; nt < 2; ++nt) { float* q = C + (size_t)row * ldc + tn * 128 + wn * 64 + nt * 32 + r; *q = *q + acc[mt][nt][reg]; }
      } else if (EPI == 2) {
        u16* C = (u16*)Cp;
        float a = acc[mt][0][reg], b = acc[mt][1][reg];
        C[(size_t)row * ldc + (tn * 2 + wn) * 32 + r] = f2bf(siluf_(a) * b);
      } else {
        u16* C = (u16*)Cp;
        if (row < 1020) {
#pragma unroll
          for (int nt = 0; nt < 2; ++nt) {
            int col = tn * 128 + wn * 64 + nt * 32 + r;
            C[(size_t)row * ldc + coff * 0 + col] = f2bf(fmaxf(acc[mt][nt][reg] + bias[col], 0.f));
          }
        }
      }
    }
  }
}

struct AttnAcc { f32x16 o0, o1; float m, l; };
DI void attn_init(AttnAcc& a) { a.o0 = zero16(); a.o1 = zero16(); a.m = -INFINITY; a.l = 0.f; }

template <class SrcF, class PosF>
DI void stage_q(u16* Qs, SrcF src, PosF posf, const float* gain, bool do_norm, bool do_rope, const float2* rope64, float scale) {
  const int tid = otid(), lg = tid & 15;
  for (int it = 0; it < 8; ++it) {
    int row = it * 16 + (tid >> 4);
    int slot = row >> 5, r = row & 31;
    float x[4];
    load4bf(src(slot, r) + lg * 4, x);
    rowop<64>(x, lg, gain, do_norm, do_rope, posf(slot, r), rope64);
#pragma unroll
    for (int i = 0; i < 4; ++i) x[i] *= scale;
    store4bf(Qs + (slot * 32 + r) * 72 + lg * 4, x);
  }
}
DI void load_qfrags(bf16x8 (&qf)[4], const u16* Qs, int slot, int r, int h) {
#pragma unroll
  for (int s = 0; s < 4; ++s) qf[s] = *(const bf16x8*)(Qs + (slot * 32 + r) * 72 + s * 16 + h * 8);
}

constexpr int KV_BUF = 32 * 72 + 64 * 40;

template <class TileF, class MaskF>
DI void attn_run(AttnAcc& a, const bf16x8 (&qf)[4], const u16* Kb, size_t kstride, int kmaxrow, const u16* Vtb, size_t vstride,
                 int ntiles, TileF tile_at, MaskF mask_at, u16* kvs) {
  const int tid = otid(), lane = tid & 63;
  const int r = lane & 31, h = lane >> 5;
  const int krow = tid >> 3, kseg = tid & 7, vrow = tid >> 2, vseg = tid & 3;
  if (ntiles <= 0) return;
  u32x4 rk, rv;
  {
    int kt = tile_at(0);
    int kr = kt * 32 + krow; kr = kr < kmaxrow ? kr : kmaxrow;
    rk = *(const u32x4*)(Kb + (size_t)kr * kstride + kseg * 8);
    rv = *(const u32x4*)(Vtb + (size_t)vrow * vstride + kt * 32 + vseg * 8);
  }
  __syncthreads();
  *(u32x4*)(kvs + krow * 72 + kseg * 8) = rk;
  *(u32x4*)(kvs + 32 * 72 + vrow * 40 + vseg * 8) = rv;
  __syncthreads();
  for (int i = 0; i < ntiles; ++i) {
    const int kt = tile_at(i);
    const int cur = i & 1;
    if (i + 1 < ntiles) {
      int kn = tile_at(i + 1);
      int kr = kn * 32 + krow; kr = kr < kmaxrow ? kr : kmaxrow;
      rk = *(const u32x4*)(Kb + (size_t)kr * kstride + kseg * 8);
      rv = *(const u32x4*)(Vtb + (size_t)vrow * vstride + kn * 32 + vseg * 8);
    }
    const u16* Kc = kvs + cur * KV_BUF;
    const u16* Vc = Kc + 32 * 72;
    f32x16 s = zero16();
#pragma unroll
    for (int ks = 0; ks < 4; ++ks) {
      bf16x8 kf = *(const bf16x8*)(Kc + r * 72 + ks * 16 + h * 8);
      s = MFMA_BF(kf, qf[ks], s);
    }
    unsigned mw = mask_at(kt);
    float mx = -INFINITY;
#pragma unroll
    for (int reg = 0; reg < 16; ++reg) {
      bool bit = (mw >> crow(reg, h)) & 1u;
      s[reg] = bit ? s[reg] : -INFINITY;
      mx = fmaxf(mx, s[reg]);
    }
    mx = fmaxf(mx, __shfl_xor(mx, 32));
    float mnew = fmaxf(a.m, mx);
    float mb = (mnew == -INFINITY) ? 0.f : mnew;
    float alpha = __builtin_amdgcn_exp2f(a.m - mb);
    float psum = 0.f;
#pragma unroll
    for (int reg = 0; reg < 16; ++reg) { float pv = __builtin_amdgcn_exp2f(s[reg] - mb); psum += pv; s[reg] = pv; }
    a.l = a.l * alpha + psum;
    a.m = mnew;
#pragma unroll
    for (int reg = 0; reg < 16; ++reg) { a.o0[reg] *= alpha; a.o1[reg] *= alpha; }
#pragma unroll
    for (int s2 = 0; s2 < 2; ++s2) {
      uint4 pu;
      pu.x = pack2(s[8 * s2 + 0], s[8 * s2 + 1]); pu.y = pack2(s[8 * s2 + 2], s[8 * s2 + 3]);
      pu.z = pack2(s[8 * s2 + 4], s[8 * s2 + 5]); pu.w = pack2(s[8 * s2 + 6], s[8 * s2 + 7]);
      bf16x8 pf = __builtin_bit_cast(bf16x8, pu);
#pragma unroll
      for (int dt = 0; dt < 2; ++dt) {
        uint2 lo = *(const uint2*)(Vc + (dt * 32 + r) * 40 + 16 * s2 + 4 * h);
        uint2 hi = *(const uint2*)(Vc + (dt * 32 + r) * 40 + 16 * s2 + 8 + 4 * h);
        uint4 vu = make_uint4(lo.x, lo.y, hi.x, hi.y);
        bf16x8 vf = __builtin_bit_cast(bf16x8, vu);
        if (dt == 0) a.o0 = MFMA_BF(vf, pf, a.o0); else a.o1 = MFMA_BF(vf, pf, a.o1);
      }
    }
    if (i + 1 < ntiles) {
      u16* Kn = kvs + (cur ^ 1) * KV_BUF;
      *(u32x4*)(Kn + krow * 72 + kseg * 8) = rk;
      *(u32x4*)(Kn + 32 * 72 + vrow * 40 + vseg * 8) = rv;
    }
    __syncthreads();
  }
}

DI unsigned lowmask(int n) { return n <= 0 ? 0u : (n >= 32 ? 0xffffffffu : ((1u << n) - 1u)); }

DI void dsa_scores(f32x16& sc, const u16* kp, int h, const u16* iqrow, const float (&wq)[8]) {
  bf16x8 kf0 = *(const bf16x8*)(kp + h * 8);
  bf16x8 kf1 = *(const bf16x8*)(kp + 16 + h * 8);
  sc = zero16();
#pragma unroll
  for (int hh = 0; hh < 8; ++hh) {
    bf16x8 q0 = *(const bf16x8*)(iqrow + hh * 32 + h * 8);
    bf16x8 q1 = *(const bf16x8*)(iqrow + hh * 32 + 16 + h * 8);
    f32x16 a = zero16();
    a = MFMA_BF(kf0, q0, a);
    a = MFMA_BF(kf1, q1, a);
#pragma unroll
    for (int reg = 0; reg < 16; ++reg) sc[reg] = fmaf(wq[hh], fmaxf(a[reg], 0.f), sc[reg]);
    if (hh & 1) __builtin_amdgcn_sched_barrier(0);
  }
}
DI u64 make_ck(float s, int idx) {
  if (s == 0.f) s = 0.f;
  unsigned u = __float_as_uint(s);
  unsigned ok = (u & 0x80000000u) ? ~u : (u | 0x80000000u);
  return ((u64)ok << 12) | (unsigned)(4095 - idx);
}

DI void job_dsa(const Params& p, int layer, int b, int tt, char* smem) {
  const int tid = otid(), lane = tid & 63, w = tid >> 6, r = lane & 31, h = lane >> 5;
  const int t0 = tt * 32, ntile = tt + 1;
  u16* cols = (u16*)(PWS + OFF_COLS);
  const u16* cb = cols + (size_t)b * SEQL * NC;
  unsigned* hist = (unsigned*)smem;
  u16* Qs = (u16*)smem;
  u16* kvs = (u16*)(smem + 18432);
  unsigned* maskw = (unsigned*)(smem + 37888);
  unsigned* segs = (unsigned*)(smem + 54272);
  u64* prefix = (u64*)(smem + 55296);
  unsigned* need = (unsigned*)(smem + 55552);
  int* flags = (int*)(smem + 55680);
  const float2* rope64 = (const float2*)(PWS + OFF_ROPE64);

  const u16* qrow = cb + (size_t)(t0 + r) * NC;
  u16* iqs = (u16*)(smem + 55808);
  for (int i = 0; i < 4; ++i) {
    int c = tid + 256 * i; int row = c >> 5, seg = c & 31;
    *(u32x4*)(iqs + row * 264 + seg * 8) = *(const u32x4*)(cb + (size_t)(t0 + row) * NC + C_IQ + seg * 8);
  }
  const u16* iqrow = iqs + r * 264;
  float wq[8];
  { float a[4], c[4]; load4bf(qrow + C_IW, a); load4bf(qrow + C_IW + 4, c);
#pragma unroll
    for (int i = 0; i < 4; ++i) { wq[i] = a[i]; wq[4 + i] = c[i]; } }

  if (tid < 32) { prefix[tid] = 0; int nd = t0 + tid + 1; need[tid] = nd < 256 ? nd : 256; }
  if (tid < 8) flags[tid] = 0;
  int shf = 0;
  for (int pass = 0; pass < 6; ++pass) {
    const int bits = pass < 5 ? 8 : 4;
    const int shift = pass < 5 ? 36 - 8 * pass : 0;
    for (int i = tid; i < 32 * 257; i += 256) hist[i] = 0;
    __syncthreads();
    const u64 mypre = prefix[r];
    for (int kt = w; kt < ntile; kt += 4) {
      f32x16 sc;
      dsa_scores(sc, cb + (size_t)(kt * 32 + r) * NC + C_IK, h, iqrow, wq);
#pragma unroll
      for (int reg = 0; reg < 16; ++reg) {
        int sidx = kt * 32 + crow(reg, h);
        u64 ck = make_ck(sc[reg], sidx);
        if (sidx <= t0 + r && (ck >> (shift + bits)) == mypre)
          atomicAdd(&hist[r * 257 + (int)((ck >> shift) & ((1u << bits) - 1u))], 1u);
      }
    }
    __syncthreads();
    {
      int row = tid >> 3, part = tid & 7;
      unsigned sum = 0;
      for (int i = 0; i < 32; ++i) sum += hist[row * 257 + part * 32 + i];
      segs[row * 8 + part] = sum;
    }
    __syncthreads();
    if ((tid & 7) == 0) {
      int row = tid >> 3;
      unsigned nd = need[row], cum = 0;
      int pt = 7;
      for (; pt > 0; --pt) { unsigned c = segs[row * 8 + pt]; if (cum + c >= nd) break; cum += c; }
      int bin = pt * 32 + 31;
      unsigned cnt = 0;
      for (; bin > pt * 32; --bin) { cnt = hist[row * 257 + bin]; if (cum + cnt >= nd) break; cum += cnt; }
      cnt = hist[row * 257 + bin];
      prefix[row] = (prefix[row] << bits) | (u64)bin;
      need[row] = nd - cum;
      if (cnt != nd - cum) atomicOr(&flags[pass], 1);
    }
    __syncthreads();
    shf = shift;
    if (flags[pass] == 0) break;
  }
  {
    const u64 thr = prefix[r] << shf;
    for (int kt = w; kt < ntile; kt += 4) {
      f32x16 sc;
      dsa_scores(sc, cb + (size_t)(kt * 32 + r) * NC + C_IK, h, iqrow, wq);
      unsigned word = 0;
#pragma unroll
      for (int reg = 0; reg < 16; ++reg) {
        int sidx = kt * 32 + crow(reg, h);
        u64 ck = make_ck(sc[reg], sidx);
        if (sidx <= t0 + r && ck >= thr) word |= 1u << crow(reg, h);
      }
      word |= __shfl_xor(word, 32);
      if (h == 0) maskw[kt * 32 + r] = word;
    }
  }
  __syncthreads();
  {
    const int tokbase = b * SEQL + t0;
    auto src = [&](int slot, int rr) { return cols + (size_t)(tokbase + rr) * NC + C_DQ + slot * 64; };
    auto posf = [&](int slot, int rr) { return t0 + rr; };
    stage_q(Qs, src, posf, p.dsa_q_gain + layer * 64, true, true, rope64, 0.125f * 1.44269504f);
  }
  __syncthreads();
  bf16x8 qf[4];
  load_qfrags(qf, Qs, w, r, h);
  AttnAcc acc; attn_init(acc);
  const u16* Kb = (const u16*)(PWS + OFF_DK) + (size_t)b * SEQL * 64;
  const u16* Vtb = (const u16*)(PWS + OFF_DVT) + (size_t)b * 64 * SEQL;
  attn_run(acc, qf, Kb, 64, SEQL - 1, Vtb, SEQL, ntile, [&](int i) { return i; }, [&](int kt) { return maskw[kt * 32 + r]; }, kvs);
  float lt = acc.l + __shfl_xor(acc.l, 32);
  float inv = lt > 0.f ? 1.f / lt : 0.f;
  u16* mixed = (u16*)(PWS + OFF_H);
  u16* orow = mixed + (size_t)(b * SEQL + t0 + r) * 1024 + 256 + w * 64;
#pragma unroll
  for (int g = 0; g < 4; ++g) {
    float x0[4], x1[4];
#pragma unroll
    for (int i = 0; i < 4; ++i) { x0[i] = acc.o0[4 * g + i] * inv; x1[i] = acc.o1[4 * g + i] * inv; }
    store4bf(orow + 8 * g + 4 * h, x0);
    store4bf(orow + 32 + 8 * g + 4 * h, x1);
  }
}

DI void job_nsa(const Params& p, int layer, int b, int tt, char* smem) {
  const int tid = otid(), lane = tid & 63, w = tid >> 6, r = lane & 31, h = lane >> 5;
  const int t0 = tt * 32;
  const int t = t0 + r;
  u16* cols = (u16*)(PWS + OFF_COLS);
  const u16* cb = cols + (size_t)b * SEQL * NC;
  u16* Qs = (u16*)smem;
  u16* kvs = (u16*)(smem + 18432);
  float* stage = (float*)(smem + 37888);
  float* imp = (float*)(smem + 54272);
  unsigned* selm = (unsigned*)(smem + 62464);
  int* tlist = (int*)(smem + 62720);
  int* nlist = (int*)(smem + 63744);
  const float2* rope64 = (const float2*)(PWS + OFF_ROPE64);
  const float qscale = 0.125f * 1.44269504f;
  const int tokbase = b * SEQL + t0;
  auto src = [&](int slot, int rr) { return cols + (size_t)(tokbase + rr) * NC + C_NQ + slot * 64; };
  auto posf = [&](int slot, int rr) { return t0 + rr; };

  stage_q(Qs, src, posf, p.nsa_q_gain + layer * 64, true, false, rope64, qscale);
  __syncthreads();
  bf16x8 qf[4];
  load_qfrags(qf, Qs, w, r, h);
  const u16* Kc_g = (const u16*)(PWS + OFF_KCMP) + (size_t)b * 256 * 64;
  const u16* Vc_g = (const u16*)(PWS + OFF_VCMPT) + (size_t)b * 64 * 256;
  const int jmax = t >= 31 ? ((t - 31) >> 4) : -1;
  const int ntc = ((2 * tt) >> 5) + 1;
  AttnAcc ac; attn_init(ac);
  attn_run(ac, qf, Kc_g, 64, 255, Vc_g, 256, ntc, [&](int i) { return i; }, [&](int kt) { return lowmask(jmax + 1 - kt * 32); }, kvs);
  float lt = ac.l + __shfl_xor(ac.l, 32);
  float inv_c = lt > 0.f ? 1.f / lt : 0.f;
  float mb_c = (ac.m == -INFINITY) ? 0.f : ac.m;
  for (int i = tid; i < 64 * 32; i += 256) imp[i] = 0.f;
  if (tid < 64) selm[tid] = 0;
  for (int kt = 0; kt < ntc; ++kt) {
    __syncthreads();
    { int krow = tid >> 3, kseg = tid & 7; int kr = kt * 32 + krow;
      *(uint4*)(kvs + krow * 72 + kseg * 8) = *(const uint4*)(Kc_g + (size_t)kr * 64 + kseg * 8); }
    __syncthreads();
    f32x16 s = zero16();
#pragma unroll
    for (int ks = 0; ks < 4; ++ks) { bf16x8 kf = *(const bf16x8*)(kvs + r * 72 + ks * 16 + h * 8); s = MFMA_BF(kf, qf[ks], s); }
    unsigned mw = lowmask(jmax + 1 - kt * 32);
#pragma unroll
    for (int reg = 0; reg < 16; ++reg) {
      bool bit = (mw >> crow(reg, h)) & 1u;
      float pv = bit ? __builtin_amdgcn_exp2f(s[reg] - mb_c) * inv_c : 0.f;
      stage[w * 1024 + crow(reg, h) * 32 + r] = pv;
    }
    __syncthreads();
    int tq = tid & 31, ng = tid >> 5, n = kt * 8 + ng;
    float ps[4];
#pragma unroll
    for (int i = 0; i < 4; ++i) { int j = 4 * ng + i; ps[i] = ((stage[j * 32 + tq] + stage[1024 + j * 32 + tq]) + stage[2048 + j * 32 + tq]) + stage[3072 + j * 32 + tq]; }
    imp[n * 32 + tq] += ((ps[0] + ps[1]) + ps[2]) + ps[3];
    __syncthreads();
    if (n + 1 < 64) imp[(n + 1) * 32 + tq] += ps[3];
  }
  __syncthreads();
  {
    int tq = tid & 31, sub = tid >> 5;
    int cur = (t0 + tq) >> 6;
    float v[8];
#pragma unroll
    for (int k = 0; k < 8; ++k) {
      int n = sub * 8 + k;
      bool forced = (n == 0) || (n == cur) || (n == cur - 1);
      float val = forced ? INFINITY : (n > cur ? -INFINITY : imp[n * 32 + tq]);
      v[k] = val;
    }
    __syncthreads();
#pragma unroll
    for (int k = 0; k < 8; ++k) imp[(sub * 8 + k) * 32 + tq] = v[k];
    __syncthreads();
    int rank[8];
#pragma unroll
    for (int k = 0; k < 8; ++k) rank[k] = 0;
    for (int n2 = 0; n2 < 64; ++n2) {
      float v2 = imp[n2 * 32 + tq];
#pragma unroll
      for (int k = 0; k < 8; ++k) { int n = sub * 8 + k; rank[k] += (v2 > v[k] || (v2 == v[k] && n2 < n)) ? 1 : 0; }
    }
    unsigned bits = 0;
#pragma unroll
    for (int k = 0; k < 8; ++k) if (rank[k] < 16) bits |= 1u << ((sub * 8 + k) & 31);
    if (bits) atomicOr(&selm[tq * 2 + (sub >> 2)], bits);
  }
  __syncthreads();
  if (tid == 0) {
    unsigned lo = 0, hi = 0;
    for (int i = 0; i < 32; ++i) { lo |= selm[2 * i]; hi |= selm[2 * i + 1]; }
    int cnt = 0;
    for (int n = 0; n < 64; ++n) {
      bool on = n < 32 ? ((lo >> n) & 1u) : ((hi >> (n - 32)) & 1u);
      if (on) { if (2 * n <= tt) tlist[cnt++] = 2 * n; if (2 * n + 1 <= tt) tlist[cnt++] = 2 * n + 1; }
    }
    nlist[0] = cnt;
  }
  const u16* grow = cb + (size_t)t * NC + C_GATES;
  float g0 = sigmoidf_(bf2f(grow[w])), g1 = sigmoidf_(bf2f(grow[4 + w])), g2 = sigmoidf_(bf2f(grow[8 + w]));
  f32x16 out0, out1;
#pragma unroll
  for (int reg = 0; reg < 16; ++reg) { out0[reg] = g0 * inv_c * ac.o0[reg]; out1[reg] = g0 * inv_c * ac.o1[reg]; }
  __syncthreads();
  stage_q(Qs, src, posf, p.nsa_q_gain + layer * 64, true, true, rope64, qscale);
  __syncthreads();
  load_qfrags(qf, Qs, w, r, h);
  const unsigned mylo = selm[2 * r], myhi = selm[2 * r + 1];
  const int nsl = nlist[0];
  {
    AttnAcc as; attn_init(as);
    const u16* Kb = cb + C_KS;
    const u16* Vtb = (const u16*)(PWS + OFF_VST) + (size_t)b * 64 * SEQL;
    attn_run(as, qf, Kb, NC, SEQL - 1, Vtb, SEQL, nsl, [&](int i) { return tlist[i]; },
             [&](int kt) { int n = kt >> 1; bool sel = n < 32 ? ((mylo >> n) & 1u) : ((myhi >> (n - 32)) & 1u); return sel ? lowmask(t - kt * 32 + 1) : 0u; }, kvs);
    float l2 = as.l + __shfl_xor(as.l, 32);
    float inv = l2 > 0.f ? 1.f / l2 : 0.f;
#pragma unroll
    for (int reg = 0; reg < 16; ++reg) { out0[reg] += g1 * inv * as.o0[reg]; out1[reg] += g1 * inv * as.o1[reg]; }
  }
  {
    AttnAcc aw; attn_init(aw);
    const u16* Kb = cb + C_KW;
    const u16* Vtb = (const u16*)(PWS + OFF_VWT) + (size_t)b * 64 * SEQL;
    const int klo = tt - 16 > 0 ? tt - 16 : 0;
    attn_run(aw, qf, Kb, NC, SEQL - 1, Vtb, SEQL, tt - klo + 1, [&](int i) { return klo + i; },
             [&](int kt) { int lo = t - 511 - kt * 32; unsigned lm = lo <= 0 ? 0xffffffffu : (lo >= 32 ? 0u : (0xffffffffu << lo)); return lowmask(t - kt * 32 + 1) & lm; }, kvs);
    float l2 = aw.l + __shfl_xor(aw.l, 32);
    float inv = l2 > 0.f ? 1.f / l2 : 0.f;
#pragma unroll
    for (int reg = 0; reg < 16; ++reg) { out0[reg] += g2 * inv * aw.o0[reg]; out1[reg] += g2 * inv * aw.o1[reg]; }
  }
  u16* mixed = (u16*)(PWS + OFF_H);
  u16* orow = mixed + (size_t)(b * SEQL + t) * 1024 + 512 + w * 64;
#pragma unroll
  for (int g = 0; g < 4; ++g) {
    float x0[4], x1[4];
#pragma unroll
    for (int i = 0; i < 4; ++i) { x0[i] = out0[4 * g + i]; x1[i] = out1[4 * g + i]; }
    store4bf(orow + 8 * g + 4 * h, x0);
    store4bf(orow + 32 + 8 * g + 4 * h, x1);
  }
}

DI void job_xattn(const Params& p, int layer, int b, int hd, int tq, char* smem) {
  const int tid = otid(), lane = tid & 63, w = tid >> 6, r = lane & 31, h = lane >> 5;
  u16* Qs = (u16*)smem;
  u16* kvs = (u16*)(smem + 18432);
  const u16* xq = (const u16*)(PWS + OFF_XQ);
  const int tokbase = b * SEQL + tq * 128;
  auto src = [&](int slot, int rr) { return xq + (size_t)(tokbase + slot * 32 + rr) * 256 + hd * 64; };
  auto posf = [&](int slot, int rr) { return 0; };
  stage_q(Qs, src, posf, p.xa_q_gain + layer * 64, true, false, (const float2*)nullptr, 0.125f * 1.44269504f);
  __syncthreads();
  bf16x8 qf[4];
  load_qfrags(qf, Qs, w, r, h);
  const u16* Kb = (const u16*)(PWS + OFF_MEMKV) + ((size_t)(layer * 4 + b) * 256) * 512 + hd * 64;
  const u16* Vtb = (const u16*)(PWS + OFF_MEMVT) + ((size_t)(layer * 4 + b) * 256 + hd * 64) * 256;
  AttnAcc a; attn_init(a);
  attn_run(a, qf, Kb, 512, 255, Vtb, 256, 8, [&](int i) { return i; }, [&](int kt) { return 0xffffffffu; }, kvs);
  float lt = a.l + __shfl_xor(a.l, 32);
  float inv = 1.f / lt;
  u16* xo = (u16*)(PWS + OFF_XO);
  u16* orow = xo + (size_t)(tokbase + w * 32 + r) * 256 + hd * 64;
#pragma unroll
  for (int g = 0; g < 4; ++g) {
    float x0[4], x1[4];
#pragma unroll
    for (int i = 0; i < 4; ++i) { x0[i] = a.o0[4 * g + i] * inv; x1[i] = a.o1[4 * g + i] * inv; }
    store4bf(orow + 8 * g + 4 * h, x0);
    store4bf(orow + 32 + 8 * g + 4 * h, x1);
  }
}

DI void job_prep(const Params& p, int layer, int job, char* smem) {
  const int tid = otid();
  const int tok0 = job * 32;
  const int b = tok0 >> 12, pos0 = tok0 & 4095;
  u16* cols = (u16*)(PWS + OFF_COLS);
  const float2* rope64 = (const float2*)(PWS + OFF_ROPE64);
  const float2* rope32 = (const float2*)(PWS + OFF_ROPE32);
  float* ckvn = (float*)smem;
  float* kpre = ckvn + 32 * 128;
  float* vbuf = kpre + 32 * 64;
  for (int it = 0; it < 4; ++it) {
    int row = it * 16 + (tid >> 4), lg = tid & 15;
    int tk = row >> 1, which = row & 1;
    u16* ptr = cols + (size_t)(tok0 + tk) * NC + (which ? C_KW : C_KS) + lg * 4;
    float x[4]; load4bf(ptr, x);
    rowop<64>(x, lg, p.nsa_k_gains + layer * 192 + (which ? 128 : 64), true, true, pos0 + tk, rope64);
    store4bf(ptr, x);
  }
  for (int it = 0; it < 8; ++it) {
    int row = it * 32 + (tid >> 3), lg = tid & 7;
    int tk = row >> 3, hh = row & 7;
    u16* ptr = cols + (size_t)(tok0 + tk) * NC + C_IQ + hh * 32 + lg * 4;
    float x[4]; load4bf(ptr, x);
    rowop<32>(x, lg, nullptr, false, true, pos0 + tk, rope32);
    store4bf(ptr, x);
  }
  {
    int tk = tid >> 3, lg = tid & 7;
    u16* ptr = cols + (size_t)(tok0 + tk) * NC + C_IK + lg * 4;
    float x[4]; load4bf(ptr, x);
    rowop<32>(x, lg, p.dsa_idxk_gain + layer * 32, true, true, pos0 + tk, rope32);
    store4bf(ptr, x);
  }
  for (int it = 0; it < 4; ++it) {
    int tk = it * 8 + (tid >> 5), lg = tid & 31;
    float x[4]; load4bf(cols + (size_t)(tok0 + tk) * NC + C_CKV + lg * 4, x);
    rowop<128>(x, lg, p.dsa_kv_gain + layer * 128, true, false, 0, rope64);
#pragma unroll
    for (int i = 0; i < 4; ++i) ckvn[tk * 128 + lg * 4 + i] = x[i];
  }
  __syncthreads();
  {
    int o = tid & 127, half = tid >> 7;
    const float* wsrc = o < 64 ? (p.dsa_w_uk + (size_t)layer * 128 * 64 + o) : (p.dsa_w_uv + (size_t)layer * 128 * 64 + (o - 64));
    float acc[16];
#pragma unroll
    for (int j = 0; j < 16; ++j) acc[j] = 0.f;
    for (int c = 0; c < 128; c += 4) {
      float w0 = wsrc[(c + 0) * 64], w1 = wsrc[(c + 1) * 64], w2 = wsrc[(c + 2) * 64], w3 = wsrc[(c + 3) * 64];
#pragma unroll
      for (int j = 0; j < 16; ++j) {
        float4 cv = *(const float4*)(ckvn + (half * 16 + j) * 128 + c);
        acc[j] = fmaf(cv.x, w0, acc[j]); acc[j] = fmaf(cv.y, w1, acc[j]); acc[j] = fmaf(cv.z, w2, acc[j]); acc[j] = fmaf(cv.w, w3, acc[j]);
      }
    }
#pragma unroll
    for (int j = 0; j < 16; ++j) {
      if (o < 64) kpre[(half * 16 + j) * 64 + o] = acc[j];
      else vbuf[(half * 16 + j) * 65 + (o - 64)] = acc[j];
    }
  }
  __syncthreads();
  u16* DK = (u16*)(PWS + OFF_DK);
  for (int it = 0; it < 2; ++it) {
    int tk = it * 16 + (tid >> 4), lg = tid & 15;
    float x[4];
#pragma unroll
    for (int i = 0; i < 4; ++i) x[i] = kpre[tk * 64 + lg * 4 + i];
    rowop<64>(x, lg, p.dsa_k_gain + layer * 64, true, true, pos0 + tk, rope64);
    store4bf(DK + (size_t)(tok0 + tk) * 64 + lg * 4, x);
  }
  for (int which = 0; which < 3; ++which) {
    if (which > 0) {
      __syncthreads();
      for (int i = 0; i < 8; ++i) { int e = tid + 256 * i; int tk = e >> 6, d = e & 63; vbuf[tk * 65 + d] = bf2f(cols[(size_t)(tok0 + tk) * NC + (which == 1 ? C_VS : C_VW) + d]); }
      __syncthreads();
    }
    u16* dst = (u16*)(PWS + (which == 0 ? OFF_DVT : (which == 1 ? OFF_VST : OFF_VWT)));
    int d = tid & 63, q = tid >> 6;
    uint4 o;
    o.x = pack2(vbuf[(q * 8 + 0) * 65 + d], vbuf[(q * 8 + 1) * 65 + d]);
    o.y = pack2(vbuf[(q * 8 + 2) * 65 + d], vbuf[(q * 8 + 3) * 65 + d]);
    o.z = pack2(vbuf[(q * 8 + 4) * 65 + d], vbuf[(q * 8 + 5) * 65 + d]);
    o.w = pack2(vbuf[(q * 8 + 6) * 65 + d], vbuf[(q * 8 + 7) * 65 + d]);
    *(uint4*)(dst + ((size_t)(b * 64 + d)) * SEQL + pos0 + q * 8) = o;
  }
}

DI void job_memkv_post(const Params& p, int job, char* smem) {
  const int tid = otid();
  const int l = job >> 5, row0 = (job & 31) * 32;
  u16* kv = (u16*)(PWS + OFF_MEMKV) + (size_t)l * 1024 * 512;
  u16* vt = (u16*)(PWS + OFF_MEMVT) + (size_t)l * 4 * 256 * 256;
  float* vbuf = (float*)smem;
  for (int it = 0; it < 8; ++it) {
    int row = it * 16 + (tid >> 4), lg = tid & 15;
    int rr = row >> 2, hd = row & 3;
    u16* ptr = kv + (size_t)(row0 + rr) * 512 + hd * 64 + lg * 4;
    float x[4]; load4bf(ptr, x);
    rowop<64>(x, lg, p.xa_k_gain + l * 64, true, false, 0, (const float2*)nullptr);
    store4bf(ptr, x);
  }
  for (int i = 0; i < 32; ++i) { int e = tid + 256 * i; int rr = e >> 8, c = e & 255; vbuf[rr * 257 + c] = bf2f(kv[(size_t)(row0 + rr) * 512 + 256 + c]); }
  __syncthreads();
  {
    int b = row0 >> 8, m0 = row0 & 255;
    int c = tid;
    for (int q = 0; q < 4; ++q) {
      uint4 o;
      o.x = pack2(vbuf[(q * 8 + 0) * 257 + c], vbuf[(q * 8 + 1) * 257 + c]);
      o.y = pack2(vbuf[(q * 8 + 2) * 257 + c], vbuf[(q * 8 + 3) * 257 + c]);
      o.z = pack2(vbuf[(q * 8 + 4) * 257 + c], vbuf[(q * 8 + 5) * 257 + c]);
      o.w = pack2(vbuf[(q * 8 + 6) * 257 + c], vbuf[(q * 8 + 7) * 257 + c]);
      *(uint4*)(vt + ((size_t)(b * 256 + c)) * 256 + m0 + q * 8) = o;
    }
  }
}

DI void job_cmp2(const Params& p, int layer, int job, char* smem) {
  const int tid = otid();
  const int rl = tid >> 4, lg = tid & 15;
  const int gr = job * 16 + rl;
  const int b = gr >> 8, j = gr & 255;
  const u16* hid = (const u16*)(PWS + OFF_HID);
  float* vb = (float*)smem;
  float ak[4] = {0.f, 0.f, 0.f, 0.f}, av[4] = {0.f, 0.f, 0.f, 0.f};
  if (j < 255) {
    const u16* hr = hid + (size_t)(b * 255 + j) * 512;
    const float* w2k = p.nsa_k_w2 + (size_t)layer * 256 * 64 + lg * 4;
    const float* w2v = p.nsa_v_w2 + (size_t)layer * 256 * 64 + lg * 4;
    for (int n = 0; n < 256; ++n) {
      float hk = bf2f(hr[n]), hv = bf2f(hr[256 + n]);
      float4 wk = *(const float4*)(w2k + n * 64), wv = *(const float4*)(w2v + n * 64);
      ak[0] = fmaf(hk, wk.x, ak[0]); ak[1] = fmaf(hk, wk.y, ak[1]); ak[2] = fmaf(hk, wk.z, ak[2]); ak[3] = fmaf(hk, wk.w, ak[3]);
      av[0] = fmaf(hv, wv.x, av[0]); av[1] = fmaf(hv, wv.y, av[1]); av[2] = fmaf(hv, wv.z, av[2]); av[3] = fmaf(hv, wv.w, av[3]);
    }
  }
  rowop<64>(ak, lg, p.nsa_k_gains + layer * 192, true, false, 0, (const float2*)nullptr);
  store4bf((u16*)(PWS + OFF_KCMP) + (size_t)gr * 64 + lg * 4, ak);
#pragma unroll
  for (int i = 0; i < 4; ++i) vb[rl * 65 + lg * 4 + i] = av[i];
  __syncthreads();
  if (tid < 128) {
    int d = tid & 63, q = tid >> 6;
    uint4 o;
    o.x = pack2(vb[(q * 8 + 0) * 65 + d], vb[(q * 8 + 1) * 65 + d]);
    o.y = pack2(vb[(q * 8 + 2) * 65 + d], vb[(q * 8 + 3) * 65 + d]);
    o.z = pack2(vb[(q * 8 + 4) * 65 + d], vb[(q * 8 + 5) * 65 + d]);
    o.w = pack2(vb[(q * 8 + 6) * 65 + d], vb[(q * 8 + 7) * 65 + d]);
    int jb = (job * 16) & 255;
    *(uint4*)((u16*)(PWS + OFF_VCMPT) + ((size_t)(b * 64 + d)) * 256 + jb + q * 8) = o;
  }
}

DI float lb_of(const Params& p, int layer, int c) {
  if (layer == 0) return 0.f;
  float p0 = p.lb_param[c], p1 = p.lb_param[256 + c];
  return 1.f / (1.f + expf(p0 - p1));
}
DI void mm32(f32x16& acc, const float* Ap, int asi, int ask, const float* Bp, int bsk, int bsj, int r, int h) {
#pragma unroll 8
  for (int k = 0; k < 64; k += 2) {
    float a = Ap[r * asi + (k + h) * ask];
    float b = Bp[(k + h) * bsk + r * bsj];
    acc = MFMA_F32(a, b, acc);
  }
}
template <bool SILU_GATE>
DI void finish_rows(const float* ob, const float* gain, const u16* cols, int gate_col, u16* mixed, int mix_col, int tb, int hd) {
  const int tid = otid(), lg = tid & 15;
  for (int it = 0; it < 4; ++it) {
    int t = it * 16 + (tid >> 4);
    float x[4];
#pragma unroll
    for (int i = 0; i < 4; ++i) x[i] = ob[t * 65 + lg * 4 + i];
    rowop<64>(x, lg, gain, true, false, 0, (const float2*)nullptr);
    float g[4]; load4bf(cols + (size_t)(tb + t) * NC + gate_col + hd * 64 + lg * 4, g);
#pragma unroll
    for (int i = 0; i < 4; ++i) x[i] *= SILU_GATE ? siluf_(g[i]) : sigmoidf_(g[i]);
    store4bf(mixed + (size_t)(tb + t) * 1024 + mix_col + hd * 64 + lg * 4, x);
  }
}

DI void job_hg_A(const Params& p, int layer, int cid, char* smem) {
  const int tid = otid(), lane = tid & 63, w = tid >> 6, r = lane & 31, h = lane >> 5;
  const int bh = cid >> 6, c = cid & 63, b = bh >> 2, hd = bh & 3;
  const int tb = b * SEQL + c * 64;
  const u16* cols = (const u16*)(PWS + OFF_COLS);
  float* B0 = (float*)smem; float* B1 = B0 + 64 * 65; float* B2 = B1 + 64 * 65;
  for (int e = tid; e < 4096; e += 256) {
    int s = e >> 6, kd = e & 63;
    const u16* row = cols + (size_t)(tb + s) * NC;
    float f = bf2f(row[C_HGF + hd * 64 + kd]), iv = bf2f(row[C_HGI + hd * 64 + kd]);
    float lbv = lb_of(p, layer, hd * 64 + kd);
    float fg = lbv + (1.f - lbv) * sigmoidf_(f);
    B0[s * 65 + kd] = logf(fg); B1[s * 65 + kd] = 1.f - fg; B2[s * 65 + kd] = iv;
  }
  __syncthreads();
  if (tid < 64) { float run = 0.f; for (int s = 0; s < 64; ++s) { run += B0[s * 65 + tid]; B0[s * 65 + tid] = run; } }
  __syncthreads();
  for (int e = tid; e < 4096; e += 256) { int s = e >> 6, kd = e & 63; B1[s * 65 + kd] *= expf(B0[63 * 65 + kd] - B0[s * 65 + kd]); }
  __syncthreads();
  const int ih = w >> 1, jh = w & 1;
  f32x16 acc = zero16();
  mm32(acc, B1 + ih * 32, 1, 65, B2 + jh * 32, 65, 1, r, h);
  float* st = (float*)(PWS + OFF_HGST) + (size_t)cid * 4096;
#pragma unroll
  for (int reg = 0; reg < 16; ++reg) st[(ih * 32 + crow(reg, h)) * 64 + jh * 32 + r] = acc[reg];
  if (tid < 64) ((float*)(PWS + OFF_HGD))[cid * 64 + tid] = expf(B0[63 * 65 + tid]);
}

DI void job_hg_scan(const Params& p, int job) {
  const int bh = job >> 4, e = (job & 15) * 256 + otid();
  float* st = (float*)(PWS + OFF_HGST);
  const float* dv = (const float*)(PWS + OFF_HGD);
  float S = 0.f;
#pragma unroll 8
  for (int c = 0; c < 64; ++c) {
    size_t idx = (size_t)(bh * 64 + c) * 4096 + e;
    float U = st[idx];
    st[idx] = S;
    S = dv[(bh * 64 + c) * 64 + (e >> 6)] * S + U;
  }
}

DI void job_hg_C(const Params& p, int layer, int cid, char* smem) {
  const int tid = otid(), lane = tid & 63, w = tid >> 6, r = lane & 31, h = lane >> 5;
  const int bh = cid >> 6, c = cid & 63, b = bh >> 2, hd = bh & 3;
  const int tb = b * SEQL + c * 64;
  const u16* cols = (const u16*)(PWS + OFF_COLS);
  float* B0 = (float*)smem; float* B1 = B0 + 64 * 65; float* B2 = B1 + 64 * 65; float* B3 = B2 + 64 * 65;
  for (int e = tid; e < 4096; e += 256) {
    int s = e >> 6, kd = e & 63;
    const u16* row = cols + (size_t)(tb + s) * NC;
    float f = bf2f(row[C_HGF + hd * 64 + kd]), iv = bf2f(row[C_HGI + hd * 64 + kd]), qr = bf2f(row[C_HGQ + hd * 64 + kd]);
    float lbv = lb_of(p, layer, hd * 64 + kd);
    float fg = lbv + (1.f - lbv) * sigmoidf_(f);
    B0[s * 65 + kd] = logf(fg); B2[s * 65 + kd] = 1.f - fg; B1[s * 65 + kd] = siluf_(qr) * 0.125f; B3[s * 65 + kd] = iv;
  }
  __syncthreads();
  if (tid < 64) { float run = 0.f; for (int s = 0; s < 64; ++s) { run += B0[s * 65 + tid]; B0[s * 65 + tid] = run; } }
  __syncthreads();
  for (int e = tid; e < 4096; e += 256) {
    int s = e >> 6, kd = e & 63;
    float bref = B0[31 * 65 + kd], bc = B0[s * 65 + kd];
    B1[s * 65 + kd] *= expf(bc - bref);
    B2[s * 65 + kd] *= expf(bref - bc);
  }
  __syncthreads();
  const int th = w >> 1, sh = w & 1;
  f32x16 at = zero16();
  if (!(th == 0 && sh == 1)) mm32(at, B1 + th * 32 * 65, 65, 1, B2 + sh * 32 * 65, 1, 65, r, h);
  __syncthreads();
  for (int e = tid; e < 4096; e += 256) { int s = e >> 6, kd = e & 63; B2[s * 65 + kd] = B1[s * 65 + kd] * expf(B0[31 * 65 + kd]); }
  __syncthreads();
#pragma unroll
  for (int reg = 0; reg < 16; ++reg) {
    int t = th * 32 + crow(reg, h), s = sh * 32 + r;
    B1[t * 65 + s] = (s <= t) ? at[reg] : 0.f;
  }
  {
    const float* st = (const float*)(PWS + OFF_HGST) + (size_t)cid * 4096;
    for (int e = tid; e < 4096; e += 256) B0[(e >> 6) * 65 + (e & 63)] = st[e];
  }
  __syncthreads();
  const int vh = w & 1;
  f32x16 o = zero16();
  mm32(o, B2 + th * 32 * 65, 65, 1, B0 + vh * 32, 65, 1, r, h);
  mm32(o, B1 + th * 32 * 65, 65, 1, B3 + vh * 32, 65, 1, r, h);
  __syncthreads();
#pragma unroll
  for (int reg = 0; reg < 16; ++reg) B2[(th * 32 + crow(reg, h)) * 65 + vh * 32 + r] = o[reg];
  __syncthreads();
  finish_rows<true>(B2, p.hg_o_gain + layer * 64, cols, C_HGG, (u16*)(PWS + OFF_H), 0, tb, hd);
}

DI float conv_silu(const Params& p, int layer, const u16* cols, int tok, int pos, int ch) {
  const float* cw = p.ml_conv_w + (size_t)layer * 4 * 512;
  float a = p.ml_conv_b[layer * 512 + ch];
#pragma unroll
  for (int j = 0; j < 4; ++j) {
    int dp = j - 3;
    float xv = (pos + dp >= 0) ? bf2f(cols[(size_t)(tok + dp) * NC + C_MQ + ch]) : 0.f;
    a = fmaf(cw[j * 512 + ch], xv, a);
  }
  return siluf_(a);
}
DI float logsigmoidf_(float x) { return fminf(x, 0.f) - log1pf(expf(-fabsf(x))); }
DI float scan_add(float v, int lane) { for (int o = 1; o < 64; o <<= 1) { float u = __shfl_up(v, o); if (lane >= o) v += u; } return v; }
DI float scan_max(float v, int lane) { for (int o = 1; o < 64; o <<= 1) { float u = __shfl_up(v, o); if (lane >= o) v = fmaxf(v, u); } return v; }

DI void job_ml_A(const Params& p, int layer, int cid, char* smem) {
  const int tid = otid(), lane = tid & 63, w = tid >> 6, r = lane & 31, h = lane >> 5;
  const int bh = cid >> 6, c = cid & 63, b = bh >> 2, hd = bh & 3;
  const int tb = b * SEQL + c * 64;
  const u16* cols = (const u16*)(PWS + OFF_COLS);
  float* B1 = (float*)smem; float* B2 = B1 + 64 * 65; float* wsv = B2 + 64 * 65;
  float* mlsc = (float*)(PWS + OFF_MLSC);
  if (w == 0) {
    const u16* row = cols + (size_t)(tb + lane) * NC;
    float fgv = bf2f(row[C_FG + hd]) + p.ml_f_bias[layer * 4 + hd];
    float igv = bf2f(row[C_IG + hd]) + p.ml_i_bias[layer * 4 + hd];
    float lf = logsigmoidf_(fgv);
    float bc = scan_add(lf, lane);
    float blast = __shfl(bc, 63);
    float lw = blast - bc + igv;
    float Mc = wave_max(lw);
    wsv[lane] = expf(lw - Mc);
    if (lane == 0) { mlsc[cid] = Mc; mlsc[1024 + cid] = blast; }
  }
  for (int e = tid; e < 4096; e += 256) {
    int s = e >> 6, d = e & 63;
    B1[s * 65 + d] = conv_silu(p, layer, cols, tb + s, c * 64 + s, 256 + hd * 64 + d) * 0.125f;
    B2[s * 65 + d] = bf2f(cols[(size_t)(tb + s) * NC + C_MV + hd * 64 + d]);
  }
  __syncthreads();
  for (int e = tid; e < 4096; e += 256) { int s = e >> 6, d = e & 63; B1[s * 65 + d] *= wsv[s]; }
  __syncthreads();
  const int ih = w >> 1, jh = w & 1;
  f32x16 acc = zero16();
  mm32(acc, B1 + ih * 32, 1, 65, B2 + jh * 32, 65, 1, r, h);
  float* st = (float*)(PWS + OFF_MLST) + (size_t)cid * 4096;
#pragma unroll
  for (int reg = 0; reg < 16; ++reg) st[(ih * 32 + crow(reg, h)) * 64 + jh * 32 + r] = acc[reg];
  if (tid < 64) { float sacc = 0.f; for (int s = 0; s < 64; ++s) sacc += B1[s * 65 + tid]; ((float*)(PWS + OFF_MLN))[cid * 64 + tid] = sacc; }
}

DI void job_ml_scan(const Params& p, int job) {
  const int bh = job >> 4, sl = job & 15, tid = otid(), e = sl * 256 + tid;
  float* st = (float*)(PWS + OFF_MLST);
  float* nv = (float*)(PWS + OFF_MLN);
  float* mlsc = (float*)(PWS + OFF_MLSC);
  float S = 0.f, nS = 0.f, m = -1e30f;
#pragma unroll 4
  for (int c = 0; c < 64; ++c) {
    int cid = bh * 64 + c;
    float Mc = mlsc[cid], bl = mlsc[1024 + cid];
    float mnew = fmaxf(bl + m, Mc);
    float dec = expf(bl + m - mnew), us = expf(Mc - mnew);
    size_t idx = (size_t)cid * 4096 + e;
    float U = st[idx];
    st[idx] = S;
    S = dec * S + us * U;
    if (sl == 0 && tid < 64) { float nu = nv[cid * 64 + tid]; nv[cid * 64 + tid] = nS; nS = dec * nS + us * nu; }
    if (sl == 0 && tid == 0) mlsc[2048 + cid] = m;
    m = mnew;
  }
}

DI void job_ml_C(const Params& p, int layer, int cid, char* smem) {
  const int tid = otid(), lane = tid & 63, w = tid >> 6, r = lane & 31, h = lane >> 5;
  const int bh = cid >> 6, c = cid & 63, b = bh >> 2, hd = bh & 3;
  const int tb = b * SEQL + c * 64;
  const u16* cols = (const u16*)(PWS + OFF_COLS);
  float* B0 = (float*)smem; float* B1 = B0 + 64 * 65; float* B2 = B1 + 64 * 65; float* B3 = B2 + 64 * 65;
  float* s_bc = B3 + 64 * 65; float* s_as = s_bc + 64; float* s_mt = s_as + 64; float* s_wi = s_mt + 64; float* s_nv = s_wi + 64; float* s_den = s_nv + 64;
  const float* mlsc = (const float*)(PWS + OFF_MLSC);
  if (w == 0) {
    const u16* row = cols + (size_t)(tb + lane) * NC;
    float fgv = bf2f(row[C_FG + hd]) + p.ml_f_bias[layer * 4 + hd];
    float igv = bf2f(row[C_IG + hd]) + p.ml_i_bias[layer * 4 + hd];
    float lf = logsigmoidf_(fgv);
    float bc = scan_add(lf, lane);
    float as = igv - bc;
    float pm = scan_max(as, lane);
    float m = mlsc[2048 + cid];
    float inter = bc + m;
    float mt = fmaxf(inter, bc + pm);
    s_bc[lane] = bc; s_as[lane] = as; s_mt[lane] = mt; s_wi[lane] = expf(inter - mt);
    s_nv[lane] = ((const float*)(PWS + OFF_MLN))[cid * 64 + lane];
  }
  {
    const float* st = (const float*)(PWS + OFF_MLST) + (size_t)cid * 4096;
    for (int e = tid; e < 4096; e += 256) {
      int s = e >> 6, d = e & 63;
      B0[s * 65 + d] = conv_silu(p, layer, cols, tb + s, c * 64 + s, hd * 64 + d);
      B1[s * 65 + d] = conv_silu(p, layer, cols, tb + s, c * 64 + s, 256 + hd * 64 + d) * 0.125f;
      B2[s * 65 + d] = bf2f(cols[(size_t)(tb + s) * NC + C_MV + hd * 64 + d]);
      B3[s * 65 + d] = st[e];
    }
  }
  __syncthreads();
  const int th = w >> 1, sh = w & 1;
  f32x16 qk = zero16();
  if (!(th == 0 && sh == 1)) mm32(qk, B0 + th * 32 * 65, 65, 1, B1 + sh * 32 * 65, 1, 65, r, h);
  __syncthreads();
#pragma unroll
  for (int reg = 0; reg < 16; ++reg) {
    int t = th * 32 + crow(reg, h), s = sh * 32 + r;
    float dm = (s <= t) ? expf(s_bc[t] + s_as[s] - s_mt[t]) : 0.f;
    B1[t * 65 + s] = qk[reg] * dm;
  }
  for (int e = tid; e < 4096; e += 256) { int t = e >> 6, d = e & 63; B0[t * 65 + d] *= s_wi[t]; }
  __syncthreads();
  const int vh = w & 1;
  f32x16 o = zero16();
  mm32(o, B0 + th * 32 * 65, 65, 1, B3 + vh * 32, 65, 1, r, h);
  mm32(o, B1 + th * 32 * 65, 65, 1, B2 + vh * 32, 65, 1, r, h);
  if (tid < 64) {
    float dsum = 0.f;
    for (int d = 0; d < 64; ++d) dsum = fmaf(B0[tid * 65 + d], s_nv[d], dsum);
    float ssum = 0.f;
    for (int s = 0; s < 64; ++s) ssum += B1[tid * 65 + s];
    s_den[tid] = dsum + ssum;
  }
  __syncthreads();
#pragma unroll
  for (int reg = 0; reg < 16; ++reg) {
    int t = th * 32 + crow(reg, h);
    float dn = fmaxf(fabsf(s_den[t]), expf(-s_mt[t]));
    B3[t * 65 + vh * 32 + r] = o[reg] / dn;
  }
  __syncthreads();
  finish_rows<false>(B3, p.ml_o_gain + layer * 64, cols, C_MOG, (u16*)(PWS + OFF_H), 768, tb, hd);
}

DI int next_job(int* ctr, int* s_job) {
  __syncthreads();
  if (otid() == 0) *s_job = atomicAdd(ctr, 1);
  __syncthreads();
  return *s_job;
}

struct ConvDesc { const float* src; int K, Nsrc, Ndst, mode; size_t dst; };

__global__ void __launch_bounds__(256, 2) fwd_megakernel(Params p) {
  cg::grid_group grid = cg::this_grid();
  __shared__ __attribute__((aligned(16))) char smem[SMEM_BYTES];
  int* s_job = (int*)(smem + SMEM_BYTES - 16);
  int* ctr = (int*)(PWS + OFF_CTR);
  u16* WB = (u16*)(PWS + OFF_WB);
  u16* cols = (u16*)(PWS + OFF_COLS);
  u16* Hb = (u16*)(PWS + OFF_H);
  const int tid = otid();

  for (int ph = 0; ph < NPHASE; ++ph) {
    const int layer = ph == 0 ? 0 : (ph - 1) / 14;
    const int kind = ph == 0 ? -1 : (ph - 1) % 14;
    const u16* WL = WB + (size_t)layer * W_LAYER;
    int j;
    if (ph == 0) {
      const int NCONV = 3744 * 2, NMEM = 128, NROPE = 192, NBIAS = 4, NX = 1024;
      const int total = NCONV + NMEM + NROPE + NBIAS + NX;
      while ((j = next_job(&ctr[ph], s_job)) < total) {
        if (j < NCONV) {
          int l = j / 3744, q = j % 3744;
          const float* src; int K, Nsrc, mode, ntn; size_t dst;
          if (q < 864) { src = p.w_in + (size_t)l * 1024 * IN_COLS; K = 1024; Nsrc = IN_COLS; mode = 1; dst = WO_IN; ntn = 54; }
          else if ((q -= 864) < 256) { src = p.w_out + (size_t)l * 1024 * 1024; K = 1024; Nsrc = 1024; mode = 0; dst = WO_OUT; ntn = 16; }
          else if ((q -= 256) < 64) { src = p.xa_wq + (size_t)l * 1024 * 256; K = 1024; Nsrc = 256; mode = 0; dst = WO_Q; ntn = 4; }
          else if ((q -= 64) < 128) { src = p.xa_wkv + (size_t)l * 1024 * 512; K = 1024; Nsrc = 512; mode = 0; dst = WO_KV; ntn = 8; }
          else if ((q -= 128) < 64) { src = p.xa_wo + (size_t)l * 256 * 1024; K = 256; Nsrc = 1024; mode = 0; dst = WO_O; ntn = 16; }
          else if ((q -= 64) < 1408) { src = p.ffn_w13 + (size_t)l * 1024 * 5632; K = 1024; Nsrc = 5632; mode = 2; dst = WO_13; ntn = 88; }
          else if ((q -= 1408) < 704) { src = p.ffn_w2 + (size_t)l * 2816 * 1024; K = 2816; Nsrc = 1024; mode = 0; dst = WO_2; ntn = 16; }
          else if ((q -= 704) < 128) { src = p.nsa_k_w1 + (size_t)l * 2048 * 256; K = 2048; Nsrc = 256; mode = 0; dst = WO_KW1; ntn = 4; }
          else { q -= 128; src = p.nsa_v_w1 + (size_t)l * 2048 * 256; K = 2048; Nsrc = 256; mode = 0; dst = WO_VW1; ntn = 4; }
          job_convert(src, K, Nsrc, WB + (size_t)l * W_LAYER + dst, mode, q % ntn, q / ntn, (float*)smem);
        } else if ((j -= NCONV) < NMEM) {
          int l = j >> 6, row0 = (j & 63) * 16;
          job_rmsnorm(p.mem, p.norm_mem + l * 1024, (u16*)(PWS + OFF_MEMH) + (size_t)l * 1024 * 1024, nullptr, row0);
        } else if ((j -= NMEM) < NROPE) {
          int e = j * 256 + tid;
          int pos = e / 12, f = e % 12;
          float inv = f < 8 ? exp2f(-(float)f * (18.931568569324174f / 8.f)) : exp2f(-(float)(f - 8) * (18.931568569324174f / 4.f));
          float angf = (float)pos * inv;
          double ang = (double)angf;
          double k = rint(ang * 0.15915494309189535);
          float rr = (float)(ang - k * 6.283185307179586);
          float2 cs = make_float2(cosf(rr), sinf(rr));
          if (f < 8) ((float2*)(PWS + OFF_ROPE64))[pos * 8 + f] = cs; else ((float2*)(PWS + OFF_ROPE32))[pos * 4 + (f - 8)] = cs;
        } else if ((j -= NROPE) < NBIAS) {
          int l = j >> 1, kv = j & 1;
          const float* pe = (kv ? p.nsa_pos_v : p.nsa_pos_k) + (size_t)l * 2048;
          const float* w1 = (kv ? p.nsa_v_w1 : p.nsa_k_w1) + (size_t)l * 2048 * 256;
          float a = 0.f;
          for (int k = 0; k < 2048; ++k) a = fmaf(pe[k], w1[(size_t)k * 256 + tid], a);
          ((float*)(PWS + OFF_BIAS1))[(l * 2 + kv) * 256 + tid] = a;
        } else {
          j -= NBIAS;
          job_rmsnorm(p.x, p.norm_mix, Hb, p.out, j * 16);
        }
      }
    } else if (kind == 0) {
      const int NG = 128 * 27, NM = layer == 0 ? 2 * 8 * 4 : 0;
      while ((j = next_job(&ctr[ph], s_job)) < NG + NM) {
        if (j < NG) gemm_tile<0, 0>(Hb, 1024, WL + WO_IN, 1024, j / 27, j % 27, smem, cols, NC, nullptr, 0);
        else { int q = j - NG; int l = q >> 5, tm = (q >> 2) & 7, tn = q & 3;
          gemm_tile<0, 0>((const u16*)(PWS + OFF_MEMH) + (size_t)l * 1024 * 1024, 1024, WB + (size_t)l * W_LAYER + WO_KV, 1024, tm, tn, smem,
                          (u16*)(PWS + OFF_MEMKV) + (size_t)l * 1024 * 512, 512, nullptr, 0); }
      }
    } else if (kind == 1) {
      const int NP = 512, NM = layer == 0 ? 64 : 0;
      while ((j = next_job(&ctr[ph], s_job)) < NP + NM) {
        if (j < NP) job_prep(p, layer, j, smem); else job_memkv_post(p, j - NP, smem);
      }
    } else if (kind == 2) {
      const int ND = 512, NCG = 32, NML = 1024, NHG = 1024;
      while ((j = next_job(&ctr[ph], s_job)) < ND + NCG + NML + NHG) {
        if (j < ND) job_dsa(p, layer, j & 3, 127 - (j >> 2), smem);
        else if ((j -= ND) < NCG) {
          int kv = j >> 4, tm = (j >> 1) & 7, tn = j & 1;
          gemm_tile<3, 1>(cols, 0, WL + (kv ? WO_VW1 : WO_KW1), 2048, tm, tn, smem, (u16*)(PWS + OFF_HID) + kv * 256, 512,
                          (const float*)(PWS + OFF_BIAS1) + (layer * 2 + kv) * 256, kv ? C_VC : C_KC);
        } else if ((j -= NCG) < NML) job_ml_A(p, layer, j, smem);
        else job_hg_A(p, layer, j - NML, smem);
      }
    } else if (kind == 3) {
      const int NS = 256, NC2 = 64;
      while ((j = next_job(&ctr[ph], s_job)) < 2 * NS + NC2) {
        if (j < NS) job_ml_scan(p, j); else if (j < 2 * NS) job_hg_scan(p, j - NS); else job_cmp2(p, layer, j - 2 * NS, smem);
      }
    } else if (kind == 4) {
      const int NN = 512, NML = 1024, NHG = 1024;
      while ((j = next_job(&ctr[ph], s_job)) < NN + NML + NHG) {
        if (j < NN) job_nsa(p, layer, j & 3, 127 - (j >> 2), smem);
        else if ((j -= NN) < NML) job_ml_C(p, layer, j, smem);
        else job_hg_C(p, layer, j - NML, smem);
      }
    } else if (kind == 5) {
      if (!(DBG_SKIP & 1)) while ((j = next_job(&ctr[ph], s_job)) < 128 * 8) gemm_tile<1, 0>(Hb, 1024, WL + WO_OUT, 1024, j >> 3, j & 7, smem, p.out, 1024, nullptr, 0, DBG_MK0, DBG_MK1);
    } else if (kind == 6 || kind == 10 || kind == 13) {
      if (kind == 13 && layer == 1) {   }
      else {
        const float* g = kind == 6 ? p.norm_xa + layer * 1024 : (kind == 10 ? p.norm_ffn + layer * 1024 : p.norm_mix + (layer + 1) * 1024);
        while ((j = next_job(&ctr[ph], s_job)) < 1024) job_rmsnorm(p.out, g, Hb, nullptr, j * 16);
      }
    } else if (kind == 7) {
      while ((j = next_job(&ctr[ph], s_job)) < 128 * 2) gemm_tile<0, 0>(Hb, 1024, WL + WO_Q, 1024, j >> 1, j & 1, smem, (u16*)(PWS + OFF_XQ), 256, nullptr, 0);
    } else if (kind == 8) {
      while ((j = next_job(&ctr[ph], s_job)) < 512) job_xattn(p, layer, j >> 7, (j >> 5) & 3, j & 31, smem);
    } else if (kind == 9) {
      if (!(DBG_SKIP & 2)) while ((j = next_job(&ctr[ph], s_job)) < 128 * 8) gemm_tile<1, 0>((const u16*)(PWS + OFF_XO), 256, WL + WO_O, 256, j >> 3, j & 7, smem, p.out, 1024, nullptr, 0);
    } else if (kind == 11) {
      while ((j = next_job(&ctr[ph], s_job)) < 128 * 44) gemm_tile<2, 0>(Hb, 1024, WL + WO_13, 1024, j / 44, j % 44, smem, (u16*)(PWS + OFF_G), DFF, nullptr, 0);
    } else if (kind == 12) {
      if (!(DBG_SKIP & 4)) while ((j = next_job(&ctr[ph], s_job)) < 128 * 8) gemm_tile<1, 0>((const u16*)(PWS + OFF_G), DFF, WL + WO_2, DFF, j >> 3, j & 7, smem, p.out, 1024, nullptr, 0);
    }
    if (ph + 1 < NPHASE) grid.sync();
  }
}

extern "C" void kernel_launch(void* const* d_in, const int* in_sizes, int n_in, void* d_out, int out_size, void* d_ws, size_t ws_size,
                              hipStream_t stream) {
  static int grid_blocks = 0;
  if (!grid_blocks) {
    int dev = 0, cus = 0, per_cu = 0;
    hipGetDevice(&dev);
    hipDeviceGetAttribute(&cus, hipDeviceAttributeMultiprocessorCount, dev);
    hipOccupancyMaxActiveBlocksPerMultiprocessor(&per_cu, fwd_megakernel, 256, 0);
    if (per_cu > 2) per_cu = 2;
    if (per_cu < 1) per_cu = 1;
    grid_blocks = cus * per_cu;
  }
  Params p{};
  const float** pp = (const float**)&p;
  for (int i = 0; i < 36; ++i) pp[i] = (const float*)d_in[i];
  p.out = (float*)d_out;
  p.ws = (char*)d_ws;
  hipMemsetAsync(d_ws, 0, 4096, stream);
  void* args[] = {&p};
  hipError_t e = hipLaunchCooperativeKernel((void*)fwd_megakernel, dim3(grid_blocks), dim3(256), args, 0, stream);
  if (e != hipSuccess) fprintf(stderr, "cooperative launch failed: %s (grid %d)\n", hipGetErrorString(e), grid_blocks);
}
```

```cpp
#include <hip/hip_runtime.h>
#include <hip/hip_bf16.h>
#include <hip/hip_cooperative_groups.h>
#include <cstdio>
namespace cg = cooperative_groups;

#define DI __device__ __forceinline__
typedef unsigned short u16;
typedef unsigned long long u64;
typedef __attribute__((ext_vector_type(8))) short bf16x8;
typedef __attribute__((ext_vector_type(4))) short s16x4;
typedef __attribute__((ext_vector_type(16))) float f32x16;
typedef __attribute__((ext_vector_type(2))) float f32x2;
typedef __attribute__((ext_vector_type(4))) unsigned u32x4;
typedef __attribute__((ext_vector_type(2))) __bf16 bf16x2v;

constexpr int T_TOK = 16384, SEQL = 4096, NBATCH = 4, DM = 1024;
constexpr int NC = 3456;
constexpr int C_HGQ = 0, C_HGF = 256, C_HGI = 512, C_HGG = 768;
constexpr int C_DQ = 1024, C_CKV = 1280, C_IQ = 1408;
constexpr int C_NQ = 1664, C_KC = 1920, C_VC = 1984, C_KS = 2048, C_VS = 2112, C_KW = 2176, C_VW = 2240;
constexpr int C_MQ = 2304, C_MK = 2560, C_MV = 2816, C_MOG = 3072;
constexpr int C_IK = 3328, C_IW = 3360, C_GATES = 3368, C_IG = 3380, C_FG = 3384;
constexpr int IN_COLS = 3388, DFF = 2816;

constexpr size_t WO_IN = 0;
constexpr size_t WO_OUT = WO_IN + (size_t)NC * 1024;
constexpr size_t WO_Q = WO_OUT + 1024 * 1024;
constexpr size_t WO_KV = WO_Q + 256 * 1024;
constexpr size_t WO_O = WO_KV + 512 * 1024;
constexpr size_t WO_13 = WO_O + 1024 * 256;
constexpr size_t WO_2 = WO_13 + (size_t)5632 * 1024;
constexpr size_t WO_KW1 = WO_2 + (size_t)1024 * 2816;
constexpr size_t WO_VW1 = WO_KW1 + 256 * 2048;
constexpr size_t W_LAYER = WO_VW1 + 256 * 2048;

constexpr size_t al256(size_t x) { return (x + 255) & ~(size_t)255; }
constexpr size_t OFF_CTR = 0;
constexpr size_t OFF_BAR = 4096;
constexpr size_t OFF_ROPE64 = 4096 + 16384;
constexpr size_t OFF_ROPE32 = OFF_ROPE64 + 4096 * 8 * 8;
constexpr size_t OFF_BIAS1 = OFF_ROPE32 + 4096 * 4 * 8;
constexpr size_t OFF_WB = al256(OFF_BIAS1 + 4096);
constexpr size_t OFF_COLS = al256(OFF_WB + 2 * W_LAYER * 2);
constexpr size_t OFF_H = al256(OFF_COLS + (size_t)T_TOK * NC * 2);
constexpr size_t OFF_HGST = al256(OFF_H + (size_t)T_TOK * 1024 * 2);
constexpr size_t OFF_MLST = al256(OFF_HGST + (size_t)1024 * 4096 * 4);
constexpr size_t OFF_HGD = al256(OFF_MLST + (size_t)1024 * 4096 * 4);
constexpr size_t OFF_MLN = al256(OFF_HGD + 1024 * 64 * 4);
constexpr size_t OFF_MLSC = al256(OFF_MLN + 1024 * 64 * 4);
constexpr size_t OFF_DK = al256(OFF_MLSC + 3 * 1024 * 4);
constexpr size_t OFF_DVT = al256(OFF_DK + (size_t)T_TOK * 64 * 2);
constexpr size_t OFF_VST = al256(OFF_DVT + (size_t)T_TOK * 64 * 2);
constexpr size_t OFF_VWT = al256(OFF_VST + (size_t)T_TOK * 64 * 2);
constexpr size_t OFF_KCMP = al256(OFF_VWT + (size_t)T_TOK * 64 * 2);
constexpr size_t OFF_VCMPT = al256(OFF_KCMP + 4 * 256 * 64 * 2);
constexpr size_t OFF_HID = al256(OFF_VCMPT + 4 * 256 * 64 * 2);
constexpr size_t OFF_MEMH = al256(OFF_HID + 1024 * 512 * 2);
constexpr size_t OFF_MEMKV = al256(OFF_MEMH + 2 * 1024 * 1024 * 2);
constexpr size_t OFF_MEMVT = al256(OFF_MEMKV + 2 * 1024 * 512 * 2);
constexpr size_t OFF_IKC = al256(OFF_MEMVT + 2 * 4 * 256 * 256 * 2);
constexpr size_t OFF_WUKV = al256(OFF_IKC + (size_t)T_TOK * 32 * 2);
constexpr size_t OFF_END = al256(OFF_WUKV + 2 * 128 * 128 * 2);
static_assert(OFF_END <= (size_t)256 * 1024 * 1024, "workspace overflow");
constexpr size_t OFF_XQ = OFF_HGST;
constexpr size_t OFF_XO = OFF_MLST;
constexpr size_t OFF_G = OFF_COLS;

constexpr int SMEM_BYTES = 75776;
constexpr int NPHASE = 28;
#define DBG_SKIP 0
#define DBG_REP -2
#define DBG_SUB 15
#define DBG_ATT_REP 1
#define DBG_EPI_REP 1
#define DBG_SELREP 1
#define DBG_SLC_REP 1
#define DBG_SWA_REP 1
#define DBG_MK0 0
#define DBG_MK1 16

struct Params {
  const float* x; const float* mem; const float* lb_param; const float* norm_mix; const float* w_in; const float* w_out;
  const float* hg_o_gain; const float* dsa_kv_gain; const float* dsa_w_uk; const float* dsa_w_uv; const float* dsa_q_gain;
  const float* dsa_k_gain; const float* dsa_idxk_gain; const float* nsa_pos_k; const float* nsa_pos_v; const float* nsa_k_w1;
  const float* nsa_k_w2; const float* nsa_v_w1; const float* nsa_v_w2; const float* nsa_q_gain; const float* nsa_k_gains;
  const float* ml_conv_w; const float* ml_conv_b; const float* ml_i_bias; const float* ml_f_bias; const float* ml_o_gain;
  const float* norm_xa; const float* norm_mem; const float* xa_wq; const float* xa_wkv; const float* xa_wo; const float* xa_q_gain;
  const float* xa_k_gain; const float* norm_ffn; const float* ffn_w13; const float* ffn_w2;
  float* out; char* ws;
  int use_cg; int pad_;
};

DI int otid() { int t = __builtin_amdgcn_workitem_id_x(); asm volatile("" : "+v"(t)); return t; }
typedef __attribute__((address_space(1))) char gchar_t;
DI char* oq(char* x) { gchar_t* g = (gchar_t*)x; asm volatile("" : "+s"(g)); return (char*)g; }
template <class T> DI T* asg(T* q) { return (T*)(__attribute__((address_space(1))) T*)q; }
#define PWS (oq(p.ws))
DI float bf2f(u16 v) { return __uint_as_float(((unsigned)v) << 16); }
DI unsigned pack2(float a, float b) { f32x2 v = {a, b}; return __builtin_bit_cast(unsigned, __builtin_convertvector(v, bf16x2v)); }
DI u16 f2bf(float a) { return (u16)(pack2(a, 0.f) & 0xffffu); }
DI float sigmoidf_(float x) { return 1.f / (1.f + expf(-x)); }
DI float siluf_(float x) { return x / (1.f + expf(-x)); }
DI int crow(int reg, int h) { return (reg & 3) + 8 * (reg >> 2) + 4 * h; }
DI f32x16 zero16() { f32x16 z; for (int i = 0; i < 16; ++i) z[i] = 0.f; return z; }
#define MFMA_BF(a, b, c) __builtin_amdgcn_mfma_f32_32x32x16_bf16((a), (b), (c), 0, 0, 0)
#define MFMA_F32(a, b, c) __builtin_amdgcn_mfma_f32_32x32x2f32((a), (b), (c), 0, 0, 0)
DI float wave_sum(float v) { for (int o = 32; o; o >>= 1) v += __shfl_xor(v, o); return v; }
DI float wave_max(float v) { for (int o = 32; o; o >>= 1) v = fmaxf(v, __shfl_xor(v, o)); return v; }
DI void load4bf(const u16* p, float (&x)[4]) { uint2 v = *(const uint2*)p; x[0] = __uint_as_float(v.x << 16); x[1] = __uint_as_float(v.x & 0xffff0000u); x[2] = __uint_as_float(v.y << 16); x[3] = __uint_as_float(v.y & 0xffff0000u); }
DI void ld8bf(const u16* p, float (&x)[8]) {
  u32x4 v = *(const u32x4*)p;
  x[0] = __uint_as_float(v.x << 16); x[1] = __uint_as_float(v.x & 0xffff0000u);
  x[2] = __uint_as_float(v.y << 16); x[3] = __uint_as_float(v.y & 0xffff0000u);
  x[4] = __uint_as_float(v.z << 16); x[5] = __uint_as_float(v.z & 0xffff0000u);
  x[6] = __uint_as_float(v.w << 16); x[7] = __uint_as_float(v.w & 0xffff0000u);
}
DI void store4bf(u16* p, const float (&x)[4]) { uint2 v; v.x = pack2(x[0], x[1]); v.y = pack2(x[2], x[3]); *(uint2*)p = v; }

template <int W>
DI void rowop(float (&x)[4], int lg, const float* gain, bool do_norm, bool do_rope, int pos, const float2* ropetab) {
  if (do_norm) {
    float ss = x[0] * x[0] + x[1] * x[1] + x[2] * x[2] + x[3] * x[3];
#pragma unroll
    for (int o = W / 8; o >= 1; o >>= 1) ss += __shfl_xor(ss, o);
    float rstd = rsqrtf(ss * (1.f / W) + 1e-6f);
#pragma unroll
    for (int i = 0; i < 4; ++i) x[i] = x[i] * rstd * gain[lg * 4 + i];
  }
  if (do_rope) {
    constexpr int HALF = W / 8, LPH = HALF / 4;
    float xp[4];
#pragma unroll
    for (int i = 0; i < 4; ++i) xp[i] = __shfl_xor(x[i], LPH);
    const float4* tp = (const float4*)(ropetab + pos * HALF + (lg % LPH) * 4);
    const float4 c01 = tp[0], c23 = tp[1];
    const float cs[4] = {c01.x, c01.z, c23.x, c23.z};
    const float sn[4] = {c01.y, c01.w, c23.y, c23.w};
    const bool rot = lg < 2 * LPH;
    const bool isx2 = lg >= LPH;
#pragma unroll
    for (int i = 0; i < 4; ++i) {
      float rv = isx2 ? (x[i] * cs[i] + xp[i] * sn[i]) : (x[i] * cs[i] - xp[i] * sn[i]);
      x[i] = rot ? rv : x[i];
    }
  }
}

DI int map_in(int n) {
  if (n < 1664) return n;
  if (n < 2304) return n + 40;
  if (n < 3328) return n + 52;
  if (n < 3360) return 1664 + (n - 3328);
  if (n < 3368) return 1696 + (n - 3360);
  if (n < 3380) return 2344 + (n - 3368);
  if (n < 3388) return n;
  return -1;
}
DI int map_w13(int n) { int blk = n >> 6, w = n & 63; return w < 32 ? blk * 32 + w : 2816 + blk * 32 + (w - 32); }

DI void job_convert(const float* src, int K, int Nsrc, u16* dst, int mode, int tile_n, int tile_k, float* sm) {
  const int tid = otid(), tx = tid & 15, ty = tid >> 4;
  int n = tile_n * 64 + tx * 4;
  int sn = mode == 0 ? n : (mode == 1 ? map_in(n) : map_w13(n));
  float4 v[4];
#pragma unroll
  for (int i = 0; i < 4; ++i) {
    int kl = ty + 16 * i;
    v[i] = sn >= 0 ? *(const float4*)(src + (size_t)(tile_k * 64 + kl) * Nsrc + sn) : make_float4(0.f, 0.f, 0.f, 0.f);
  }
#pragma unroll
  for (int i = 0; i < 4; ++i) {
    int kl = ty + 16 * i;
    sm[kl * 65 + tx * 4 + 0] = v[i].x; sm[kl * 65 + tx * 4 + 1] = v[i].y; sm[kl * 65 + tx * 4 + 2] = v[i].z; sm[kl * 65 + tx * 4 + 3] = v[i].w;
  }
  __syncthreads();
  int row = tid >> 2, seg = tid & 3;
  unsigned pk[8];
#pragma unroll
  for (int i = 0; i < 8; ++i) pk[i] = pack2(sm[(seg * 16 + 2 * i) * 65 + row], sm[(seg * 16 + 2 * i + 1) * 65 + row]);
  uint4* d = (uint4*)(dst + (size_t)(tile_n * 64 + row) * K + tile_k * 64 + seg * 16);
  d[0] = make_uint4(pk[0], pk[1], pk[2], pk[3]);
  d[1] = make_uint4(pk[4], pk[5], pk[6], pk[7]);
}

DI void job_rmsnorm(const float* X, const float* gain, u16* H, float* copy_out, int row0) {
  const int tid = otid(), lane = tid & 63, w = tid >> 6;
  for (int i = 0; i < 4; ++i) {
    int row = row0 + w * 4 + i;
    const float4* xr = (const float4*)(X + (size_t)row * 1024);
    float4 v[4];
    float ss = 0.f;
#pragma unroll
    for (int j = 0; j < 4; ++j) { v[j] = xr[lane + 64 * j]; ss += v[j].x * v[j].x + v[j].y * v[j].y + v[j].z * v[j].z + v[j].w * v[j].w; }
    ss = wave_sum(ss);
    float rstd = rsqrtf(ss * (1.f / 1024.f) + 1e-6f);
#pragma unroll
    for (int j = 0; j < 4; ++j) {
      float4 g = ((const float4*)gain)[lane + 64 * j];
      uint2 o; o.x = pack2(v[j].x * rstd * g.x, v[j].y * rstd * g.y); o.y = pack2(v[j].z * rstd * g.z, v[j].w * rstd * g.w);
      *(uint2*)(H + (size_t)row * 1024 + (lane + 64 * j) * 4) = o;
      if (copy_out) ((float4*)(copy_out + (size_t)row * 1024))[lane + 64 * j] = v[j];
    }
  }
}

template <int EPI, int AMODE>
DI void gemm_tile(const u16* __restrict__ A, int lda, const u16* __restrict__ Bt, int K, int tm, int tn, char* smem,
                  void* Cp, int ldc, const float* bias, int coff, int kt0 = 0, int kt1 = -1) {
  u16* As = (u16*)smem;
  u16* Bs = As + 2 * 128 * 72;
  const int tid = otid(), lane = tid & 63, w = tid >> 6;
  const int r = lane & 31, h = lane >> 5, wm = w >> 1, wn = w & 1;
  const int lrow = tid >> 3, lseg = tid & 7;
  const u16* ap[4];
  const u16* bp[4];
#pragma unroll
  for (int i = 0; i < 4; ++i) {
    int row = tm * 128 + lrow + 32 * i;
    if (AMODE == 0) ap[i] = A + (size_t)row * lda + lseg * 8;
    else { int m = row < 1019 ? row : 1019; int b = m / 255, j = m % 255; ap[i] = A + ((size_t)(b * 4096 + 16 * j)) * NC + coff + lseg * 8; }
    bp[i] = Bt + (size_t)(tn * 128 + lrow + 32 * i) * K + lseg * 8;
  }
  const size_t akstep = AMODE == 0 ? 64 : NC;
  f32x16 acc[2][2];
#pragma unroll
  for (int a = 0; a < 2; ++a)
#pragma unroll
    for (int b = 0; b < 2; ++b) acc[a][b] = zero16();
  u32x4 ra[4], rb[4];
#pragma unroll
  for (int i = 0; i < 4; ++i) { ra[i] = *(const u32x4*)(ap[i] + (size_t)kt0 * akstep); rb[i] = *(const u32x4*)(bp[i] + (size_t)kt0 * 64); }
#pragma unroll
  for (int i = 0; i < 4; ++i) {
    *(u32x4*)(As + (lrow + 32 * i) * 72 + lseg * 8) = ra[i];
    *(u32x4*)(Bs + (lrow + 32 * i) * 72 + lseg * 8) = rb[i];
  }
  __syncthreads();
  const int nk = kt1 < 0 ? K / 64 : kt1;
  for (int kt = kt0; kt < nk; ++kt) {
    const int cur = (kt - kt0) & 1;
    if (kt + 1 < nk) {
#pragma unroll
      for (int i = 0; i < 4; ++i) { ra[i] = *(const u32x4*)(ap[i] + (size_t)(kt + 1) * akstep); rb[i] = *(const u32x4*)(bp[i] + (size_t)(kt + 1) * 64); }
    }
    const u16* Ac = As + cur * 128 * 72;
    const u16* Bc = Bs + cur * 128 * 72;
#pragma unroll
    for (int s = 0; s < 4; ++s) {
      bf16x8 af[2], bfr[2];
#pragma unroll
      for (int mt = 0; mt < 2; ++mt) af[mt] = *(const bf16x8*)(Ac + (wm * 64 + mt * 32 + r) * 72 + s * 16 + h * 8);
#pragma unroll
      for (int nt = 0; nt < 2; ++nt) bfr[nt] = *(const bf16x8*)(Bc + (wn * 64 + nt * 32 + r) * 72 + s * 16 + h * 8);
#pragma unroll
      for (int mt = 0; mt < 2; ++mt)
#pragma unroll
        for (int nt = 0; nt < 2; ++nt) acc[mt][nt] = MFMA_BF(af[mt], bfr[nt], acc[mt][nt]);
    }
    if (kt + 1 < nk) {
      u16* An = As + (cur ^ 1) * 128 * 72;
      u16* Bn = Bs + (cur ^ 1) * 128 * 72;
#pragma unroll
      for (int i = 0; i < 4; ++i) {
        *(u32x4*)(An + (lrow + 32 * i) * 72 + lseg * 8) = ra[i];
        *(u32x4*)(Bn + (lrow + 32 * i) * 72 + lseg * 8) = rb[i];
      }
    }
    __syncthreads();
  }
  for (int erep = 0; erep < ((EPI == 0 || EPI == 2) ? DBG_EPI_REP : 1); ++erep)
#pragma unroll
  for (int mt = 0; mt < 2; ++mt) {
#pragma unroll
    for (int reg = 0; reg < 16; ++reg) {
      int row = tm * 128 + wm * 64 + mt * 32 + crow(reg, h);
      if (EPI == 0) {
        u16* C = (u16*)Cp;
#pragma unroll
        for (int nt = 0; nt < 2; ++nt) C[(size_t)row * ldc + tn * 128 + wn * 64 + nt * 32 + r] = f2bf(acc[mt][nt][reg]);
      } else if (EPI == 1) {
        float* C = (float*)Cp;
#pragma unroll
        for (int nt = 0; nt < 2; ++nt) { float* q = C + (size_t)row * ldc + tn * 128 + wn * 64 + nt * 32 + r; *q = *q + acc[mt][nt][reg]; }
      } else if (EPI == 2) {
        u16* C = (u16*)Cp;
        float a = acc[mt][0][reg], b = acc[mt][1][reg];
        C[(size_t)row * ldc + (tn * 2 + wn) * 32 + r] = f2bf(siluf_(a) * b);
      } else {
        u16* C = (u16*)Cp;
        if (row < 1020) {
#pragma unroll
          for (int nt = 0; nt < 2; ++nt) {
            int col = tn * 128 + wn * 64 + nt * 32 + r;
            C[(size_t)row * ldc + coff * 0 + col] = f2bf(fmaxf(acc[mt][nt][reg] + bias[col], 0.f));
          }
        }
      }
    }
  }
}

struct AttnAcc { f32x16 o0, o1; float m, l; };
DI void attn_init(AttnAcc& a) { a.o0 = zero16(); a.o1 = zero16(); a.m = -INFINITY; a.l = 0.f; }

template <class SrcF, class PosF>
DI void stage_q(u16* Qs, SrcF src, PosF posf, const float* gain, bool do_norm, bool do_rope, const float2* rope64, float scale) {
  const int tid = otid(), lg = tid & 15;
#pragma unroll
  for (int it = 0; it < 8; ++it) {
    int row = it * 16 + (tid >> 4);
    int slot = row >> 5, r = row & 31;
    float x[4];
    load4bf(src(slot, r) + lg * 4, x);
    rowop<64>(x, lg, gain, do_norm, do_rope, posf(slot, r), rope64);
#pragma unroll
    for (int i = 0; i < 4; ++i) x[i] *= scale;
    store4bf(Qs + (slot * 32 + r) * 72 + lg * 4, x);
  }
}
DI void load_qfrags(bf16x8 (&qf)[4], const u16* Qs, int slot, int r, int h) {
#pragma unroll
  for (int s = 0; s < 4; ++s) qf[s] = *(const bf16x8*)(Qs + (slot * 32 + r) * 72 + s * 16 + h * 8);
}

constexpr int KV_BUF = 32 * 72 + 64 * 40;

template <class TileF, class MaskF>
DI void attn_run(AttnAcc& a, const bf16x8 (&qf)[4], const u16* Kb, size_t kstride, int kmaxrow, const u16* Vtb, size_t vstride,
                 int ntiles, TileF tile_at, MaskF mask_at, u16* kvs) {
  const int tid = otid(), lane = tid & 63;
  const int r = lane & 31, h = lane >> 5;
  const int krow = tid >> 3, kseg = tid & 7, vrow = tid >> 2, vseg = tid & 3;
  if (ntiles <= 0) return;
  u32x4 rk, rv;
  {
    int kt = tile_at(0);
    int kr = kt * 32 + krow; kr = kr < kmaxrow ? kr : kmaxrow;
    rk = *(const u32x4*)(Kb + (size_t)kr * kstride + kseg * 8);
    rv = *(const u32x4*)(Vtb + (size_t)vrow * vstride + kt * 32 + vseg * 8);
  }
  __syncthreads();
  *(u32x4*)(kvs + krow * 72 + kseg * 8) = rk;
  *(u32x4*)(kvs + 32 * 72 + vrow * 40 + vseg * 8) = rv;
  __syncthreads();
  for (int i = 0; i < ntiles; ++i) {
    const int kt = tile_at(i);
    const int cur = i & 1;
    if (i + 1 < ntiles) {
      int kn = tile_at(i + 1);
      int kr = kn * 32 + krow; kr = kr < kmaxrow ? kr : kmaxrow;
      rk = *(const u32x4*)(Kb + (size_t)kr * kstride + kseg * 8);
      rv = *(const u32x4*)(Vtb + (size_t)vrow * vstride + kn * 32 + vseg * 8);
    }
    const u16* Kc = kvs + cur * KV_BUF;
    const u16* Vc = Kc + 32 * 72;
    f32x16 s = zero16();
#pragma unroll
    for (int ks = 0; ks < 4; ++ks) {
      bf16x8 kf = *(const bf16x8*)(Kc + r * 72 + ks * 16 + h * 8);
      s = MFMA_BF(kf, qf[ks], s);
    }
    unsigned mw = mask_at(kt);
    float mx = -INFINITY;
#pragma unroll
    for (int reg = 0; reg < 16; ++reg) {
      bool bit = (mw >> crow(reg, h)) & 1u;
      s[reg] = bit ? s[reg] : -INFINITY;
      mx = fmaxf(mx, s[reg]);
    }
    mx = fmaxf(mx, __shfl_xor(mx, 32));
    float mnew = fmaxf(a.m, mx);
    float mb = (mnew == -INFINITY) ? 0.f : mnew;
    float alpha = __builtin_amdgcn_exp2f(a.m - mb);
    float psum = 0.f;
#pragma unroll
    for (int reg = 0; reg < 16; ++reg) { float pv = __builtin_amdgcn_exp2f(s[reg] - mb); psum += pv; s[reg] = pv; }
    a.l = a.l * alpha + psum;
    a.m = mnew;
#pragma unroll
    for (int reg = 0; reg < 16; ++reg) { a.o0[reg] *= alpha; a.o1[reg] *= alpha; }
#pragma unroll
    for (int s2 = 0; s2 < 2; ++s2) {
      uint4 pu;
      pu.x = pack2(s[8 * s2 + 0], s[8 * s2 + 1]); pu.y = pack2(s[8 * s2 + 2], s[8 * s2 + 3]);
      pu.z = pack2(s[8 * s2 + 4], s[8 * s2 + 5]); pu.w = pack2(s[8 * s2 + 6], s[8 * s2 + 7]);
      bf16x8 pf = __builtin_bit_cast(bf16x8, pu);
#pragma unroll
      for (int dt = 0; dt < 2; ++dt) {
        uint2 lo = *(const uint2*)(Vc + (dt * 32 + r) * 40 + 16 * s2 + 4 * h);
        uint2 hi = *(const uint2*)(Vc + (dt * 32 + r) * 40 + 16 * s2 + 8 + 4 * h);
        uint4 vu = make_uint4(lo.x, lo.y, hi.x, hi.y);
        bf16x8 vf = __builtin_bit_cast(bf16x8, vu);
        if (dt == 0) a.o0 = MFMA_BF(vf, pf, a.o0); else a.o1 = MFMA_BF(vf, pf, a.o1);
      }
    }
    if (i + 1 < ntiles) {
      u16* Kn = kvs + (cur ^ 1) * KV_BUF;
      *(u32x4*)(Kn + krow * 72 + kseg * 8) = rk;
      *(u32x4*)(Kn + 32 * 72 + vrow * 40 + vseg * 8) = rv;
    }
    __syncthreads();
  }
}

DI unsigned lowmask(int n) { return n <= 0 ? 0u : (n >= 32 ? 0xffffffffu : ((1u << n) - 1u)); }

DI void dsa_scores(f32x16& sc, const bf16x8& kf0, const bf16x8& kf1, int h, const u16* iqrow, const float (&wq)[8]) {
  {
    bf16x8 q0 = *(const bf16x8*)(iqrow + 256 + h * 8);
    bf16x8 q1 = *(const bf16x8*)(iqrow + 256 + 16 + h * 8);
    sc = zero16();
    sc = MFMA_BF(kf0, q0, sc);
    sc = MFMA_BF(kf1, q1, sc);
  }
#pragma unroll
  for (int hh = 0; hh < 8; ++hh) {
    bf16x8 q0 = *(const bf16x8*)(iqrow + hh * 32 + h * 8);
    bf16x8 q1 = *(const bf16x8*)(iqrow + hh * 32 + 16 + h * 8);
    f32x16 a = zero16();
    a = MFMA_BF(kf0, q0, a);
    a = MFMA_BF(kf1, q1, a);
#pragma unroll
    for (int reg = 0; reg < 16; ++reg) sc[reg] = fmaf(wq[hh], __builtin_fabsf(a[reg]), sc[reg]);
    if (hh & 1) __builtin_amdgcn_sched_barrier(0);
  }
}
DI unsigned okey_of(float s) {
  unsigned u = __float_as_uint(s + 0.f);
  return u ^ ((unsigned)((int)u >> 31) | 0x80000000u);
}

template <int MODE>
DI void dsa_hist_tiles(unsigned* hist, const u16* ikc, const u16* iqrow, const float (&wq)[8], int w, int r, int h, int lane, int ntile, int tq,
                       unsigned mhi, unsigned mlo, int shm, int shd, bool last_idx) {
  int kt = w;
  bf16x8 n0, n1;
  if (kt < ntile) { const u16* kp = ikc + (size_t)(kt * 32 + r) * 32 + h * 8; n0 = *(const bf16x8*)kp; n1 = *(const bf16x8*)(kp + 16); }
  for (; kt < ntile; kt += 4) {
    bf16x8 kf0 = n0, kf1 = n1;
    if (kt + 4 < ntile) { const u16* kp = ikc + (size_t)((kt + 4) * 32 + r) * 32 + h * 8; n0 = *(const bf16x8*)kp; n1 = *(const bf16x8*)(kp + 16); }
    f32x16 sc;
    dsa_scores(sc, kf0, kf1, h, iqrow, wq);
#pragma unroll
    for (int reg = 0; reg < 16; ++reg) {
      const int sidx = kt * 32 + crow(reg, h);
      const unsigned ok = okey_of(sc[reg]);
      bool sel = sidx <= tq;
      unsigned digit;
      if (MODE == 0) { digit = ok >> 24; }
      else if (MODE == 1) { sel = sel && ((ok >> shm) == mhi); digit = (ok >> shd) & 255u; }
      else { const unsigned ri = 4095u - (unsigned)sidx; sel = sel && (ok == mhi) && (last_idx ? ((ri >> 4) == mlo) : true); digit = last_idx ? (ri & 15u) : (ri >> 4); }
      const int addr = sel ? (r * 257 + (int)digit) : (32 * 257 + lane);
      atomicAdd(&hist[addr], 1u);
    }
  }
}

constexpr int DSA_CAP = 64;

DI void job_dsa(const Params& p, int layer, int b, int tt, char* smem) {
  const int tid = otid(), lane = tid & 63, w = tid >> 6, r = lane & 31, h = lane >> 5;
  const int t0 = tt * 32, ntile = tt + 1;
  u16* cols = (u16*)(PWS + OFF_COLS);
  const u16* cb = cols + (size_t)b * SEQL * NC;
  const u16* ikc = (const u16*)(PWS + OFF_IKC) + (size_t)b * SEQL * 32;
  unsigned* hist = (unsigned*)smem;
  unsigned* candk = (unsigned*)smem;
  unsigned* candi = (unsigned*)(smem + 8192);
  unsigned* candn = (unsigned*)(smem + 16384);
  u16* Qs = (u16*)smem;
  u16* kvs = (u16*)(smem + 18432);
  unsigned* maskw = (unsigned*)(smem + 37888);
  unsigned* segs = (unsigned*)(smem + 54272);
  unsigned* prehi = (unsigned*)(smem + 55296);
  unsigned* prelo = (unsigned*)(smem + 55424);
  unsigned* need = (unsigned*)(smem + 55552);
  int* flags = (int*)(smem + 55680);
  const float2* rope64 = (const float2*)(PWS + OFF_ROPE64);

  const u16* qrow = cb + (size_t)(t0 + r) * NC;
  u16* iqs = (u16*)(smem + 55808);
  for (int i = 0; i < 4; ++i) {
    int c = tid + 256 * i; int row = c >> 5, seg = c & 31;
    *(u32x4*)(iqs + row * 296 + seg * 8) = *(const u32x4*)(cb + (size_t)(t0 + row) * NC + C_IQ + seg * 8);
  }
  const u16* iqrow = iqs + r * 296;
  float wq[8];
  { float a[4], c[4]; load4bf(qrow + C_IW, a); load4bf(qrow + C_IW + 4, c);
#pragma unroll
    for (int i = 0; i < 4; ++i) { wq[i] = 0.5f * a[i]; wq[4 + i] = 0.5f * c[i]; } }

  if (tid < 32) { prehi[tid] = 0; prelo[tid] = 0; int nd = t0 + tid + 1; need[tid] = nd < 256 ? nd : 256; }
  if (tid < 16) flags[tid] = 0;
  __syncthreads();
  {
    int row = tid >> 3, lg = tid & 7;
    const u16* wr = cb + (size_t)(t0 + row) * NC + C_IW;
    float acc4[4] = {0.f, 0.f, 0.f, 0.f};
#pragma unroll
    for (int hh = 0; hh < 8; ++hh) {
      float wv = 0.5f * bf2f(wr[hh]);
      float x[4]; load4bf(iqs + row * 296 + hh * 32 + lg * 4, x);
#pragma unroll
      for (int i = 0; i < 4; ++i) acc4[i] = fmaf(wv, x[i], acc4[i]);
    }
    store4bf(iqs + row * 296 + 256 + lg * 4, acc4);
  }
  const int tq = t0 + r;
  int lastpass = 0;
  bool fast = false;
  for (int pass = 0; pass < 6; ++pass) {
    for (int i = tid; i < 32 * 257 + 64; i += 256) hist[i] = 0;
    __syncthreads();
    const unsigned mhi = prehi[r], mlo = prelo[r];
    if (pass == 0) dsa_hist_tiles<0>(hist, ikc, iqrow, wq, w, r, h, lane, ntile, tq, mhi, mlo, 0, 0, false);
    else if (pass < 4) dsa_hist_tiles<1>(hist, ikc, iqrow, wq, w, r, h, lane, ntile, tq, mhi, mlo, 32 - 8 * pass, 24 - 8 * pass, false);
    else dsa_hist_tiles<2>(hist, ikc, iqrow, wq, w, r, h, lane, ntile, tq, mhi, mlo, 0, 0, pass == 5);
    __syncthreads();
    {
      int row = tid >> 3, part = tid & 7;
      unsigned sum = 0;
      for (int i = 0; i < 32; ++i) sum += hist[row * 257 + part * 32 + i];
      segs[row * 8 + part] = sum;
    }
    __syncthreads();
    if ((tid & 7) == 0) {
      int row = tid >> 3;
      unsigned nd = need[row], cum = 0;
      int pt = 7;
      for (; pt > 0; --pt) { unsigned c = segs[row * 8 + pt]; if (cum + c >= nd) break; cum += c; }
      int bin = pt * 32 + 31;
      for (; bin > pt * 32; --bin) { unsigned c = hist[row * 257 + bin]; if (cum + c >= nd) break; cum += c; }
      unsigned cnt = hist[row * 257 + bin];
      if (pass < 4) prehi[row] = (prehi[row] << 8) | (unsigned)bin;
      else if (pass == 4) prelo[row] = (unsigned)bin;
      else prelo[row] = (prelo[row] << 4) | (unsigned)bin;
      need[row] = nd - cum;
      if (cnt != nd - cum) atomicOr(&flags[pass], 1);
      if (pass == 1 && cnt > (unsigned)DSA_CAP) atomicOr(&flags[8], 1);
    }
    __syncthreads();
    lastpass = pass;
    if (flags[pass] == 0) break;
    if (pass == 1 && flags[8] == 0) { fast = true; break; }
  }
  if (fast) {
    if (tid < 32) candn[tid] = 0;
    __syncthreads();
    const unsigned t16 = prehi[r];
    int kt = w;
    bf16x8 n0, n1;
    if (kt < ntile) { const u16* kp = ikc + (size_t)(kt * 32 + r) * 32 + h * 8; n0 = *(const bf16x8*)kp; n1 = *(const bf16x8*)(kp + 16); }
    for (; kt < ntile; kt += 4) {
      bf16x8 kf0 = n0, kf1 = n1;
      if (kt + 4 < ntile) { const u16* kp = ikc + (size_t)((kt + 4) * 32 + r) * 32 + h * 8; n0 = *(const bf16x8*)kp; n1 = *(const bf16x8*)(kp + 16); }
      f32x16 sc;
      dsa_scores(sc, kf0, kf1, h, iqrow, wq);
      unsigned word = 0;
#pragma unroll
      for (int reg = 0; reg < 16; ++reg) {
        const int sidx = kt * 32 + crow(reg, h);
        const unsigned ok = okey_of(sc[reg]);
        const unsigned hi16 = ok >> 16;
        const bool valid = sidx <= tq;
        word |= (valid && hi16 > t16) ? (1u << crow(reg, h)) : 0u;
        if (valid && hi16 == t16) {
          unsigned slot = atomicAdd(&candn[r], 1u);
          if (slot < (unsigned)DSA_CAP) { candk[r * 64 + slot] = ok; candi[r * 64 + slot] = (unsigned)sidx; }
        }
      }
      word |= __shfl_xor(word, 32);
      if (h == 0) maskw[kt * 32 + r] = word;
    }
    __syncthreads();
    {
      int row = tid >> 3, j8 = tid & 7;
      unsigned nc = candn[row]; nc = nc < (unsigned)DSA_CAP ? nc : (unsigned)DSA_CAP;
      const unsigned nd = need[row];
      for (unsigned i = j8; i < nc; i += 8) {
        unsigned ki = candk[row * 64 + i], ii = candi[row * 64 + i];
        unsigned rank = 0;
        for (unsigned k = 0; k < nc; ++k) { unsigned kk = candk[row * 64 + k], ik2 = candi[row * 64 + k]; rank += (kk > ki || (kk == ki && ik2 < ii)) ? 1u : 0u; }
        if (rank < nd) atomicOr(&maskw[(ii >> 5) * 32 + row], 1u << (ii & 31u));
      }
    }
  } else {
    unsigned thi = prehi[r], tlo = prelo[r];
    if (lastpass < 3) thi <<= (24 - 8 * lastpass);
    if (lastpass < 4) tlo = 0; else if (lastpass == 4) tlo <<= 4;
    int kt = w;
    bf16x8 n0, n1;
    if (kt < ntile) { const u16* kp = ikc + (size_t)(kt * 32 + r) * 32 + h * 8; n0 = *(const bf16x8*)kp; n1 = *(const bf16x8*)(kp + 16); }
    for (; kt < ntile; kt += 4) {
      bf16x8 kf0 = n0, kf1 = n1;
      if (kt + 4 < ntile) { const u16* kp = ikc + (size_t)((kt + 4) * 32 + r) * 32 + h * 8; n0 = *(const bf16x8*)kp; n1 = *(const bf16x8*)(kp + 16); }
      f32x16 sc;
      dsa_scores(sc, kf0, kf1, h, iqrow, wq);
      unsigned word = 0;
#pragma unroll
      for (int reg = 0; reg < 16; ++reg) {
        const int sidx = kt * 32 + crow(reg, h);
        const unsigned ok = okey_of(sc[reg]);
        const unsigned ri = 4095u - (unsigned)sidx;
        bool sel = (sidx <= tq) && (ok > thi || (ok == thi && ri >= tlo));
        word |= sel ? (1u << crow(reg, h)) : 0u;
      }
      word |= __shfl_xor(word, 32);
      if (h == 0) maskw[kt * 32 + r] = word;
    }
  }
  __syncthreads();
  {
    const int tokbase = b * SEQL + t0;
    auto src = [&](int slot, int rr) { return cols + (size_t)(tokbase + rr) * NC + C_DQ + slot * 64; };
    auto posf = [&](int slot, int rr) { return t0 + rr; };
    stage_q(Qs, src, posf, p.dsa_q_gain + layer * 64, true, true, rope64, 0.125f * 1.44269504f);
  }
  __syncthreads();
  bf16x8 qf[4];
  load_qfrags(qf, Qs, w, r, h);
  AttnAcc acc; attn_init(acc);
  const u16* Kb = (const u16*)(PWS + OFF_DK) + (size_t)b * SEQL * 64;
  const u16* Vtb = (const u16*)(PWS + OFF_DVT) + (size_t)b * 64 * SEQL;
  for (int rep = 0; rep < DBG_ATT_REP; ++rep) { attn_init(acc);
  attn_run(acc, qf, Kb, 64, SEQL - 1, Vtb, SEQL, ntile, [&](int i) { return i; }, [&](int kt) { return maskw[kt * 32 + r]; }, kvs); }
  float lt = acc.l + __shfl_xor(acc.l, 32);
  float inv = lt > 0.f ? 1.f / lt : 0.f;
  u16* mixed = (u16*)(PWS + OFF_H);
  u16* orow = mixed + (size_t)(b * SEQL + t0 + r) * 1024 + 256 + w * 64;
#pragma unroll
  for (int g = 0; g < 4; ++g) {
    float x0[4], x1[4];
#pragma unroll
    for (int i = 0; i < 4; ++i) { x0[i] = acc.o0[4 * g + i] * inv; x1[i] = acc.o1[4 * g + i] * inv; }
    store4bf(orow + 8 * g + 4 * h, x0);
    store4bf(orow + 32 + 8 * g + 4 * h, x1);
  }
}

DI void job_nsa(const Params& p, int layer, int b, int tt, char* smem) {
  const int tid = otid(), lane = tid & 63, w = tid >> 6, r = lane & 31, h = lane >> 5;
  const int t0 = tt * 32;
  const int t = t0 + r;
  u16* cols = (u16*)(PWS + OFF_COLS);
  const u16* cb = cols + (size_t)b * SEQL * NC;
  u16* Qs = (u16*)smem;
  u16* kvs = (u16*)(smem + 18432);
  float* stage = (float*)(smem + 37888);
  float* imp = (float*)(smem + 54272);
  unsigned* selm = (unsigned*)(smem + 62464);
  int* tlist = (int*)(smem + 62720);
  int* nlist = (int*)(smem + 63744);
  const float2* rope64 = (const float2*)(PWS + OFF_ROPE64);
  const float qscale = 0.125f * 1.44269504f;
  const int tokbase = b * SEQL + t0;
  auto src = [&](int slot, int rr) { return cols + (size_t)(tokbase + rr) * NC + C_NQ + slot * 64; };
  auto posf = [&](int slot, int rr) { return t0 + rr; };

  stage_q(Qs, src, posf, p.nsa_q_gain + layer * 64, true, false, rope64, qscale);
  __syncthreads();
  bf16x8 qf[4];
  load_qfrags(qf, Qs, w, r, h);
  const u16* Kc_g = (const u16*)(PWS + OFF_KCMP) + (size_t)b * 256 * 64;
  const u16* Vc_g = (const u16*)(PWS + OFF_VCMPT) + (size_t)b * 64 * 256;
  const int jmax = t >= 31 ? ((t - 31) >> 4) : -1;
  const int ntc = ((2 * tt) >> 5) + 1;
  AttnAcc ac; attn_init(ac);
  attn_run(ac, qf, Kc_g, 64, 255, Vc_g, 256, ntc, [&](int i) { return i; }, [&](int kt) { return lowmask(jmax + 1 - kt * 32); }, kvs);
  float lt = ac.l + __shfl_xor(ac.l, 32);
  float inv_c = lt > 0.f ? 1.f / lt : 0.f;
  float mb_c = (ac.m == -INFINITY) ? 0.f : ac.m;
  for (int i = tid; i < 64 * 32; i += 256) imp[i] = 0.f;
  if (tid < 64) selm[tid] = 0;
  {
    const int krow = tid >> 3, kseg = tid & 7;
    u32x4 rk = *(const u32x4*)(Kc_g + (size_t)krow * 64 + kseg * 8);
    __syncthreads();
    *(u32x4*)(kvs + krow * 72 + kseg * 8) = rk;
    __syncthreads();
    for (int kt = 0; kt < ntc; ++kt) {
      const u16* Kc = kvs + (kt & 1) * KV_BUF;
      if (kt + 1 < ntc) rk = *(const u32x4*)(Kc_g + (size_t)((kt + 1) * 32 + krow) * 64 + kseg * 8);
      f32x16 s = zero16();
#pragma unroll
      for (int ks = 0; ks < 4; ++ks) { bf16x8 kf = *(const bf16x8*)(Kc + r * 72 + ks * 16 + h * 8); s = MFMA_BF(kf, qf[ks], s); }
      unsigned mw = lowmask(jmax + 1 - kt * 32);
#pragma unroll
      for (int reg = 0; reg < 16; ++reg) {
        bool bit = (mw >> crow(reg, h)) & 1u;
        float pv = bit ? __builtin_amdgcn_exp2f(s[reg] - mb_c) * inv_c : 0.f;
        stage[w * 1024 + crow(reg, h) * 32 + r] = pv;
      }
      if (kt + 1 < ntc) *(u32x4*)(kvs + ((kt + 1) & 1) * KV_BUF + krow * 72 + kseg * 8) = rk;
      __syncthreads();
      int tq = tid & 31, ng = tid >> 5, n = kt * 8 + ng;
      float ps[4];
#pragma unroll
      for (int i = 0; i < 4; ++i) { int j = 4 * ng + i; ps[i] = ((stage[j * 32 + tq] + stage[1024 + j * 32 + tq]) + stage[2048 + j * 32 + tq]) + stage[3072 + j * 32 + tq]; }
      imp[n * 32 + tq] += ((ps[0] + ps[1]) + ps[2]) + ps[3];
      __syncthreads();
      if (n + 1 < 64) imp[(n + 1) * 32 + tq] += ps[3];
    }
  }
  __syncthreads();
  {
    int tq = tid & 31, sub = tid >> 5;
    int cur = (t0 + tq) >> 6;
    float v[8];
#pragma unroll
    for (int k = 0; k < 8; ++k) {
      int n = sub * 8 + k;
      bool forced = (n == 0) || (n == cur) || (n == cur - 1);
      float val = forced ? INFINITY : (n > cur ? -INFINITY : imp[n * 32 + tq]);
      v[k] = val;
    }
    __syncthreads();
#pragma unroll
    for (int k = 0; k < 8; ++k) imp[(sub * 8 + k) * 32 + tq] = v[k];
    __syncthreads();
    int rank[8];
#pragma unroll
    for (int k = 0; k < 8; ++k) rank[k] = 0;
    for (int n2 = 0; n2 < 64; ++n2) {
      float v2 = imp[n2 * 32 + tq];
#pragma unroll
      for (int k = 0; k < 8; ++k) { int n = sub * 8 + k; rank[k] += (v2 > v[k] || (v2 == v[k] && n2 < n)) ? 1 : 0; }
    }
    unsigned bits = 0;
#pragma unroll
    for (int k = 0; k < 8; ++k) if (rank[k] < 16) bits |= 1u << ((sub * 8 + k) & 31);
    if (bits) atomicOr(&selm[tq * 2 + (sub >> 2)], bits);
  }
  __syncthreads();
  if (tid == 0) {
    unsigned lo = 0, hi = 0;
    for (int i = 0; i < 32; ++i) { lo |= selm[2 * i]; hi |= selm[2 * i + 1]; }
    int cnt = 0;
    for (int n = 0; n < 64; ++n) {
      bool on = n < 32 ? ((lo >> n) & 1u) : ((hi >> (n - 32)) & 1u);
      if (on) { if (2 * n <= tt) tlist[cnt++] = 2 * n; if (2 * n + 1 <= tt) tlist[cnt++] = 2 * n + 1; }
    }
    nlist[0] = cnt;
  }
  const u16* grow = cb + (size_t)t * NC + C_GATES;
  float g0 = sigmoidf_(bf2f(grow[w])), g1 = sigmoidf_(bf2f(grow[4 + w])), g2 = sigmoidf_(bf2f(grow[8 + w]));
  f32x16 out0, out1;
#pragma unroll
  for (int reg = 0; reg < 16; ++reg) { out0[reg] = g0 * inv_c * ac.o0[reg]; out1[reg] = g0 * inv_c * ac.o1[reg]; }
  __syncthreads();
  stage_q(Qs, src, posf, p.nsa_q_gain + layer * 64, true, true, rope64, qscale);
  __syncthreads();
  load_qfrags(qf, Qs, w, r, h);
  const unsigned mylo = selm[2 * r], myhi = selm[2 * r + 1];
  const int nsl = nlist[0];
  {
    AttnAcc as; attn_init(as);
    const u16* Kb = cb + C_KS;
    const u16* Vtb = (const u16*)(PWS + OFF_VST) + (size_t)b * 64 * SEQL;
    for (int rep = 0; rep < DBG_SLC_REP; ++rep) { attn_init(as);
    attn_run(as, qf, Kb, NC, SEQL - 1, Vtb, SEQL, nsl, [&](int i) { return tlist[i]; },
             [&](int kt) { int n = kt >> 1; bool sel = n < 32 ? ((mylo >> n) & 1u) : ((myhi >> (n - 32)) & 1u); return sel ? lowmask(t - kt * 32 + 1) : 0u; }, kvs); }
    float l2 = as.l + __shfl_xor(as.l, 32);
    float inv = l2 > 0.f ? 1.f / l2 : 0.f;
#pragma unroll
    for (int reg = 0; reg < 16; ++reg) { out0[reg] += g1 * inv * as.o0[reg]; out1[reg] += g1 * inv * as.o1[reg]; }
  }
  {
    AttnAcc aw; attn_init(aw);
    const u16* Kb = cb + C_KW;
    const u16* Vtb = (const u16*)(PWS + OFF_VWT) + (size_t)b * 64 * SEQL;
    const int klo = tt - 16 > 0 ? tt - 16 : 0;
    for (int rep = 0; rep < DBG_SWA_REP; ++rep) { attn_init(aw);
    attn_run(aw, qf, Kb, NC, SEQL - 1, Vtb, SEQL, tt - klo + 1, [&](int i) { return klo + i; },
             [&](int kt) { int lo = t - 511 - kt * 32; unsigned lm = lo <= 0 ? 0xffffffffu : (lo >= 32 ? 0u : (0xffffffffu << lo)); return lowmask(t - kt * 32 + 1) & lm; }, kvs); }
    float l2 = aw.l + __shfl_xor(aw.l, 32);
    float inv = l2 > 0.f ? 1.f / l2 : 0.f;
#pragma unroll
    for (int reg = 0; reg < 16; ++reg) { out0[reg] += g2 * inv * aw.o0[reg]; out1[reg] += g2 * inv * aw.o1[reg]; }
  }
  u16* mixed = (u16*)(PWS + OFF_H);
  u16* orow = mixed + (size_t)(b * SEQL + t) * 1024 + 512 + w * 64;
#pragma unroll
  for (int g = 0; g < 4; ++g) {
    float x0[4], x1[4];
#pragma unroll
    for (int i = 0; i < 4; ++i) { x0[i] = out0[4 * g + i]; x1[i] = out1[4 * g + i]; }
    store4bf(orow + 8 * g + 4 * h, x0);
    store4bf(orow + 32 + 8 * g + 4 * h, x1);
  }
}

DI void job_xattn(const Params& p, int layer, int b, int hd, int tq, char* smem) {
  const int tid = otid(), lane = tid & 63, w = tid >> 6, r = lane & 31, h = lane >> 5;
  u16* Qs = (u16*)smem;
  u16* kvs = (u16*)(smem + 18432);
  const u16* xq = (const u16*)(PWS + OFF_XQ);
  const int tokbase = b * SEQL + tq * 128;
  auto src = [&](int slot, int rr) { return xq + (size_t)(tokbase + slot * 32 + rr) * 256 + hd * 64; };
  auto posf = [&](int slot, int rr) { return 0; };
  stage_q(Qs, src, posf, p.xa_q_gain + layer * 64, true, false, (const float2*)nullptr, 0.125f * 1.44269504f);
  __syncthreads();
  bf16x8 qf[4];
  load_qfrags(qf, Qs, w, r, h);
  const u16* Kb = (const u16*)(PWS + OFF_MEMKV) + ((size_t)(layer * 4 + b) * 256) * 512 + hd * 64;
  const u16* Vtb = (const u16*)(PWS + OFF_MEMVT) + ((size_t)(layer * 4 + b) * 256 + hd * 64) * 256;
  AttnAcc a; attn_init(a);
  attn_run(a, qf, Kb, 512, 255, Vtb, 256, 8, [&](int i) { return i; }, [&](int kt) { return 0xffffffffu; }, kvs);
  float lt = a.l + __shfl_xor(a.l, 32);
  float inv = 1.f / lt;
  u16* xo = (u16*)(PWS + OFF_XO);
  u16* orow = xo + (size_t)(tokbase + w * 32 + r) * 256 + hd * 64;
#pragma unroll
  for (int g = 0; g < 4; ++g) {
    float x0[4], x1[4];
#pragma unroll
    for (int i = 0; i < 4; ++i) { x0[i] = a.o0[4 * g + i] * inv; x1[i] = a.o1[4 * g + i] * inv; }
    store4bf(orow + 8 * g + 4 * h, x0);
    store4bf(orow + 32 + 8 * g + 4 * h, x1);
  }
}

DI void job_prep(const Params& p, int layer, int job, char* smem) {
  const int tid = otid();
  const int tok0 = job * 32;
  const int b = tok0 >> 12, pos0 = tok0 & 4095;
  u16* cols = (u16*)(PWS + OFF_COLS);
  const float2* rope64 = (const float2*)(PWS + OFF_ROPE64);
  const float2* rope32 = (const float2*)(PWS + OFF_ROPE32);
  float* ckvn = (float*)smem;
  float* kpre = ckvn + 32 * 128;
  float* vbuf = kpre + 32 * 64;
  for (int it = 0; it < 4; ++it) {
    int row = it * 16 + (tid >> 4), lg = tid & 15;
    int tk = row >> 1, which = row & 1;
    u16* ptr = cols + (size_t)(tok0 + tk) * NC + (which ? C_KW : C_KS) + lg * 4;
    float x[4]; load4bf(ptr, x);
    rowop<64>(x, lg, p.nsa_k_gains + layer * 192 + (which ? 128 : 64), true, true, pos0 + tk, rope64);
    store4bf(ptr, x);
  }
  for (int it = 0; it < 8; ++it) {
    int row = it * 32 + (tid >> 3), lg = tid & 7;
    int tk = row >> 3, hh = row & 7;
    u16* ptr = cols + (size_t)(tok0 + tk) * NC + C_IQ + hh * 32 + lg * 4;
    float x[4]; load4bf(ptr, x);
    rowop<32>(x, lg, nullptr, false, true, pos0 + tk, rope32);
    store4bf(ptr, x);
  }
  {
    int tk = tid >> 3, lg = tid & 7;
    u16* ptr = cols + (size_t)(tok0 + tk) * NC + C_IK + lg * 4;
    float x[4]; load4bf(ptr, x);
    rowop<32>(x, lg, p.dsa_idxk_gain + layer * 32, true, true, pos0 + tk, rope32);
    store4bf((u16*)(PWS + OFF_IKC) + (size_t)(tok0 + tk) * 32 + lg * 4, x);
  }
  u16* ckvb = (u16*)smem;
  for (int it = 0; it < 4; ++it) {
    int tk = it * 8 + (tid >> 5), lg = tid & 31;
    float x[4]; load4bf(cols + (size_t)(tok0 + tk) * NC + C_CKV + lg * 4, x);
    rowop<128>(x, lg, p.dsa_kv_gain + layer * 128, true, false, 0, rope64);
    store4bf(ckvb + tk * 136 + lg * 4, x);
  }
  __syncthreads();
  {
    const int lane = tid & 63, w = tid >> 6, r = lane & 31, h = lane >> 5;
    const u16* wt = (const u16*)(PWS + OFF_WUKV) + (size_t)layer * 128 * 128 + (size_t)(w * 32 + r) * 128;
    f32x16 acc = zero16();
#pragma unroll
    for (int s2 = 0; s2 < 8; ++s2) {
      bf16x8 af = *(const bf16x8*)(ckvb + r * 136 + s2 * 16 + h * 8);
      bf16x8 bfr = *(const bf16x8*)(wt + s2 * 16 + h * 8);
      acc = MFMA_BF(af, bfr, acc);
    }
#pragma unroll
    for (int reg = 0; reg < 16; ++reg) {
      int tk = crow(reg, h), n = w * 32 + r;
      if (n < 64) kpre[tk * 64 + n] = acc[reg]; else vbuf[tk * 65 + (n - 64)] = acc[reg];
    }
  }
  __syncthreads();
  u16* DK = (u16*)(PWS + OFF_DK);
  for (int it = 0; it < 2; ++it) {
    int tk = it * 16 + (tid >> 4), lg = tid & 15;
    float x[4];
#pragma unroll
    for (int i = 0; i < 4; ++i) x[i] = kpre[tk * 64 + lg * 4 + i];
    rowop<64>(x, lg, p.dsa_k_gain + layer * 64, true, true, pos0 + tk, rope64);
    store4bf(DK + (size_t)(tok0 + tk) * 64 + lg * 4, x);
  }
  for (int which = 0; which < 3; ++which) {
    if (which > 0) {
      __syncthreads();
      for (int i = 0; i < 8; ++i) { int e = tid + 256 * i; int tk = e >> 6, d = e & 63; vbuf[tk * 65 + d] = bf2f(cols[(size_t)(tok0 + tk) * NC + (which == 1 ? C_VS : C_VW) + d]); }
      __syncthreads();
    }
    u16* dst = (u16*)(PWS + (which == 0 ? OFF_DVT : (which == 1 ? OFF_VST : OFF_VWT)));
    int d = tid & 63, q = tid >> 6;
    uint4 o;
    o.x = pack2(vbuf[(q * 8 + 0) * 65 + d], vbuf[(q * 8 + 1) * 65 + d]);
    o.y = pack2(vbuf[(q * 8 + 2) * 65 + d], vbuf[(q * 8 + 3) * 65 + d]);
    o.z = pack2(vbuf[(q * 8 + 4) * 65 + d], vbuf[(q * 8 + 5) * 65 + d]);
    o.w = pack2(vbuf[(q * 8 + 6) * 65 + d], vbuf[(q * 8 + 7) * 65 + d]);
    *(uint4*)(dst + ((size_t)(b * 64 + d)) * SEQL + pos0 + q * 8) = o;
  }
}

DI void job_memkv_post(const Params& p, int job, char* smem) {
  const int tid = otid();
  const int l = job >> 5, row0 = (job & 31) * 32;
  u16* kv = (u16*)(PWS + OFF_MEMKV) + (size_t)l * 1024 * 512;
  u16* vt = (u16*)(PWS + OFF_MEMVT) + (size_t)l * 4 * 256 * 256;
  float* vbuf = (float*)smem;
  for (int it = 0; it < 8; ++it) {
    int row = it * 16 + (tid >> 4), lg = tid & 15;
    int rr = row >> 2, hd = row & 3;
    u16* ptr = kv + (size_t)(row0 + rr) * 512 + hd * 64 + lg * 4;
    float x[4]; load4bf(ptr, x);
    rowop<64>(x, lg, p.xa_k_gain + l * 64, true, false, 0, (const float2*)nullptr);
    store4bf(ptr, x);
  }
  for (int i = 0; i < 32; ++i) { int e = tid + 256 * i; int rr = e >> 8, c = e & 255; vbuf[rr * 257 + c] = bf2f(kv[(size_t)(row0 + rr) * 512 + 256 + c]); }
  __syncthreads();
  {
    int b = row0 >> 8, m0 = row0 & 255;
    int c = tid;
    for (int q = 0; q < 4; ++q) {
      uint4 o;
      o.x = pack2(vbuf[(q * 8 + 0) * 257 + c], vbuf[(q * 8 + 1) * 257 + c]);
      o.y = pack2(vbuf[(q * 8 + 2) * 257 + c], vbuf[(q * 8 + 3) * 257 + c]);
      o.z = pack2(vbuf[(q * 8 + 4) * 257 + c], vbuf[(q * 8 + 5) * 257 + c]);
      o.w = pack2(vbuf[(q * 8 + 6) * 257 + c], vbuf[(q * 8 + 7) * 257 + c]);
      *(uint4*)(vt + ((size_t)(b * 256 + c)) * 256 + m0 + q * 8) = o;
    }
  }
}

DI void job_cmp2(const Params& p, int layer, int job, char* smem) {
  const int tid = otid();
  const int rl = tid >> 5, nq = (tid >> 4) & 1, lg = tid & 15;
  const int gr0 = job * 8;
  const int gr = gr0 + rl;
  const int b = gr >> 8, j = gr & 255;
  const u16* hid = (const u16*)(PWS + OFF_HID);
  float* hs = (float*)smem;
  float* part = hs + 8 * 512;
  float* vb = part + 8 * 16 * 8;
  for (int i = 0; i < 2; ++i) {
    int c = tid + 256 * i; int row = c >> 6, seg = c & 63;
    int g2 = gr0 + row; int b2 = g2 >> 8, j2 = g2 & 255;
    float x[8];
    if (j2 < 255) ld8bf(hid + (size_t)(b2 * 255 + j2) * 512 + seg * 8, x);
    else { for (int k = 0; k < 8; ++k) x[k] = 0.f; }
#pragma unroll
    for (int k = 0; k < 8; ++k) hs[row * 512 + seg * 8 + k] = x[k];
  }
  __syncthreads();
  float ak[4] = {0.f, 0.f, 0.f, 0.f}, av[4] = {0.f, 0.f, 0.f, 0.f};
  {
    const float* w2k = p.nsa_k_w2 + (size_t)layer * 256 * 64 + lg * 4;
    const float* w2v = p.nsa_v_w2 + (size_t)layer * 256 * 64 + lg * 4;
    const float* hr = hs + rl * 512;
#pragma unroll 8
    for (int n = nq * 128; n < nq * 128 + 128; ++n) {
      float hk = hr[n], hv = hr[256 + n];
      float4 wk = *(const float4*)(w2k + n * 64), wv = *(const float4*)(w2v + n * 64);
      ak[0] = fmaf(hk, wk.x, ak[0]); ak[1] = fmaf(hk, wk.y, ak[1]); ak[2] = fmaf(hk, wk.z, ak[2]); ak[3] = fmaf(hk, wk.w, ak[3]);
      av[0] = fmaf(hv, wv.x, av[0]); av[1] = fmaf(hv, wv.y, av[1]); av[2] = fmaf(hv, wv.z, av[2]); av[3] = fmaf(hv, wv.w, av[3]);
    }
  }
  if (nq == 1) {
#pragma unroll
    for (int i = 0; i < 4; ++i) { part[(rl * 16 + lg) * 8 + i] = ak[i]; part[(rl * 16 + lg) * 8 + 4 + i] = av[i]; }
  }
  __syncthreads();
  if (nq == 0) {
#pragma unroll
    for (int i = 0; i < 4; ++i) { ak[i] += part[(rl * 16 + lg) * 8 + i]; av[i] += part[(rl * 16 + lg) * 8 + 4 + i]; }
  }
  rowop<64>(ak, lg, p.nsa_k_gains + layer * 192, true, false, 0, (const float2*)nullptr);
  if (nq == 0) {
    store4bf((u16*)(PWS + OFF_KCMP) + (size_t)gr * 64 + lg * 4, ak);
#pragma unroll
    for (int i = 0; i < 4; ++i) vb[rl * 65 + lg * 4 + i] = av[i];
  }
  __syncthreads();
  if (tid < 64) {
    int d = tid;
    uint4 o;
    o.x = pack2(vb[0 * 65 + d], vb[1 * 65 + d]);
    o.y = pack2(vb[2 * 65 + d], vb[3 * 65 + d]);
    o.z = pack2(vb[4 * 65 + d], vb[5 * 65 + d]);
    o.w = pack2(vb[6 * 65 + d], vb[7 * 65 + d]);
    int bb = gr0 >> 8, jb = gr0 & 255;
    *(uint4*)((u16*)(PWS + OFF_VCMPT) + ((size_t)(bb * 64 + d)) * 256 + jb) = o;
  }
}

DI float lb_of(const Params& p, int layer, int c) {
  if (layer == 0) return 0.f;
  float p0 = p.lb_param[c], p1 = p.lb_param[256 + c];
  return 1.f / (1.f + expf(p0 - p1));
}
DI void mm32(f32x16& acc, const float* Ap, int asi, int ask, const float* Bp, int bsk, int bsj, int r, int h) {
#pragma unroll 8
  for (int k = 0; k < 64; k += 2) {
    float a = Ap[r * asi + (k + h) * ask];
    float b = Bp[(k + h) * bsk + r * bsj];
    acc = MFMA_F32(a, b, acc);
  }
}
template <bool SILU_GATE>
DI void finish_rows(const float* ob, const float* gain, const u16* cols, int gate_col, u16* mixed, int mix_col, int tb, int hd) {
  const int tid = otid(), lg = tid & 15;
  for (int it = 0; it < 4; ++it) {
    int t = it * 16 + (tid >> 4);
    float x[4];
#pragma unroll
    for (int i = 0; i < 4; ++i) x[i] = ob[t * 65 + lg * 4 + i];
    rowop<64>(x, lg, gain, true, false, 0, (const float2*)nullptr);
    float g[4]; load4bf(cols + (size_t)(tb + t) * NC + gate_col + hd * 64 + lg * 4, g);
#pragma unroll
    for (int i = 0; i < 4; ++i) x[i] *= SILU_GATE ? siluf_(g[i]) : sigmoidf_(g[i]);
    store4bf(mixed + (size_t)(tb + t) * 1024 + mix_col + hd * 64 + lg * 4, x);
  }
}

DI void conv8(const u16* cols, const float (&cw)[4][8], const float (&cbias)[8], int tok, int pos, int coloff, float (&out)[8]) {
#pragma unroll
  for (int k = 0; k < 8; ++k) out[k] = cbias[k];
#pragma unroll
  for (int j = 0; j < 4; ++j) {
    int dp = j - 3;
    if (pos + dp >= 0) {
      float x[8]; ld8bf(cols + (size_t)(tok + dp) * NC + coloff, x);
#pragma unroll
      for (int k = 0; k < 8; ++k) out[k] = fmaf(cw[j][k], x[k], out[k]);
    }
  }
#pragma unroll
  for (int k = 0; k < 8; ++k) out[k] = siluf_(out[k]);
}
DI void load_convw(const Params& p, int layer, int ch0, float (&cw)[4][8], float (&cbias)[8]) {
  const float* w = p.ml_conv_w + (size_t)layer * 4 * 512 + ch0;
#pragma unroll
  for (int j = 0; j < 4; ++j) {
    float4 a = *(const float4*)(w + j * 512), b2 = *(const float4*)(w + j * 512 + 4);
    cw[j][0] = a.x; cw[j][1] = a.y; cw[j][2] = a.z; cw[j][3] = a.w; cw[j][4] = b2.x; cw[j][5] = b2.y; cw[j][6] = b2.z; cw[j][7] = b2.w;
  }
  const float* bb = p.ml_conv_b + layer * 512 + ch0;
  float4 a = *(const float4*)bb, b2 = *(const float4*)(bb + 4);
  cbias[0] = a.x; cbias[1] = a.y; cbias[2] = a.z; cbias[3] = a.w; cbias[4] = b2.x; cbias[5] = b2.y; cbias[6] = b2.z; cbias[7] = b2.w;
}
DI void load_state(float* dst, const float* src, int tid) {
#pragma unroll
  for (int i = 0; i < 4; ++i) { int e4 = tid + 256 * i; int row = e4 >> 4, c4 = (e4 & 15) * 4; float4 v = *(const float4*)(src + row * 64 + c4);
    dst[row * 65 + c4] = v.x; dst[row * 65 + c4 + 1] = v.y; dst[row * 65 + c4 + 2] = v.z; dst[row * 65 + c4 + 3] = v.w; }
}

DI void job_hg_A(const Params& p, int layer, int cid, char* smem) {
  const int tid = otid(), lane = tid & 63, w = tid >> 6, r = lane & 31, h = lane >> 5;
  const int bh = cid >> 6, c = cid & 63, b = bh >> 2, hd = bh & 3;
  const int tb = b * SEQL + c * 64;
  const u16* cols = (const u16*)(PWS + OFF_COLS);
  float* B0 = (float*)smem; float* B1 = B0 + 64 * 65; float* B2 = B1 + 64 * 65;
  {
    const int seg = tid & 7;
    float lbv[8];
#pragma unroll
    for (int k = 0; k < 8; ++k) lbv[k] = lb_of(p, layer, hd * 64 + seg * 8 + k);
#pragma unroll
    for (int i = 0; i < 2; ++i) {
      int s = (tid >> 3) + 32 * i;
      const u16* row = cols + (size_t)(tb + s) * NC + hd * 64 + seg * 8;
      float f[8], iv[8]; ld8bf(row + C_HGF, f); ld8bf(row + C_HGI, iv);
#pragma unroll
      for (int k = 0; k < 8; ++k) {
        float fg = lbv[k] + (1.f - lbv[k]) * sigmoidf_(f[k]);
        B0[s * 65 + seg * 8 + k] = logf(fg); B1[s * 65 + seg * 8 + k] = 1.f - fg; B2[s * 65 + seg * 8 + k] = iv[k];
      }
    }
  }
  __syncthreads();
  if (tid < 64) { float run = 0.f; for (int s = 0; s < 64; ++s) { run += B0[s * 65 + tid]; B0[s * 65 + tid] = run; } }
  __syncthreads();
  for (int e = tid; e < 4096; e += 256) { int s = e >> 6, kd = e & 63; B1[s * 65 + kd] *= expf(B0[63 * 65 + kd] - B0[s * 65 + kd]); }
  __syncthreads();
  const int ih = w >> 1, jh = w & 1;
  f32x16 acc = zero16();
  mm32(acc, B1 + ih * 32, 1, 65, B2 + jh * 32, 65, 1, r, h);
  float* st = (float*)(PWS + OFF_HGST) + (size_t)cid * 4096;
#pragma unroll
  for (int reg = 0; reg < 16; ++reg) st[(ih * 32 + crow(reg, h)) * 64 + jh * 32 + r] = acc[reg];
  if (tid < 64) ((float*)(PWS + OFF_HGD))[cid * 64 + tid] = expf(B0[63 * 65 + tid]);
}

DI void job_hg_scan(const Params& p, int job) {
  const int bh = job >> 4, e = (job & 15) * 256 + otid();
  float* st = (float*)(PWS + OFF_HGST);
  const float* dv = (const float*)(PWS + OFF_HGD);
  float S = 0.f;
  for (int c0 = 0; c0 < 64; c0 += 16) {
    float U[16], D[16];
#pragma unroll
    for (int i = 0; i < 16; ++i) { U[i] = st[(size_t)(bh * 64 + c0 + i) * 4096 + e]; D[i] = dv[(bh * 64 + c0 + i) * 64 + (e >> 6)]; }
#pragma unroll
    for (int i = 0; i < 16; ++i) { st[(size_t)(bh * 64 + c0 + i) * 4096 + e] = S; S = D[i] * S + U[i]; }
  }
}

DI void job_hg_C(const Params& p, int layer, int cid, char* smem) {
  const int tid = otid(), lane = tid & 63, w = tid >> 6, r = lane & 31, h = lane >> 5;
  const int bh = cid >> 6, c = cid & 63, b = bh >> 2, hd = bh & 3;
  const int tb = b * SEQL + c * 64;
  const u16* cols = (const u16*)(PWS + OFF_COLS);
  float* B0 = (float*)smem; float* B1 = B0 + 64 * 65; float* B2 = B1 + 64 * 65; float* B3 = B2 + 64 * 65;
  {
    const int seg = tid & 7;
    float lbv[8];
#pragma unroll
    for (int k = 0; k < 8; ++k) lbv[k] = lb_of(p, layer, hd * 64 + seg * 8 + k);
#pragma unroll
    for (int i = 0; i < 2; ++i) {
      int s = (tid >> 3) + 32 * i;
      const u16* row = cols + (size_t)(tb + s) * NC + hd * 64 + seg * 8;
      float f[8], iv[8], qr[8]; ld8bf(row + C_HGF, f); ld8bf(row + C_HGI, iv); ld8bf(row + C_HGQ, qr);
#pragma unroll
      for (int k = 0; k < 8; ++k) {
        float fg = lbv[k] + (1.f - lbv[k]) * sigmoidf_(f[k]);
        B0[s * 65 + seg * 8 + k] = logf(fg); B2[s * 65 + seg * 8 + k] = 1.f - fg;
        B1[s * 65 + seg * 8 + k] = siluf_(qr[k]) * 0.125f; B3[s * 65 + seg * 8 + k] = iv[k];
      }
    }
  }
  __syncthreads();
  if (tid < 64) { float run = 0.f; for (int s = 0; s < 64; ++s) { run += B0[s * 65 + tid]; B0[s * 65 + tid] = run; } }
  __syncthreads();
  for (int e = tid; e < 4096; e += 256) {
    int s = e >> 6, kd = e & 63;
    float bref = B0[31 * 65 + kd], bc = B0[s * 65 + kd];
    B1[s * 65 + kd] *= expf(bc - bref);
    B2[s * 65 + kd] *= expf(bref - bc);
  }
  __syncthreads();
  const int th = w >> 1, sh = w & 1;
  f32x16 at = zero16();
  if (!(th == 0 && sh == 1)) mm32(at, B1 + th * 32 * 65, 65, 1, B2 + sh * 32 * 65, 1, 65, r, h);
  __syncthreads();
  for (int e = tid; e < 4096; e += 256) { int s = e >> 6, kd = e & 63; B2[s * 65 + kd] = B1[s * 65 + kd] * expf(B0[31 * 65 + kd]); }
  __syncthreads();
#pragma unroll
  for (int reg = 0; reg < 16; ++reg) {
    int t = th * 32 + crow(reg, h), s = sh * 32 + r;
    B1[t * 65 + s] = (s <= t) ? at[reg] : 0.f;
  }
  load_state(B0, (const float*)(PWS + OFF_HGST) + (size_t)cid * 4096, tid);
  __syncthreads();
  const int vh = w & 1;
  f32x16 o = zero16();
  mm32(o, B2 + th * 32 * 65, 65, 1, B0 + vh * 32, 65, 1, r, h);
  mm32(o, B1 + th * 32 * 65, 65, 1, B3 + vh * 32, 65, 1, r, h);
  __syncthreads();
#pragma unroll
  for (int reg = 0; reg < 16; ++reg) B2[(th * 32 + crow(reg, h)) * 65 + vh * 32 + r] = o[reg];
  __syncthreads();
  finish_rows<true>(B2, p.hg_o_gain + layer * 64, cols, C_HGG, (u16*)(PWS + OFF_H), 0, tb, hd);
}

DI float conv_silu(const Params& p, int layer, const u16* cols, int tok, int pos, int ch) {
  const float* cw = p.ml_conv_w + (size_t)layer * 4 * 512;
  float a = p.ml_conv_b[layer * 512 + ch];
#pragma unroll
  for (int j = 0; j < 4; ++j) {
    int dp = j - 3;
    float xv = (pos + dp >= 0) ? bf2f(cols[(size_t)(tok + dp) * NC + C_MQ + ch]) : 0.f;
    a = fmaf(cw[j * 512 + ch], xv, a);
  }
  return siluf_(a);
}
DI float logsigmoidf_(float x) { return fminf(x, 0.f) - log1pf(expf(-fabsf(x))); }
DI float scan_add(float v, int lane) { for (int o = 1; o < 64; o <<= 1) { float u = __shfl_up(v, o); if (lane >= o) v += u; } return v; }
DI float scan_max(float v, int lane) { for (int o = 1; o < 64; o <<= 1) { float u = __shfl_up(v, o); if (lane >= o) v = fmaxf(v, u); } return v; }

DI void job_ml_A(const Params& p, int layer, int cid, char* smem) {
  const int tid = otid(), lane = tid & 63, w = tid >> 6, r = lane & 31, h = lane >> 5;
  const int bh = cid >> 6, c = cid & 63, b = bh >> 2, hd = bh & 3;
  const int tb = b * SEQL + c * 64;
  const u16* cols = (const u16*)(PWS + OFF_COLS);
  float* B1 = (float*)smem; float* B2 = B1 + 64 * 65; float* wsv = B2 + 64 * 65;
  float* mlsc = (float*)(PWS + OFF_MLSC);
  if (w == 0) {
    const u16* row = cols + (size_t)(tb + lane) * NC;
    float fgv = bf2f(row[C_FG + hd]) + p.ml_f_bias[layer * 4 + hd];
    float igv = bf2f(row[C_IG + hd]) + p.ml_i_bias[layer * 4 + hd];
    float lf = logsigmoidf_(fgv);
    float bc = scan_add(lf, lane);
    float blast = __shfl(bc, 63);
    float lw = blast - bc + igv;
    float Mc = wave_max(lw);
    wsv[lane] = expf(lw - Mc);
    if (lane == 0) { mlsc[cid] = Mc; mlsc[1024 + cid] = blast; }
  }
  {
    const int seg = tid & 7;
    float cw[4][8], cbias[8];
    load_convw(p, layer, 256 + hd * 64 + seg * 8, cw, cbias);
#pragma unroll
    for (int i = 0; i < 2; ++i) {
      int s = (tid >> 3) + 32 * i;
      float kv[8], vv[8];
      conv8(cols, cw, cbias, tb + s, c * 64 + s, C_MK + hd * 64 + seg * 8, kv);
      ld8bf(cols + (size_t)(tb + s) * NC + C_MV + hd * 64 + seg * 8, vv);
#pragma unroll
      for (int k = 0; k < 8; ++k) { B1[s * 65 + seg * 8 + k] = kv[k] * 0.125f; B2[s * 65 + seg * 8 + k] = vv[k]; }
    }
  }
  __syncthreads();
  for (int e = tid; e < 4096; e += 256) { int s = e >> 6, d = e & 63; B1[s * 65 + d] *= wsv[s]; }
  __syncthreads();
  const int ih = w >> 1, jh = w & 1;
  f32x16 acc = zero16();
  mm32(acc, B1 + ih * 32, 1, 65, B2 + jh * 32, 65, 1, r, h);
  float* st = (float*)(PWS + OFF_MLST) + (size_t)cid * 4096;
#pragma unroll
  for (int reg = 0; reg < 16; ++reg) st[(ih * 32 + crow(reg, h)) * 64 + jh * 32 + r] = acc[reg];
  if (tid < 64) { float sacc = 0.f; for (int s = 0; s < 64; ++s) sacc += B1[s * 65 + tid]; ((float*)(PWS + OFF_MLN))[cid * 64 + tid] = sacc; }
}

DI void job_ml_scan(const Params& p, int job) {
  const int bh = job >> 4, sl = job & 15, tid = otid(), e = sl * 256 + tid;
  float* st = (float*)(PWS + OFF_MLST);
  float* nv = (float*)(PWS + OFF_MLN);
  float* mlsc = (float*)(PWS + OFF_MLSC);
  float S = 0.f, nS = 0.f, m = -1e30f;
  const bool don = (sl == 0 && tid < 64);
  for (int c0 = 0; c0 < 64; c0 += 16) {
    float U[16], Mc[16], Bl[16], Nu[16];
#pragma unroll
    for (int i = 0; i < 16; ++i) {
      int cid = bh * 64 + c0 + i;
      U[i] = st[(size_t)cid * 4096 + e]; Mc[i] = mlsc[cid]; Bl[i] = mlsc[1024 + cid];
      Nu[i] = don ? nv[cid * 64 + tid] : 0.f;
    }
#pragma unroll
    for (int i = 0; i < 16; ++i) {
      int cid = bh * 64 + c0 + i;
      float mnew = fmaxf(Bl[i] + m, Mc[i]);
      float dec = expf(Bl[i] + m - mnew), us = expf(Mc[i] - mnew);
      st[(size_t)cid * 4096 + e] = S;
      S = dec * S + us * U[i];
      if (don) { nv[cid * 64 + tid] = nS; nS = dec * nS + us * Nu[i]; }
      if (sl == 0 && tid == 0) mlsc[2048 + cid] = m;
      m = mnew;
    }
  }
}

DI void job_ml_C(const Params& p, int layer, int cid, char* smem) {
  const int tid = otid(), lane = tid & 63, w = tid >> 6, r = lane & 31, h = lane >> 5;
  const int bh = cid >> 6, c = cid & 63, b = bh >> 2, hd = bh & 3;
  const int tb = b * SEQL + c * 64;
  const u16* cols = (const u16*)(PWS + OFF_COLS);
  float* B0 = (float*)smem; float* B1 = B0 + 64 * 65; float* B2 = B1 + 64 * 65; float* B3 = B2 + 64 * 65;
  float* s_bc = B3 + 64 * 65; float* s_as = s_bc + 64; float* s_mt = s_as + 64; float* s_wi = s_mt + 64; float* s_nv = s_wi + 64; float* s_den = s_nv + 64;
  const float* mlsc = (const float*)(PWS + OFF_MLSC);
  if (w == 0) {
    const u16* row = cols + (size_t)(tb + lane) * NC;
    float fgv = bf2f(row[C_FG + hd]) + p.ml_f_bias[layer * 4 + hd];
    float igv = bf2f(row[C_IG + hd]) + p.ml_i_bias[layer * 4 + hd];
    float lf = logsigmoidf_(fgv);
    float bc = scan_add(lf, lane);
    float as = igv - bc;
    float pm = scan_max(as, lane);
    float m = mlsc[2048 + cid];
    float inter = bc + m;
    float mt = fmaxf(inter, bc + pm);
    s_bc[lane] = bc; s_as[lane] = as; s_mt[lane] = mt; s_wi[lane] = expf(inter - mt);
    s_nv[lane] = ((const float*)(PWS + OFF_MLN))[cid * 64 + lane];
  }
  {
    const int seg = tid & 7;
    {
      float cw[4][8], cbias[8];
      load_convw(p, layer, hd * 64 + seg * 8, cw, cbias);
#pragma unroll
      for (int i = 0; i < 2; ++i) {
        int s = (tid >> 3) + 32 * i;
        float qv[8];
        conv8(cols, cw, cbias, tb + s, c * 64 + s, C_MQ + hd * 64 + seg * 8, qv);
#pragma unroll
        for (int k = 0; k < 8; ++k) B0[s * 65 + seg * 8 + k] = qv[k];
      }
    }
    {
      float cw[4][8], cbias[8];
      load_convw(p, layer, 256 + hd * 64 + seg * 8, cw, cbias);
#pragma unroll
      for (int i = 0; i < 2; ++i) {
        int s = (tid >> 3) + 32 * i;
        float kv[8], vv[8];
        conv8(cols, cw, cbias, tb + s, c * 64 + s, C_MK + hd * 64 + seg * 8, kv);
        ld8bf(cols + (size_t)(tb + s) * NC + C_MV + hd * 64 + seg * 8, vv);
#pragma unroll
        for (int k = 0; k < 8; ++k) { B1[s * 65 + seg * 8 + k] = kv[k] * 0.125f; B2[s * 65 + seg * 8 + k] = vv[k]; }
      }
    }
    load_state(B3, (const float*)(PWS + OFF_MLST) + (size_t)cid * 4096, tid);
  }
  __syncthreads();
  const int th = w >> 1, sh = w & 1;
  f32x16 qk = zero16();
  if (!(th == 0 && sh == 1)) mm32(qk, B0 + th * 32 * 65, 65, 1, B1 + sh * 32 * 65, 1, 65, r, h);
  __syncthreads();
#pragma unroll
  for (int reg = 0; reg < 16; ++reg) {
    int t = th * 32 + crow(reg, h), s = sh * 32 + r;
    float dm = (s <= t) ? expf(s_bc[t] + s_as[s] - s_mt[t]) : 0.f;
    B1[t * 65 + s] = qk[reg] * dm;
  }
  for (int e = tid; e < 4096; e += 256) { int t = e >> 6, d = e & 63; B0[t * 65 + d] *= s_wi[t]; }
  __syncthreads();
  const int vh = w & 1;
  f32x16 o = zero16();
  mm32(o, B0 + th * 32 * 65, 65, 1, B3 + vh * 32, 65, 1, r, h);
  mm32(o, B1 + th * 32 * 65, 65, 1, B2 + vh * 32, 65, 1, r, h);
  if (tid < 64) {
    float dsum = 0.f;
    for (int d = 0; d < 64; ++d) dsum = fmaf(B0[tid * 65 + d], s_nv[d], dsum);
    float ssum = 0.f;
    for (int s = 0; s < 64; ++s) ssum += B1[tid * 65 + s];
    s_den[tid] = dsum + ssum;
  }
  __syncthreads();
#pragma unroll
  for (int reg = 0; reg < 16; ++reg) {
    int t = th * 32 + crow(reg, h);
    float dn = fmaxf(fabsf(s_den[t]), expf(-s_mt[t]));
    B3[t * 65 + vh * 32 + r] = o[reg] / dn;
  }
  __syncthreads();
  finish_rows<false>(B3, p.ml_o_gain + layer * 64, cols, C_MOG, (u16*)(PWS + OFF_H), 768, tb, hd);
}


#define XB_TMO      128
#define XB_XCNT(j)  (256  + 64 * (j))
#define XB_XSUB(j)  (1280 + 64 * (j))
#define XB_XGEN(j)  (2304 + 64 * (j))
#define XB_TOP      3328
#define XB_TOPGEN   3392
#define XCD_BAR_WORDS 3456
#define XB_SPIN_CAP (1u << 20)
#define LAS __attribute__((address_space(3)))
DI unsigned xb_ld(unsigned* p) { return __hip_atomic_load(p, __ATOMIC_RELAXED, __HIP_MEMORY_SCOPE_AGENT); }
DI unsigned xb_add(unsigned* p, unsigned v) { return __hip_atomic_fetch_add(p, v, __ATOMIC_RELAXED, __HIP_MEMORY_SCOPE_AGENT); }
DI unsigned xb_xcc_id() { return (unsigned)__builtin_amdgcn_s_getreg((3 << 11) | 20) & 0xFu; }
#define XB_SPIN(cond, bar) do { unsigned _sp = 0; while (cond) { __builtin_amdgcn_s_sleep(1); \
    if ((++_sp & 255u) == 0u) { if (xb_ld(&(bar)[XB_TMO])) break; if (_sp > XB_SPIN_CAP) { atomicAdd(&(bar)[XB_TMO], 1u); break; } } } } while (0)
struct XcdBarrier { unsigned* bar; unsigned x; volatile LAS unsigned* st; };
DI XcdBarrier xcd_barrier_post(unsigned* bar, volatile LAS unsigned* st) {
  XcdBarrier b; b.bar = bar; b.x = xb_xcc_id(); b.st = st;
  if (__builtin_amdgcn_workitem_id_x() == 0) (void)xb_add(&bar[XB_XCNT(b.x)], 1u);
  return b;
}
DI void xcd_barrier_complete(unsigned* bar, unsigned x, unsigned& nloc, unsigned& nx) {
  const unsigned G = gridDim.x * gridDim.y * gridDim.z;
  unsigned sum, cnt, mine, sp = 0u;
  for (;;) {
    sum = 0u; cnt = 0u; mine = 0u;
#pragma unroll
    for (unsigned j = 0; j < 16; ++j) { const unsigned c = xb_ld(&bar[XB_XCNT(j)]); sum += c; cnt += (c > 0u) ? 1u : 0u; mine = (j == x) ? c : mine; }
    if (sum == G) break;
    __builtin_amdgcn_s_sleep(1);
    if ((++sp & 255u) == 0u) { if (xb_ld(&bar[XB_TMO])) break; if (sp > XB_SPIN_CAP) { atomicAdd(&bar[XB_TMO], 1u); break; } }
  }
  nloc = mine > 0u ? mine : 1u; nx = cnt > 0u ? cnt : 1u;
}
DI void xcd_barrier(const XcdBarrier& b) {
  asm volatile("s_waitcnt vmcnt(0)" ::: "memory");
  __syncthreads();
  if (__builtin_amdgcn_workitem_id_x() == 0) {
    unsigned* bar = b.bar;
    __builtin_amdgcn_s_waitcnt(0);
    unsigned nloc = b.st[0], nx = b.st[1];
    if (nloc == 0u) { xcd_barrier_complete(bar, b.x, nloc, nx); b.st[0] = nloc; b.st[1] = nx; }
    const unsigned old = xb_add(&bar[XB_XSUB(b.x)], 1u);
    const unsigned gen = old / nloc;
    if (old + 1u == (gen + 1u) * nloc) {
      __builtin_amdgcn_fence(__ATOMIC_RELEASE, "agent");
      asm volatile("s_waitcnt vmcnt(0)" ::: "memory");
      const unsigned og = xb_add(&bar[XB_TOP], 1u);
      const unsigned tg = og / nx;
      if (og + 1u == (tg + 1u) * nx) xb_add(&bar[XB_TOPGEN], 1u);
      else XB_SPIN(xb_ld(&bar[XB_TOPGEN]) == tg, bar);
      __builtin_amdgcn_fence(__ATOMIC_ACQUIRE, "agent");
      xb_add(&bar[XB_XGEN(b.x)], 1u);
      asm volatile("s_waitcnt vmcnt(0)" ::: "memory");
    } else {
      XB_SPIN(xb_ld(&bar[XB_XGEN(b.x)]) == gen, bar);
      __builtin_amdgcn_fence(__ATOMIC_ACQUIRE, "agent");
      asm volatile("s_waitcnt vmcnt(0)" ::: "memory");
    }
  }
  __syncthreads();
}

DI int next_job(int* ctr, int* s_job) {
  __syncthreads();
  if (otid() == 0) *s_job = atomicAdd(ctr, 1);
  __syncthreads();
  return *s_job;
}

struct ConvDesc { const float* src; int K, Nsrc, Ndst, mode; size_t dst; };

__global__ void __launch_bounds__(256, 2) fwd_megakernel(Params p) {
  p.x = asg(p.x);
  p.mem = asg(p.mem);
  p.lb_param = asg(p.lb_param);
  p.norm_mix = asg(p.norm_mix);
  p.w_in = asg(p.w_in);
  p.w_out = asg(p.w_out);
  p.hg_o_gain = asg(p.hg_o_gain);
  p.dsa_kv_gain = asg(p.dsa_kv_gain);
  p.dsa_w_uk = asg(p.dsa_w_uk);
  p.dsa_w_uv = asg(p.dsa_w_uv);
  p.dsa_q_gain = asg(p.dsa_q_gain);
  p.dsa_k_gain = asg(p.dsa_k_gain);
  p.dsa_idxk_gain = asg(p.dsa_idxk_gain);
  p.nsa_pos_k = asg(p.nsa_pos_k);
  p.nsa_pos_v = asg(p.nsa_pos_v);
  p.nsa_k_w1 = asg(p.nsa_k_w1);
  p.nsa_k_w2 = asg(p.nsa_k_w2);
  p.nsa_v_w1 = asg(p.nsa_v_w1);
  p.nsa_v_w2 = asg(p.nsa_v_w2);
  p.nsa_q_gain = asg(p.nsa_q_gain);
  p.nsa_k_gains = asg(p.nsa_k_gains);
  p.ml_conv_w = asg(p.ml_conv_w);
  p.ml_conv_b = asg(p.ml_conv_b);
  p.ml_i_bias = asg(p.ml_i_bias);
  p.ml_f_bias = asg(p.ml_f_bias);
  p.ml_o_gain = asg(p.ml_o_gain);
  p.norm_xa = asg(p.norm_xa);
  p.norm_mem = asg(p.norm_mem);
  p.xa_wq = asg(p.xa_wq);
  p.xa_wkv = asg(p.xa_wkv);
  p.xa_wo = asg(p.xa_wo);
  p.xa_q_gain = asg(p.xa_q_gain);
  p.xa_k_gain = asg(p.xa_k_gain);
  p.norm_ffn = asg(p.norm_ffn);
  p.ffn_w13 = asg(p.ffn_w13);
  p.ffn_w2 = asg(p.ffn_w2);
  p.out = asg(p.out);
  cg::grid_group grid = cg::this_grid();
  __shared__ __attribute__((aligned(16))) char smem[SMEM_BYTES];
  int* s_job = (int*)(smem + SMEM_BYTES - 16);
  volatile LAS unsigned* xst = (volatile LAS unsigned*)(smem + SMEM_BYTES - 32);
  if (otid() == 0) { xst[0] = 0u; xst[1] = 0u; }
  __syncthreads();
  XcdBarrier xb = xcd_barrier_post((unsigned*)(p.ws + OFF_BAR), xst);
  int* ctr0 = (int*)(PWS + OFF_CTR);
  u16* WB = (u16*)(PWS + OFF_WB);
  u16* cols = (u16*)(PWS + OFF_COLS);
  u16* Hb = (u16*)(PWS + OFF_H);
  const int tid = otid();

  for (int ph2 = 0; ph2 < 2 * NPHASE; ++ph2) {
    const int ph = ph2 >> 1;
    const int layer = ph == 0 ? 0 : (ph - 1) / 14;
    const int kind = ph == 0 ? -1 : (ph - 1) % 14;
    if ((ph2 & 1) && DBG_REP == 99) { xcd_barrier(xb); continue; }
    if ((ph2 & 1) && kind != DBG_REP) continue;
    int* ctr = ctr0 + ((ph2 & 1) ? 32 : 0);
    const int sub = (ph2 & 1) ? DBG_SUB : 15;
    const u16* WL = WB + (size_t)layer * W_LAYER;
    int j;
    if (ph == 0) {
      const int NBIAS = 64, NUKV = 2, NROPE = 192, NMEM = 128, NCONV = 3744 * 2, NX = 1024;
      const int total = NBIAS + NUKV + NROPE + NMEM + NCONV + NX;
      while ((j = next_job(&ctr[ph], s_job)) < total) {
        if (j < NBIAS) {
          int l = j >> 5, kv = (j >> 4) & 1, ng = j & 15;
          const float* pe = (kv ? p.nsa_pos_v : p.nsa_pos_k) + (size_t)l * 2048;
          const float* w1 = (kv ? p.nsa_v_w1 : p.nsa_k_w1) + (size_t)l * 2048 * 256;
          int nl = tid & 15, kp = tid >> 4;
          float a = 0.f;
#pragma unroll 8
          for (int k = kp * 128; k < kp * 128 + 128; ++k) a = fmaf(pe[k], w1[(size_t)k * 256 + ng * 16 + nl], a);
          float* red = (float*)smem;
          red[kp * 16 + nl] = a;
          __syncthreads();
          if (tid < 16) {
            float t = 0.f;
            for (int q = 0; q < 16; ++q) t += red[q * 16 + tid];
            ((float*)(PWS + OFF_BIAS1))[(l * 2 + kv) * 256 + ng * 16 + tid] = t;
          }
        } else if ((j -= NBIAS) < NUKV) {
          u16* wt = (u16*)(PWS + OFF_WUKV) + (size_t)j * 128 * 128;
          const float* uk = p.dsa_w_uk + (size_t)j * 128 * 64;
          const float* uv = p.dsa_w_uv + (size_t)j * 128 * 64;
          for (int e = tid; e < 128 * 128; e += 256) { int n = e >> 7, k = e & 127; wt[e] = f2bf(n < 64 ? uk[k * 64 + n] : uv[k * 64 + (n - 64)]); }
        } else if ((j -= NUKV) < NROPE) {
          int e = j * 256 + tid;
          int pos = e / 12, f = e % 12;
          float inv = f < 8 ? exp2f(-(float)f * (18.931568569324174f / 8.f)) : exp2f(-(float)(f - 8) * (18.931568569324174f / 4.f));
          float angf = (float)pos * inv;
          double ang = (double)angf;
          double k = rint(ang * 0.15915494309189535);
          float rr = (float)(ang - k * 6.283185307179586);
          float2 cs = make_float2(cosf(rr), sinf(rr));
          if (f < 8) ((float2*)(PWS + OFF_ROPE64))[pos * 8 + f] = cs; else ((float2*)(PWS + OFF_ROPE32))[pos * 4 + (f - 8)] = cs;
        } else if ((j -= NROPE) < NMEM) {
          int l = j >> 6, row0 = (j & 63) * 16;
          job_rmsnorm(p.mem, p.norm_mem + l * 1024, (u16*)(PWS + OFF_MEMH) + (size_t)l * 1024 * 1024, nullptr, row0);
        } else if ((j -= NMEM) < NCONV) {
          int l = j / 3744, q = j % 3744;
          const float* src; int K, Nsrc, mode, ntn; size_t dst;
          if (q < 864) { src = p.w_in + (size_t)l * 1024 * IN_COLS; K = 1024; Nsrc = IN_COLS; mode = 1; dst = WO_IN; ntn = 54; }
          else if ((q -= 864) < 256) { src = p.w_out + (size_t)l * 1024 * 1024; K = 1024; Nsrc = 1024; mode = 0; dst = WO_OUT; ntn = 16; }
          else if ((q -= 256) < 64) { src = p.xa_wq + (size_t)l * 1024 * 256; K = 1024; Nsrc = 256; mode = 0; dst = WO_Q; ntn = 4; }
          else if ((q -= 64) < 128) { src = p.xa_wkv + (size_t)l * 1024 * 512; K = 1024; Nsrc = 512; mode = 0; dst = WO_KV; ntn = 8; }
          else if ((q -= 128) < 64) { src = p.xa_wo + (size_t)l * 256 * 1024; K = 256; Nsrc = 1024; mode = 0; dst = WO_O; ntn = 16; }
          else if ((q -= 64) < 1408) { src = p.ffn_w13 + (size_t)l * 1024 * 5632; K = 1024; Nsrc = 5632; mode = 2; dst = WO_13; ntn = 88; }
          else if ((q -= 1408) < 704) { src = p.ffn_w2 + (size_t)l * 2816 * 1024; K = 2816; Nsrc = 1024; mode = 0; dst = WO_2; ntn = 16; }
          else if ((q -= 704) < 128) { src = p.nsa_k_w1 + (size_t)l * 2048 * 256; K = 2048; Nsrc = 256; mode = 0; dst = WO_KW1; ntn = 4; }
          else { q -= 128; src = p.nsa_v_w1 + (size_t)l * 2048 * 256; K = 2048; Nsrc = 256; mode = 0; dst = WO_VW1; ntn = 4; }
          job_convert(src, K, Nsrc, WB + (size_t)l * W_LAYER + dst, mode, q % ntn, q / ntn, (float*)smem);
        } else {
          j -= NCONV;
          job_rmsnorm(p.x, p.norm_mix, Hb, p.out, j * 16);
        }
      }
    } else if (kind == 0) {
      const int NG = 128 * 27, NM = layer == 0 ? 2 * 8 * 4 : 0;
      while ((j = next_job(&ctr[ph], s_job)) < NG + NM) {
        if (j < NG) gemm_tile<0, 0>(Hb, 1024, WL + WO_IN, 1024, j / 27, j % 27, smem, cols, NC, nullptr, 0);
        else { int q = j - NG; int l = q >> 5, tm = (q >> 2) & 7, tn = q & 3;
          gemm_tile<0, 0>((const u16*)(PWS + OFF_MEMH) + (size_t)l * 1024 * 1024, 1024, WB + (size_t)l * W_LAYER + WO_KV, 1024, tm, tn, smem,
                          (u16*)(PWS + OFF_MEMKV) + (size_t)l * 1024 * 512, 512, nullptr, 0); }
      }
    } else if (kind == 1) {
      const int NP = 512, NM = layer == 0 ? 64 : 0;
      while ((j = next_job(&ctr[ph], s_job)) < NP + NM) {
        if (j < NP) job_prep(p, layer, j, smem); else job_memkv_post(p, j - NP, smem);
      }
    } else if (kind == 2) {
      const int ND = 512, NCG = 32, NML = 1024, NHG = 1024;
      while ((j = next_job(&ctr[ph], s_job)) < ND + NCG + NML + NHG) {
        if (j < ND) { if (sub & 1) job_dsa(p, layer, j & 3, 127 - (j >> 2), smem); }
        else if ((j -= ND) < NCG) { if (sub & 2) {
          int kv = j >> 4, tm = (j >> 1) & 7, tn = j & 1;
          gemm_tile<3, 1>(cols, 0, WL + (kv ? WO_VW1 : WO_KW1), 2048, tm, tn, smem, (u16*)(PWS + OFF_HID) + kv * 256, 512,
                          (const float*)(PWS + OFF_BIAS1) + (layer * 2 + kv) * 256, kv ? C_VC : C_KC); }
        } else if ((j -= NCG) < NML) { if (sub & 4) job_ml_A(p, layer, j, smem); }
        else { if (sub & 8) job_hg_A(p, layer, j - NML, smem); }
      }
    } else if (kind == 3) {
      const int NS = 256, NC2 = 128;
      while ((j = next_job(&ctr[ph], s_job)) < 2 * NS + NC2) {
        if (j < NS) job_ml_scan(p, j); else if (j < 2 * NS) job_hg_scan(p, j - NS); else job_cmp2(p, layer, j - 2 * NS, smem);
      }
    } else if (kind == 4) {
      const int NN = 512, NML = 1024, NHG = 1024;
      while ((j = next_job(&ctr[ph], s_job)) < NN + NML + NHG) {
        if (j < NN) { if (sub & 1) job_nsa(p, layer, j & 3, 127 - (j >> 2), smem); }
        else if ((j -= NN) < NML) { if (sub & 2) job_ml_C(p, layer, j, smem); }
        else { if (sub & 4) job_hg_C(p, layer, j - NML, smem); }
      }
    } else if (kind == 5) {
      if (!(DBG_SKIP & 1)) while ((j = next_job(&ctr[ph], s_job)) < 128 * 8) gemm_tile<1, 0>(Hb, 1024, WL + WO_OUT, 1024, j >> 3, j & 7, smem, p.out, 1024, nullptr, 0, DBG_MK0, DBG_MK1);
    } else if (kind == 6 || kind == 10 || kind == 13) {
      if (kind == 13 && layer == 1) {   }
      else {
        const float* g = kind == 6 ? p.norm_xa + layer * 1024 : (kind == 10 ? p.norm_ffn + layer * 1024 : p.norm_mix + (layer + 1) * 1024);
        while ((j = next_job(&ctr[ph], s_job)) < 1024) job_rmsnorm(p.out, g, Hb, nullptr, j * 16);
      }
    } else if (kind == 7) {
      while ((j = next_job(&ctr[ph], s_job)) < 128 * 2) gemm_tile<0, 0>(Hb, 1024, WL + WO_Q, 1024, j >> 1, j & 1, smem, (u16*)(PWS + OFF_XQ), 256, nullptr, 0);
    } else if (kind == 8) {
      while ((j = next_job(&ctr[ph], s_job)) < 512) job_xattn(p, layer, j >> 7, (j >> 5) & 3, j & 31, smem);
    } else if (kind == 9) {
      if (!(DBG_SKIP & 2)) while ((j = next_job(&ctr[ph], s_job)) < 128 * 8) gemm_tile<1, 0>((const u16*)(PWS + OFF_XO), 256, WL + WO_O, 256, j >> 3, j & 7, smem, p.out, 1024, nullptr, 0);
    } else if (kind == 11) {
      while ((j = next_job(&ctr[ph], s_job)) < 128 * 44) gemm_tile<2, 0>(Hb, 1024, WL + WO_13, 1024, j / 44, j % 44, smem, (u16*)(PWS + OFF_G), DFF, nullptr, 0);
    } else if (kind == 12) {
      if (!(DBG_SKIP & 4)) while ((j = next_job(&ctr[ph], s_job)) < 128 * 8) gemm_tile<1, 0>((const u16*)(PWS + OFF_G), DFF, WL + WO_2, DFF, j >> 3, j & 7, smem, p.out, 1024, nullptr, 0);
    }
    if (ph2 + 1 < 2 * NPHASE) { if (p.use_cg) grid.sync(); else xcd_barrier(xb); }
  }
}

extern "C" void kernel_launch(void* const* d_in, const int* in_sizes, int n_in, void* d_out, int out_size, void* d_ws, size_t ws_size,
                              hipStream_t stream) {
  static int grid_blocks = 0;
  if (!grid_blocks) {
    int dev = 0, cus = 0, per_cu = 0;
    hipGetDevice(&dev);
    hipDeviceGetAttribute(&cus, hipDeviceAttributeMultiprocessorCount, dev);
    hipOccupancyMaxActiveBlocksPerMultiprocessor(&per_cu, fwd_megakernel, 256, 0);
    if (per_cu > 2) per_cu = 2;
    if (per_cu < 1) per_cu = 1;
    grid_blocks = cus * per_cu;
  }
  Params p{};
  const float** pp = (const float**)&p;
  for (int i = 0; i < 36; ++i) pp[i] = (const float*)d_in[i];
  p.out = (float*)d_out;
  p.ws = (char*)d_ws;
  p.use_cg = 0; p.pad_ = 0;
  hipMemsetAsync(d_ws, 0, 4096 + 16384, stream);
  void* args[] = {&p};
  hipError_t e = hipLaunchCooperativeKernel((void*)fwd_megakernel, dim3(grid_blocks), dim3(256), args, 0, stream);
  if (e != hipSuccess) fprintf(stderr, "cooperative launch failed: %s (grid %d)\n", hipGetErrorString(e), grid_blocks);
}
```

```cpp
#include <hip/hip_runtime.h>
#include <hip/hip_bf16.h>
#include <hip/hip_cooperative_groups.h>
#include <cstdio>
namespace cg = cooperative_groups;

#define DI __device__ __forceinline__
typedef unsigned short u16;
typedef unsigned long long u64;
typedef __attribute__((ext_vector_type(8))) short bf16x8;
typedef __attribute__((ext_vector_type(4))) short s16x4;
typedef __attribute__((ext_vector_type(16))) float f32x16;
typedef __attribute__((ext_vector_type(2))) float f32x2;
typedef __attribute__((ext_vector_type(4))) unsigned u32x4;
typedef __attribute__((ext_vector_type(2))) __bf16 bf16x2v;

constexpr int T_TOK = 16384, SEQL = 4096, NBATCH = 4, DM = 1024;
constexpr int NC = 3456;
constexpr int C_HGQ = 0, C_HGF = 256, C_HGI = 512, C_HGG = 768;
constexpr int C_DQ = 1024, C_CKV = 1280, C_IQ = 1408;
constexpr int C_NQ = 1664, C_KC = 1920, C_VC = 1984, C_KS = 2048, C_VS = 2112, C_KW = 2176, C_VW = 2240;
constexpr int C_MQ = 2304, C_MK = 2560, C_MV = 2816, C_MOG = 3072;
constexpr int C_IK = 3328, C_IW = 3360, C_GATES = 3368, C_IG = 3380, C_FG = 3384;
constexpr int IN_COLS = 3388, DFF = 2816;

constexpr size_t WO_IN = 0;
constexpr size_t WO_OUT = WO_IN + (size_t)NC * 1024;
constexpr size_t WO_Q = WO_OUT + 1024 * 1024;
constexpr size_t WO_KV = WO_Q + 256 * 1024;
constexpr size_t WO_O = WO_KV + 512 * 1024;
constexpr size_t WO_13 = WO_O + 1024 * 256;
constexpr size_t WO_2 = WO_13 + (size_t)5632 * 1024;
constexpr size_t WO_KW1 = WO_2 + (size_t)1024 * 2816;
constexpr size_t WO_VW1 = WO_KW1 + 256 * 2048;
constexpr size_t W_LAYER = WO_VW1 + 256 * 2048;

constexpr size_t al256(size_t x) { return (x + 255) & ~(size_t)255; }
constexpr size_t OFF_CTR = 0;
constexpr size_t OFF_BAR = 4096;
constexpr size_t OFF_ROPE64 = 4096 + 16384;
constexpr size_t OFF_ROPE32 = OFF_ROPE64 + 4096 * 8 * 8;
constexpr size_t OFF_BIAS1 = OFF_ROPE32 + 4096 * 4 * 8;
constexpr size_t OFF_WB = al256(OFF_BIAS1 + 4096);
constexpr size_t OFF_COLS = al256(OFF_WB + 2 * W_LAYER * 2);
constexpr size_t OFF_H = al256(OFF_COLS + (size_t)T_TOK * NC * 2);
constexpr size_t OFF_HGST = al256(OFF_H + (size_t)T_TOK * 1024 * 2);
constexpr size_t OFF_MLST = al256(OFF_HGST + (size_t)1024 * 4096 * 4);
constexpr size_t OFF_HGD = al256(OFF_MLST + (size_t)1024 * 4096 * 4);
constexpr size_t OFF_MLN = al256(OFF_HGD + 1024 * 64 * 4);
constexpr size_t OFF_MLSC = al256(OFF_MLN + 1024 * 64 * 4);
constexpr size_t OFF_DK = al256(OFF_MLSC + 3 * 1024 * 4);
constexpr size_t OFF_DVT = al256(OFF_DK + (size_t)T_TOK * 64 * 2);
constexpr size_t OFF_VST = al256(OFF_DVT + (size_t)T_TOK * 64 * 2);
constexpr size_t OFF_VWT = al256(OFF_VST + (size_t)T_TOK * 64 * 2);
constexpr size_t OFF_KCMP = al256(OFF_VWT + (size_t)T_TOK * 64 * 2);
constexpr size_t OFF_VCMPT = al256(OFF_KCMP + 4 * 256 * 64 * 2);
constexpr size_t OFF_HID = al256(OFF_VCMPT + 4 * 256 * 64 * 2);
constexpr size_t OFF_MEMH = al256(OFF_HID + 1024 * 512 * 2);
constexpr size_t OFF_MEMKV = al256(OFF_MEMH + 2 * 1024 * 1024 * 2);
constexpr size_t OFF_MEMVT = al256(OFF_MEMKV + 2 * 1024 * 512 * 2);
constexpr size_t OFF_IKC = al256(OFF_MEMVT + 2 * 4 * 256 * 256 * 2);
constexpr size_t OFF_WUKV = al256(OFF_IKC + (size_t)T_TOK * 32 * 2);
constexpr size_t OFF_KSC = al256(OFF_WUKV + 2 * 128 * 128 * 2);
constexpr size_t OFF_KWC = al256(OFF_KSC + (size_t)T_TOK * 64 * 2);
constexpr size_t OFF_END = al256(OFF_KWC + (size_t)T_TOK * 64 * 2);
static_assert(OFF_END <= (size_t)256 * 1024 * 1024, "workspace overflow");
constexpr size_t OFF_XQ = OFF_HGST;
constexpr size_t OFF_XO = OFF_MLST;
constexpr size_t OFF_G = OFF_COLS;

constexpr int SMEM_BYTES = 75776;
constexpr int NPHASE = 28;
#define DBG_SKIP 0
#define DBG_REP -2
#define DBG_SUB 15
#define DBG_ATT_REP 1
#define DBG_EPI_REP 1
#define DBG_SELREP 1
#define DBG_SLC_REP 1
#define DBG_SWA_REP 1
#define DBG_MK0 0
#define DBG_MK1 16

struct Params {
  const float* x; const float* mem; const float* lb_param; const float* norm_mix; const float* w_in; const float* w_out;
  const float* hg_o_gain; const float* dsa_kv_gain; const float* dsa_w_uk; const float* dsa_w_uv; const float* dsa_q_gain;
  const float* dsa_k_gain; const float* dsa_idxk_gain; const float* nsa_pos_k; const float* nsa_pos_v; const float* nsa_k_w1;
  const float* nsa_k_w2; const float* nsa_v_w1; const float* nsa_v_w2; const float* nsa_q_gain; const float* nsa_k_gains;
  const float* ml_conv_w; const float* ml_conv_b; const float* ml_i_bias; const float* ml_f_bias; const float* ml_o_gain;
  const float* norm_xa; const float* norm_mem; const float* xa_wq; const float* xa_wkv; const float* xa_wo; const float* xa_q_gain;
  const float* xa_k_gain; const float* norm_ffn; const float* ffn_w13; const float* ffn_w2;
  float* out; char* ws;
  int use_cg; int pad_;
};

DI int otid() { int t = __builtin_amdgcn_workitem_id_x(); asm volatile("" : "+v"(t)); return t; }
typedef __attribute__((address_space(1))) char gchar_t;
DI char* oq(char* x) { gchar_t* g = (gchar_t*)x; asm volatile("" : "+s"(g)); return (char*)g; }
template <class T> DI T* asg(T* q) { return (T*)(__attribute__((address_space(1))) T*)q; }
#define PWS (oq(p.ws))
DI float bf2f(u16 v) { return __uint_as_float(((unsigned)v) << 16); }
DI unsigned pack2(float a, float b) { f32x2 v = {a, b}; return __builtin_bit_cast(unsigned, __builtin_convertvector(v, bf16x2v)); }
DI u16 f2bf(float a) { return (u16)(pack2(a, 0.f) & 0xffffu); }
DI float sigmoidf_(float x) { return 1.f / (1.f + expf(-x)); }
DI float siluf_(float x) { return x / (1.f + expf(-x)); }
DI int crow(int reg, int h) { return (reg & 3) + 8 * (reg >> 2) + 4 * h; }
DI f32x16 zero16() { f32x16 z; for (int i = 0; i < 16; ++i) z[i] = 0.f; return z; }
#define MFMA_BF(a, b, c) __builtin_amdgcn_mfma_f32_32x32x16_bf16((a), (b), (c), 0, 0, 0)
#define MFMA_F32(a, b, c) __builtin_amdgcn_mfma_f32_32x32x2f32((a), (b), (c), 0, 0, 0)
DI float wave_sum(float v) { for (int o = 32; o; o >>= 1) v += __shfl_xor(v, o); return v; }
DI float wave_max(float v) { for (int o = 32; o; o >>= 1) v = fmaxf(v, __shfl_xor(v, o)); return v; }
DI void load4bf(const u16* p, float (&x)[4]) { uint2 v = *(const uint2*)p; x[0] = __uint_as_float(v.x << 16); x[1] = __uint_as_float(v.x & 0xffff0000u); x[2] = __uint_as_float(v.y << 16); x[3] = __uint_as_float(v.y & 0xffff0000u); }
DI void ld8bf(const u16* p, float (&x)[8]) {
  u32x4 v = *(const u32x4*)p;
  x[0] = __uint_as_float(v.x << 16); x[1] = __uint_as_float(v.x & 0xffff0000u);
  x[2] = __uint_as_float(v.y << 16); x[3] = __uint_as_float(v.y & 0xffff0000u);
  x[4] = __uint_as_float(v.z << 16); x[5] = __uint_as_float(v.z & 0xffff0000u);
  x[6] = __uint_as_float(v.w << 16); x[7] = __uint_as_float(v.w & 0xffff0000u);
}
DI void store4bf(u16* p, const float (&x)[4]) { uint2 v; v.x = pack2(x[0], x[1]); v.y = pack2(x[2], x[3]); *(uint2*)p = v; }

template <int W>
DI void rowop(float (&x)[4], int lg, const float* gain, bool do_norm, bool do_rope, int pos, const float2* ropetab) {
  if (do_norm) {
    float ss = x[0] * x[0] + x[1] * x[1] + x[2] * x[2] + x[3] * x[3];
#pragma unroll
    for (int o = W / 8; o >= 1; o >>= 1) ss += __shfl_xor(ss, o);
    float rstd = rsqrtf(ss * (1.f / W) + 1e-6f);
#pragma unroll
    for (int i = 0; i < 4; ++i) x[i] = x[i] * rstd * gain[lg * 4 + i];
  }
  if (do_rope) {
    constexpr int HALF = W / 8, LPH = HALF / 4;
    float xp[4];
#pragma unroll
    for (int i = 0; i < 4; ++i) xp[i] = __shfl_xor(x[i], LPH);
    const float4* tp = (const float4*)(ropetab + pos * HALF + (lg % LPH) * 4);
    const float4 c01 = tp[0], c23 = tp[1];
    const float cs[4] = {c01.x, c01.z, c23.x, c23.z};
    const float sn[4] = {c01.y, c01.w, c23.y, c23.w};
    const bool rot = lg < 2 * LPH;
    const bool isx2 = lg >= LPH;
#pragma unroll
    for (int i = 0; i < 4; ++i) {
      float rv = isx2 ? (x[i] * cs[i] + xp[i] * sn[i]) : (x[i] * cs[i] - xp[i] * sn[i]);
      x[i] = rot ? rv : x[i];
    }
  }
}

DI int map_in(int n) {
  if (n < 1664) return n;
  if (n < 2304) return n + 40;
  if (n < 3328) return n + 52;
  if (n < 3360) return 1664 + (n - 3328);
  if (n < 3368) return 1696 + (n - 3360);
  if (n < 3380) return 2344 + (n - 3368);
  if (n < 3388) return n;
  return -1;
}
DI int map_w13(int n) { int blk = n >> 6, w = n & 63; return w < 32 ? blk * 32 + w : 2816 + blk * 32 + (w - 32); }

DI void job_convert(const float* src, int K, int Nsrc, u16* dst, int mode, int tile_n, int tile_k4, float* sm) {
  const int tid = otid(), tx = tid & 15, ty = tid >> 4;
  int n = tile_n * 64 + tx * 4;
  int sn = mode == 0 ? n : (mode == 1 ? map_in(n) : map_w13(n));
  float4 v[16];
#pragma unroll
  for (int i = 0; i < 16; ++i) {
    int kl = ty + 16 * i;
    v[i] = sn >= 0 ? *(const float4*)(src + (size_t)(tile_k4 * 256 + kl) * Nsrc + sn) : make_float4(0.f, 0.f, 0.f, 0.f);
  }
#pragma unroll
  for (int i = 0; i < 16; ++i) {
    int kl = ty + 16 * i;
    float* t = sm + (kl >> 6) * (64 * 65) + (kl & 63) * 65 + tx * 4;
    t[0] = v[i].x; t[1] = v[i].y; t[2] = v[i].z; t[3] = v[i].w;
  }
  __syncthreads();
  int row = tid >> 2, seg = tid & 3;
#pragma unroll
  for (int q = 0; q < 4; ++q) {
    const float* t = sm + q * (64 * 65);
    unsigned pk[8];
#pragma unroll
    for (int i = 0; i < 8; ++i) pk[i] = pack2(t[(seg * 16 + 2 * i) * 65 + row], t[(seg * 16 + 2 * i + 1) * 65 + row]);
    uint4* d = (uint4*)(dst + (size_t)(tile_n * 64 + row) * K + tile_k4 * 256 + q * 64 + seg * 16);
    d[0] = make_uint4(pk[0], pk[1], pk[2], pk[3]);
    d[1] = make_uint4(pk[4], pk[5], pk[6], pk[7]);
  }
}

DI void job_rmsnorm(const float* X, const float* gain, u16* H, float* copy_out, int row0) {
  const int tid = otid(), lane = tid & 63, w = tid >> 6;
  for (int i = 0; i < 4; ++i) {
    int row = row0 + w * 4 + i;
    const float4* xr = (const float4*)(X + (size_t)row * 1024);
    float4 v[4];
    float ss = 0.f;
#pragma unroll
    for (int j = 0; j < 4; ++j) { v[j] = xr[lane + 64 * j]; ss += v[j].x * v[j].x + v[j].y * v[j].y + v[j].z * v[j].z + v[j].w * v[j].w; }
    ss = wave_sum(ss);
    float rstd = rsqrtf(ss * (1.f / 1024.f) + 1e-6f);
#pragma unroll
    for (int j = 0; j < 4; ++j) {
      float4 g = ((const float4*)gain)[lane + 64 * j];
      uint2 o; o.x = pack2(v[j].x * rstd * g.x, v[j].y * rstd * g.y); o.y = pack2(v[j].z * rstd * g.z, v[j].w * rstd * g.w);
      *(uint2*)(H + (size_t)row * 1024 + (lane + 64 * j) * 4) = o;
      if (copy_out) ((float4*)(copy_out + (size_t)row * 1024))[lane + 64 * j] = v[j];
    }
  }
}

template <int EPI, int AMODE>
DI void gemm_tile(const u16* __restrict__ A, int lda, const u16* __restrict__ Bt, int K, int tm, int tn, char* smem,
                  void* Cp, int ldc, const float* bias, int coff, int kt0 = 0, int kt1 = -1) {
  char* As = smem;
  char* Bs = smem + 32768;
  const int tid = otid(), lane = tid & 63, w = tid >> 6;
  const int r = lane & 31, h = lane >> 5, wm = w >> 1, wn = w & 1;
  const int lr8 = lane >> 3, lc = (lane & 7) ^ lr8;
  const u16* ap[4];
  const u16* bp[4];
#pragma unroll
  for (int q = 0; q < 4; ++q) {
    int rowl = (w * 4 + q) * 8 + lr8;
    int row = tm * 128 + rowl;
    if (AMODE == 0) ap[q] = A + (size_t)row * lda + lc * 8;
    else { int m = row < 1019 ? row : 1019; int b = m / 255, j = m % 255; ap[q] = A + ((size_t)(b * 4096 + 16 * j)) * NC + coff + lc * 8; }
    bp[q] = Bt + (size_t)(tn * 128 + rowl) * K + lc * 8;
  }
  const size_t akstep = AMODE == 0 ? 64 : NC;
  f32x16 acc[2][2];
#pragma unroll
  for (int a = 0; a < 2; ++a)
#pragma unroll
    for (int b = 0; b < 2; ++b) acc[a][b] = zero16();
  const int nk = kt1 < 0 ? K / 64 : kt1;
#define G_ISSUE(BUF, KT) _Pragma("unroll") for (int q = 0; q < 4; ++q) { \
    __builtin_amdgcn_global_load_lds((const unsigned*)(ap[q] + (size_t)(KT) * akstep), (unsigned*)(As + (BUF) * 16384 + (w * 4 + q) * 1024), 16, 0, 0); \
    __builtin_amdgcn_global_load_lds((const unsigned*)(bp[q] + (size_t)(KT) * 64), (unsigned*)(Bs + (BUF) * 16384 + (w * 4 + q) * 1024), 16, 0, 0); }
  const int r7 = r & 7;
  G_ISSUE(0, kt0)
  __syncthreads();
  for (int kt = kt0; kt < nk; ++kt) {
    const int cur = (kt - kt0) & 1;
    if (kt + 1 < nk) { G_ISSUE(cur ^ 1, kt + 1) }
    const char* Ac = As + cur * 16384;
    const char* Bc = Bs + cur * 16384;
#pragma unroll
    for (int s = 0; s < 4; ++s) {
      const int co = ((2 * s + h) ^ r7) * 16;
      bf16x8 af[2], bfr[2];
#pragma unroll
      for (int mt = 0; mt < 2; ++mt) af[mt] = *(const bf16x8*)(Ac + (wm * 64 + mt * 32 + r) * 128 + co);
#pragma unroll
      for (int nt = 0; nt < 2; ++nt) bfr[nt] = *(const bf16x8*)(Bc + (wn * 64 + nt * 32 + r) * 128 + co);
#pragma unroll
      for (int mt = 0; mt < 2; ++mt)
#pragma unroll
        for (int nt = 0; nt < 2; ++nt) acc[mt][nt] = MFMA_BF(af[mt], bfr[nt], acc[mt][nt]);
    }
    __syncthreads();
  }
#undef G_ISSUE
  for (int erep = 0; erep < ((EPI == 0 || EPI == 2) ? DBG_EPI_REP : 1); ++erep)
#pragma unroll
  for (int mt = 0; mt < 2; ++mt) {
#pragma unroll
    for (int reg = 0; reg < 16; ++reg) {
      int row = tm * 128 + wm * 64 + mt * 32 + crow(reg, h);
      if (EPI == 0) {
        u16* C = (u16*)Cp;
#pragma unroll
        for (int nt = 0; nt < 2; ++nt) C[(size_t)row * ldc + tn * 128 + wn * 64 + nt * 32 + r] = f2bf(acc[mt][nt][reg]);
      } else if (EPI == 1) {
        float* C = (float*)Cp;
#pragma unroll
        for (int nt = 0; nt < 2; ++nt) { float* q = C + (size_t)row * ldc + tn * 128 + wn * 64 + nt * 32 + r; *q = *q + acc[mt][nt][reg]; }
      } else if (EPI == 2) {
        u16* C = (u16*)Cp;
        float a = acc[mt][0][reg], b = acc[mt][1][reg];
        C[(size_t)row * ldc + (tn * 2 + wn) * 32 + r] = f2bf(siluf_(a) * b);
      } else {
        u16* C = (u16*)Cp;
        if (row < 1020) {
#pragma unroll
          for (int nt = 0; nt < 2; ++nt) {
            int col = tn * 128 + wn * 64 + nt * 32 + r;
            C[(size_t)row * ldc + coff * 0 + col] = f2bf(fmaxf(acc[mt][nt][reg] + bias[col], 0.f));
          }
        }
      }
    }
  }
}

struct AttnAcc { f32x16 o0, o1; float m, l; };
DI void attn_init(AttnAcc& a) { a.o0 = zero16(); a.o1 = zero16(); a.m = -INFINITY; a.l = 0.f; }

template <class SrcF, class PosF>
DI void stage_q(u16* Qs, SrcF src, PosF posf, const float* gain, bool do_norm, bool do_rope, const float2* rope64, float scale) {
  const int tid = otid(), lg = tid & 15;
#pragma unroll
  for (int it = 0; it < 8; ++it) {
    int row = it * 16 + (tid >> 4);
    int slot = row >> 5, r = row & 31;
    float x[4];
    load4bf(src(slot, r) + lg * 4, x);
    rowop<64>(x, lg, gain, do_norm, do_rope, posf(slot, r), rope64);
#pragma unroll
    for (int i = 0; i < 4; ++i) x[i] *= scale;
    store4bf(Qs + (slot * 32 + r) * 72 + lg * 4, x);
  }
}
DI void load_qfrags(bf16x8 (&qf)[4], const u16* Qs, int slot, int r, int h) {
#pragma unroll
  for (int s = 0; s < 4; ++s) qf[s] = *(const bf16x8*)(Qs + (slot * 32 + r) * 72 + s * 16 + h * 8);
}

constexpr int KV_BUF = 32 * 72 + 64 * 40;

template <class TileF, class MaskF>
DI void attn_run(AttnAcc& a, const bf16x8 (&qf)[4], const u16* Kb, size_t kstride, int kmaxrow, const u16* Vtb, size_t vstride,
                 int ntiles, TileF tile_at, MaskF mask_at, u16* kvs) {
  const int tid = otid(), lane = tid & 63;
  const int r = lane & 31, h = lane >> 5;
  const int krow = tid >> 3, kseg = tid & 7, vrow = tid >> 2, vseg = tid & 3;
  if (ntiles <= 0) return;
  u32x4 rk, rv;
  {
    int kt = tile_at(0);
    int kr = kt * 32 + krow; kr = kr < kmaxrow ? kr : kmaxrow;
    rk = *(const u32x4*)(Kb + (size_t)kr * kstride + kseg * 8);
    rv = *(const u32x4*)(Vtb + (size_t)vrow * vstride + kt * 32 + vseg * 8);
  }
  __syncthreads();
  *(u32x4*)(kvs + krow * 72 + kseg * 8) = rk;
  *(u32x4*)(kvs + 32 * 72 + vrow * 40 + vseg * 8) = rv;
  __syncthreads();
  for (int i = 0; i < ntiles; ++i) {
    const int kt = tile_at(i);
    const int cur = i & 1;
    if (i + 1 < ntiles) {
      int kn = tile_at(i + 1);
      int kr = kn * 32 + krow; kr = kr < kmaxrow ? kr : kmaxrow;
      rk = *(const u32x4*)(Kb + (size_t)kr * kstride + kseg * 8);
      rv = *(const u32x4*)(Vtb + (size_t)vrow * vstride + kn * 32 + vseg * 8);
    }
    const u16* Kc = kvs + cur * KV_BUF;
    const u16* Vc = Kc + 32 * 72;
    f32x16 s = zero16();
#pragma unroll
    for (int ks = 0; ks < 4; ++ks) {
      bf16x8 kf = *(const bf16x8*)(Kc + r * 72 + ks * 16 + h * 8);
      s = MFMA_BF(kf, qf[ks], s);
    }
    unsigned mw = mask_at(kt);
    float mx = -INFINITY;
#pragma unroll
    for (int reg = 0; reg < 16; ++reg) {
      bool bit = (mw >> crow(reg, h)) & 1u;
      s[reg] = bit ? s[reg] : -INFINITY;
      mx = fmaxf(mx, s[reg]);
    }
    mx = fmaxf(mx, __shfl_xor(mx, 32));
    float mnew = fmaxf(a.m, mx);
    float mb = (mnew == -INFINITY) ? 0.f : mnew;
    float alpha = __builtin_amdgcn_exp2f(a.m - mb);
    float psum = 0.f;
#pragma unroll
    for (int reg = 0; reg < 16; ++reg) { float pv = __builtin_amdgcn_exp2f(s[reg] - mb); psum += pv; s[reg] = pv; }
    a.l = a.l * alpha + psum;
    a.m = mnew;
#pragma unroll
    for (int reg = 0; reg < 16; ++reg) { a.o0[reg] *= alpha; a.o1[reg] *= alpha; }
#pragma unroll
    for (int s2 = 0; s2 < 2; ++s2) {
      uint4 pu;
      pu.x = pack2(s[8 * s2 + 0], s[8 * s2 + 1]); pu.y = pack2(s[8 * s2 + 2], s[8 * s2 + 3]);
      pu.z = pack2(s[8 * s2 + 4], s[8 * s2 + 5]); pu.w = pack2(s[8 * s2 + 6], s[8 * s2 + 7]);
      bf16x8 pf = __builtin_bit_cast(bf16x8, pu);
#pragma unroll
      for (int dt = 0; dt < 2; ++dt) {
        uint2 lo = *(const uint2*)(Vc + (dt * 32 + r) * 40 + 16 * s2 + 4 * h);
        uint2 hi = *(const uint2*)(Vc + (dt * 32 + r) * 40 + 16 * s2 + 8 + 4 * h);
        uint4 vu = make_uint4(lo.x, lo.y, hi.x, hi.y);
        bf16x8 vf = __builtin_bit_cast(bf16x8, vu);
        if (dt == 0) a.o0 = MFMA_BF(vf, pf, a.o0); else a.o1 = MFMA_BF(vf, pf, a.o1);
      }
    }
    if (i + 1 < ntiles) {
      u16* Kn = kvs + (cur ^ 1) * KV_BUF;
      *(u32x4*)(Kn + krow * 72 + kseg * 8) = rk;
      *(u32x4*)(Kn + 32 * 72 + vrow * 40 + vseg * 8) = rv;
    }
    __syncthreads();
  }
}

DI unsigned lowmask(int n) { return n <= 0 ? 0u : (n >= 32 ? 0xffffffffu : ((1u << n) - 1u)); }

DI void dsa_scores(f32x16& sc, const bf16x8& kf0, const bf16x8& kf1, int h, const u16* iqrow, const float (&wq)[8]) {
  {
    bf16x8 q0 = *(const bf16x8*)(iqrow + 256 + h * 8);
    bf16x8 q1 = *(const bf16x8*)(iqrow + 256 + 16 + h * 8);
    sc = zero16();
    sc = MFMA_BF(kf0, q0, sc);
    sc = MFMA_BF(kf1, q1, sc);
  }
#pragma unroll
  for (int hh = 0; hh < 8; ++hh) {
    bf16x8 q0 = *(const bf16x8*)(iqrow + hh * 32 + h * 8);
    bf16x8 q1 = *(const bf16x8*)(iqrow + hh * 32 + 16 + h * 8);
    f32x16 a = zero16();
    a = MFMA_BF(kf0, q0, a);
    a = MFMA_BF(kf1, q1, a);
#pragma unroll
    for (int reg = 0; reg < 16; ++reg) sc[reg] = fmaf(wq[hh], __builtin_fabsf(a[reg]), sc[reg]);
    if (hh & 1) __builtin_amdgcn_sched_barrier(0);
  }
}
DI unsigned okey_of(float s) {
  unsigned u = __float_as_uint(s + 0.f);
  return u ^ ((unsigned)((int)u >> 31) | 0x80000000u);
}

template <int MODE>
DI void dsa_hist_tiles(unsigned* hist, const u16* ikc, const u16* iqrow, const float (&wq)[8], int w, int r, int h, int lane, int ntile, int tq,
                       unsigned mhi, unsigned mlo, int shm, int shd, bool last_idx) {
  int kt = w;
  bf16x8 n0, n1;
  if (kt < ntile) { const u16* kp = ikc + (size_t)(kt * 32 + r) * 32 + h * 8; n0 = *(const bf16x8*)kp; n1 = *(const bf16x8*)(kp + 16); }
  for (; kt < ntile; kt += 4) {
    bf16x8 kf0 = n0, kf1 = n1;
    if (kt + 4 < ntile) { const u16* kp = ikc + (size_t)((kt + 4) * 32 + r) * 32 + h * 8; n0 = *(const bf16x8*)kp; n1 = *(const bf16x8*)(kp + 16); }
    f32x16 sc;
    dsa_scores(sc, kf0, kf1, h, iqrow, wq);
#pragma unroll
    for (int reg = 0; reg < 16; ++reg) {
      const int sidx = kt * 32 + crow(reg, h);
      const unsigned ok = okey_of(sc[reg]);
      bool sel = sidx <= tq;
      unsigned digit;
      if (MODE == 0) { digit = ok >> 24; }
      else if (MODE == 1) { sel = sel && ((ok >> shm) == mhi); digit = (ok >> shd) & 255u; }
      else { const unsigned ri = 4095u - (unsigned)sidx; sel = sel && (ok == mhi) && (last_idx ? ((ri >> 4) == mlo) : true); digit = last_idx ? (ri & 15u) : (ri >> 4); }
      const int addr = sel ? (r * 257 + (int)digit) : (32 * 257 + lane);
      atomicAdd(&hist[addr], 1u);
    }
  }
}

constexpr int DSA_CAP = 64;

DI void job_dsa(const Params& p, int layer, int b, int tt, char* smem, int mode) {
  const int tid = otid(), lane = tid & 63, w = tid >> 6, r = lane & 31, h = lane >> 5;
  const int t0 = tt * 32, ntile = tt + 1;
  u16* cols = (u16*)(PWS + OFF_COLS);
  const u16* cb = cols + (size_t)b * SEQL * NC;
  const u16* ikc = (const u16*)(PWS + OFF_IKC) + (size_t)b * SEQL * 32;
  unsigned* hist = (unsigned*)smem;
  unsigned* candk = (unsigned*)smem;
  unsigned* candi = (unsigned*)(smem + 8192);
  unsigned* candn = (unsigned*)(smem + 16384);
  u16* Qs = (u16*)smem;
  u16* kvs = (u16*)(smem + 18432);
  unsigned* maskw = (unsigned*)(smem + 37888);
  unsigned* segs = (unsigned*)(smem + 54272);
  unsigned* prehi = (unsigned*)(smem + 55296);
  unsigned* prelo = (unsigned*)(smem + 55424);
  unsigned* need = (unsigned*)(smem + 55552);
  int* flags = (int*)(smem + 55680);
  const float2* rope64 = (const float2*)(PWS + OFF_ROPE64);

  unsigned* gmask = (unsigned*)((u16*)(PWS + OFF_H) + (size_t)(b * SEQL + t0) * 1024 + 256);
  if (mode == 0) {
  const u16* qrow = cb + (size_t)(t0 + r) * NC;
  u16* iqs = (u16*)(smem + 55808);
  for (int i = 0; i < 4; ++i) {
    int c = tid + 256 * i; int row = c >> 5, seg = c & 31;
    *(u32x4*)(iqs + row * 296 + seg * 8) = *(const u32x4*)(cb + (size_t)(t0 + row) * NC + C_IQ + seg * 8);
  }
  const u16* iqrow = iqs + r * 296;
  float wq[8];
  { float a[4], c[4]; load4bf(qrow + C_IW, a); load4bf(qrow + C_IW + 4, c);
#pragma unroll
    for (int i = 0; i < 4; ++i) { wq[i] = 0.5f * a[i]; wq[4 + i] = 0.5f * c[i]; } }

  if (tid < 32) { prehi[tid] = 0; prelo[tid] = 0; int nd = t0 + tid + 1; need[tid] = nd < 256 ? nd : 256; }
  if (tid < 16) flags[tid] = 0;
  __syncthreads();
  {
    int row = tid >> 3, lg = tid & 7;
    const u16* wr = cb + (size_t)(t0 + row) * NC + C_IW;
    float acc4[4] = {0.f, 0.f, 0.f, 0.f};
#pragma unroll
    for (int hh = 0; hh < 8; ++hh) {
      float wv = 0.5f * bf2f(wr[hh]);
      float x[4]; load4bf(iqs + row * 296 + hh * 32 + lg * 4, x);
#pragma unroll
      for (int i = 0; i < 4; ++i) acc4[i] = fmaf(wv, x[i], acc4[i]);
    }
    store4bf(iqs + row * 296 + 256 + lg * 4, acc4);
  }
  const int tq = t0 + r;
  int lastpass = 0;
  bool fast = false;
  for (int pass = 0; pass < 6; ++pass) {
    for (int i = tid; i < 32 * 257 + 64; i += 256) hist[i] = 0;
    __syncthreads();
    const unsigned mhi = prehi[r], mlo = prelo[r];
    if (pass == 0) dsa_hist_tiles<0>(hist, ikc, iqrow, wq, w, r, h, lane, ntile, tq, mhi, mlo, 0, 0, false);
    else if (pass < 4) dsa_hist_tiles<1>(hist, ikc, iqrow, wq, w, r, h, lane, ntile, tq, mhi, mlo, 32 - 8 * pass, 24 - 8 * pass, false);
    else dsa_hist_tiles<2>(hist, ikc, iqrow, wq, w, r, h, lane, ntile, tq, mhi, mlo, 0, 0, pass == 5);
    __syncthreads();
    {
      int row = tid >> 3, part = tid & 7;
      unsigned sum = 0;
      for (int i = 0; i < 32; ++i) sum += hist[row * 257 + part * 32 + i];
      segs[row * 8 + part] = sum;
    }
    __syncthreads();
    if ((tid & 7) == 0) {
      int row = tid >> 3;
      unsigned nd = need[row], cum = 0;
      int pt = 7;
      for (; pt > 0; --pt) { unsigned c = segs[row * 8 + pt]; if (cum + c >= nd) break; cum += c; }
      int bin = pt * 32 + 31;
      for (; bin > pt * 32; --bin) { unsigned c = hist[row * 257 + bin]; if (cum + c >= nd) break; cum += c; }
      unsigned cnt = hist[row * 257 + bin];
      if (pass < 4) prehi[row] = (prehi[row] << 8) | (unsigned)bin;
      else if (pass == 4) prelo[row] = (unsigned)bin;
      else prelo[row] = (prelo[row] << 4) | (unsigned)bin;
      need[row] = nd - cum;
      if (cnt != nd - cum) atomicOr(&flags[pass], 1);
      if (pass == 1 && cnt > (unsigned)DSA_CAP) atomicOr(&flags[8], 1);
    }
    __syncthreads();
    lastpass = pass;
    if (flags[pass] == 0) break;
    if (pass == 1 && flags[8] == 0) { fast = true; break; }
  }
  if (fast) {
    if (tid < 32) candn[tid] = 0;
    __syncthreads();
    const unsigned t16 = prehi[r];
    int kt = w;
    bf16x8 n0, n1;
    if (kt < ntile) { const u16* kp = ikc + (size_t)(kt * 32 + r) * 32 + h * 8; n0 = *(const bf16x8*)kp; n1 = *(const bf16x8*)(kp + 16); }
    for (; kt < ntile; kt += 4) {
      bf16x8 kf0 = n0, kf1 = n1;
      if (kt + 4 < ntile) { const u16* kp = ikc + (size_t)((kt + 4) * 32 + r) * 32 + h * 8; n0 = *(const bf16x8*)kp; n1 = *(const bf16x8*)(kp + 16); }
      f32x16 sc;
      dsa_scores(sc, kf0, kf1, h, iqrow, wq);
      unsigned word = 0;
#pragma unroll
      for (int reg = 0; reg < 16; ++reg) {
        const int sidx = kt * 32 + crow(reg, h);
        const unsigned ok = okey_of(sc[reg]);
        const unsigned hi16 = ok >> 16;
        const bool valid = sidx <= tq;
        word |= (valid && hi16 > t16) ? (1u << crow(reg, h)) : 0u;
        if (valid && hi16 == t16) {
          unsigned slot = atomicAdd(&candn[r], 1u);
          if (slot < (unsigned)DSA_CAP) { candk[r * 64 + slot] = ok; candi[r * 64 + slot] = (unsigned)sidx; }
        }
      }
      word |= __shfl_xor(word, 32);
      if (h == 0) maskw[kt * 32 + r] = word;
    }
    __syncthreads();
    {
      int row = tid >> 3, j8 = tid & 7;
      unsigned nc = candn[row]; nc = nc < (unsigned)DSA_CAP ? nc : (unsigned)DSA_CAP;
      const unsigned nd = need[row];
      for (unsigned i = j8; i < nc; i += 8) {
        unsigned ki = candk[row * 64 + i], ii = candi[row * 64 + i];
        unsigned rank = 0;
        for (unsigned k = 0; k < nc; ++k) { unsigned kk = candk[row * 64 + k], ik2 = candi[row * 64 + k]; rank += (kk > ki || (kk == ki && ik2 < ii)) ? 1u : 0u; }
        if (rank < nd) atomicOr(&maskw[(ii >> 5) * 32 + row], 1u << (ii & 31u));
      }
    }
  } else {
    unsigned thi = prehi[r], tlo = prelo[r];
    if (lastpass < 3) thi <<= (24 - 8 * lastpass);
    if (lastpass < 4) tlo = 0; else if (lastpass == 4) tlo <<= 4;
    int kt = w;
    bf16x8 n0, n1;
    if (kt < ntile) { const u16* kp = ikc + (size_t)(kt * 32 + r) * 32 + h * 8; n0 = *(const bf16x8*)kp; n1 = *(const bf16x8*)(kp + 16); }
    for (; kt < ntile; kt += 4) {
      bf16x8 kf0 = n0, kf1 = n1;
      if (kt + 4 < ntile) { const u16* kp = ikc + (size_t)((kt + 4) * 32 + r) * 32 + h * 8; n0 = *(const bf16x8*)kp; n1 = *(const bf16x8*)(kp + 16); }
      f32x16 sc;
      dsa_scores(sc, kf0, kf1, h, iqrow, wq);
      unsigned word = 0;
#pragma unroll
      for (int reg = 0; reg < 16; ++reg) {
        const int sidx = kt * 32 + crow(reg, h);
        const unsigned ok = okey_of(sc[reg]);
        const unsigned ri = 4095u - (unsigned)sidx;
        bool sel = (sidx <= tq) && (ok > thi || (ok == thi && ri >= tlo));
        word |= sel ? (1u << crow(reg, h)) : 0u;
      }
      word |= __shfl_xor(word, 32);
      if (h == 0) maskw[kt * 32 + r] = word;
    }
  }
  __syncthreads();
  for (int i = 0; i < 16; ++i) {
    int idx = tid + 256 * i; int rr = idx >> 7, kt = idx & 127;
    if (kt < ntile) gmask[(size_t)rr * 512 + kt] = maskw[kt * 32 + rr];
  }
  return;
  }
  for (int i = 0; i < 16; ++i) {
    int idx = tid + 256 * i; int rr = idx >> 7, kt = idx & 127;
    if (kt < ntile) maskw[kt * 32 + rr] = gmask[(size_t)rr * 512 + kt];
  }
  __syncthreads();
  {
    const int tokbase = b * SEQL + t0;
    auto src = [&](int slot, int rr) { return cols + (size_t)(tokbase + rr) * NC + C_DQ + slot * 64; };
    auto posf = [&](int slot, int rr) { return t0 + rr; };
    stage_q(Qs, src, posf, p.dsa_q_gain + layer * 64, true, true, rope64, 0.125f * 1.44269504f);
  }
  __syncthreads();
  bf16x8 qf[4];
  load_qfrags(qf, Qs, w, r, h);
  AttnAcc acc; attn_init(acc);
  const u16* Kb = (const u16*)(PWS + OFF_DK) + (size_t)b * SEQL * 64;
  const u16* Vtb = (const u16*)(PWS + OFF_DVT) + (size_t)b * 64 * SEQL;
  for (int rep = 0; rep < DBG_ATT_REP; ++rep) { attn_init(acc);
  attn_run(acc, qf, Kb, 64, SEQL - 1, Vtb, SEQL, ntile, [&](int i) { return i; }, [&](int kt) { return maskw[kt * 32 + r]; }, kvs); }
  float lt = acc.l + __shfl_xor(acc.l, 32);
  float inv = lt > 0.f ? 1.f / lt : 0.f;
  u16* mixed = (u16*)(PWS + OFF_H);
  u16* orow = mixed + (size_t)(b * SEQL + t0 + r) * 1024 + 256 + w * 64;
#pragma unroll
  for (int g = 0; g < 4; ++g) {
    float x0[4], x1[4];
#pragma unroll
    for (int i = 0; i < 4; ++i) { x0[i] = acc.o0[4 * g + i] * inv; x1[i] = acc.o1[4 * g + i] * inv; }
    store4bf(orow + 8 * g + 4 * h, x0);
    store4bf(orow + 32 + 8 * g + 4 * h, x1);
  }
}

DI void job_nsa(const Params& p, int layer, int b, int tt, char* smem) {
  const int tid = otid(), lane = tid & 63, w = tid >> 6, r = lane & 31, h = lane >> 5;
  const int t0 = tt * 32;
  const int t = t0 + r;
  u16* cols = (u16*)(PWS + OFF_COLS);
  const u16* cb = cols + (size_t)b * SEQL * NC;
  u16* Qs = (u16*)smem;
  u16* kvs = (u16*)(smem + 18432);
  float* stage = (float*)(smem + 37888);
  float* imp = (float*)(smem + 54272);
  unsigned* selm = (unsigned*)(smem + 62464);
  int* tlist = (int*)(smem + 62720);
  int* nlist = (int*)(smem + 63744);
  const float2* rope64 = (const float2*)(PWS + OFF_ROPE64);
  const float qscale = 0.125f * 1.44269504f;
  const int tokbase = b * SEQL + t0;
  auto src = [&](int slot, int rr) { return cols + (size_t)(tokbase + rr) * NC + C_NQ + slot * 64; };
  auto posf = [&](int slot, int rr) { return t0 + rr; };

  stage_q(Qs, src, posf, p.nsa_q_gain + layer * 64, true, false, rope64, qscale);
  __syncthreads();
  bf16x8 qf[4];
  load_qfrags(qf, Qs, w, r, h);
  const u16* Kc_g = (const u16*)(PWS + OFF_KCMP) + (size_t)b * 256 * 64;
  const u16* Vc_g = (const u16*)(PWS + OFF_VCMPT) + (size_t)b * 64 * 256;
  const int jmax = t >= 31 ? ((t - 31) >> 4) : -1;
  const int ntc = ((2 * tt) >> 5) + 1;
  AttnAcc ac; attn_init(ac);
  attn_run(ac, qf, Kc_g, 64, 255, Vc_g, 256, ntc, [&](int i) { return i; }, [&](int kt) { return lowmask(jmax + 1 - kt * 32); }, kvs);
  float lt = ac.l + __shfl_xor(ac.l, 32);
  float inv_c = lt > 0.f ? 1.f / lt : 0.f;
  float mb_c = (ac.m == -INFINITY) ? 0.f : ac.m;
  for (int i = tid; i < 64 * 32; i += 256) imp[i] = 0.f;
  if (tid < 64) selm[tid] = 0;
  {
    const int krow = tid >> 3, kseg = tid & 7;
    u32x4 rk = *(const u32x4*)(Kc_g + (size_t)krow * 64 + kseg * 8);
    __syncthreads();
    *(u32x4*)(kvs + krow * 72 + kseg * 8) = rk;
    __syncthreads();
    for (int kt = 0; kt < ntc; ++kt) {
      const u16* Kc = kvs + (kt & 1) * KV_BUF;
      if (kt + 1 < ntc) rk = *(const u32x4*)(Kc_g + (size_t)((kt + 1) * 32 + krow) * 64 + kseg * 8);
      f32x16 s = zero16();
#pragma unroll
      for (int ks = 0; ks < 4; ++ks) { bf16x8 kf = *(const bf16x8*)(Kc + r * 72 + ks * 16 + h * 8); s = MFMA_BF(kf, qf[ks], s); }
      unsigned mw = lowmask(jmax + 1 - kt * 32);
#pragma unroll
      for (int reg = 0; reg < 16; ++reg) {
        bool bit = (mw >> crow(reg, h)) & 1u;
        float pv = bit ? __builtin_amdgcn_exp2f(s[reg] - mb_c) * inv_c : 0.f;
        stage[w * 1024 + crow(reg, h) * 32 + r] = pv;
      }
      if (kt + 1 < ntc) *(u32x4*)(kvs + ((kt + 1) & 1) * KV_BUF + krow * 72 + kseg * 8) = rk;
      __syncthreads();
      int tq = tid & 31, ng = tid >> 5, n = kt * 8 + ng;
      float ps[4];
#pragma unroll
      for (int i = 0; i < 4; ++i) { int j = 4 * ng + i; ps[i] = ((stage[j * 32 + tq] + stage[1024 + j * 32 + tq]) + stage[2048 + j * 32 + tq]) + stage[3072 + j * 32 + tq]; }
      imp[n * 32 + tq] += ((ps[0] + ps[1]) + ps[2]) + ps[3];
      __syncthreads();
      if (n + 1 < 64) imp[(n + 1) * 32 + tq] += ps[3];
    }
  }
  __syncthreads();
  {
    int tq = tid & 31, sub = tid >> 5;
    int cur = (t0 + tq) >> 6;
    float v[8];
#pragma unroll
    for (int k = 0; k < 8; ++k) {
      int n = sub * 8 + k;
      bool forced = (n == 0) || (n == cur) || (n == cur - 1);
      float val = forced ? INFINITY : (n > cur ? -INFINITY : imp[n * 32 + tq]);
      v[k] = val;
    }
    __syncthreads();
#pragma unroll
    for (int k = 0; k < 8; ++k) imp[(sub * 8 + k) * 32 + tq] = v[k];
    __syncthreads();
    int rank[8];
#pragma unroll
    for (int k = 0; k < 8; ++k) rank[k] = 0;
    for (int n2 = 0; n2 < 64; ++n2) {
      float v2 = imp[n2 * 32 + tq];
#pragma unroll
      for (int k = 0; k < 8; ++k) { int n = sub * 8 + k; rank[k] += (v2 > v[k] || (v2 == v[k] && n2 < n)) ? 1 : 0; }
    }
    unsigned bits = 0;
#pragma unroll
    for (int k = 0; k < 8; ++k) if (rank[k] < 16) bits |= 1u << ((sub * 8 + k) & 31);
    if (bits) atomicOr(&selm[tq * 2 + (sub >> 2)], bits);
  }
  __syncthreads();
  if (tid == 0) {
    unsigned lo = 0, hi = 0;
    for (int i = 0; i < 32; ++i) { lo |= selm[2 * i]; hi |= selm[2 * i + 1]; }
    int cnt = 0;
    for (int n = 0; n < 64; ++n) {
      bool on = n < 32 ? ((lo >> n) & 1u) : ((hi >> (n - 32)) & 1u);
      if (on) { if (2 * n <= tt) tlist[cnt++] = 2 * n; if (2 * n + 1 <= tt) tlist[cnt++] = 2 * n + 1; }
    }
    nlist[0] = cnt;
  }
  const u16* grow = cb + (size_t)t * NC + C_GATES;
  float g0 = sigmoidf_(bf2f(grow[w])), g1 = sigmoidf_(bf2f(grow[4 + w])), g2 = sigmoidf_(bf2f(grow[8 + w]));
  f32x16 out0, out1;
#pragma unroll
  for (int reg = 0; reg < 16; ++reg) { out0[reg] = g0 * inv_c * ac.o0[reg]; out1[reg] = g0 * inv_c * ac.o1[reg]; }
  __syncthreads();
  stage_q(Qs, src, posf, p.nsa_q_gain + layer * 64, true, true, rope64, qscale);
  __syncthreads();
  load_qfrags(qf, Qs, w, r, h);
  const unsigned mylo = selm[2 * r], myhi = selm[2 * r + 1];
  const int nsl = nlist[0];
  {
    AttnAcc as; attn_init(as);
    const u16* Kb = (const u16*)(PWS + OFF_KSC) + (size_t)b * SEQL * 64;
    const u16* Vtb = (const u16*)(PWS + OFF_VST) + (size_t)b * 64 * SEQL;
    for (int rep = 0; rep < DBG_SLC_REP; ++rep) { attn_init(as);
    attn_run(as, qf, Kb, 64, SEQL - 1, Vtb, SEQL, nsl, [&](int i) { return tlist[i]; },
             [&](int kt) { int n = kt >> 1; bool sel = n < 32 ? ((mylo >> n) & 1u) : ((myhi >> (n - 32)) & 1u); return sel ? lowmask(t - kt * 32 + 1) : 0u; }, kvs); }
    float l2 = as.l + __shfl_xor(as.l, 32);
    float inv = l2 > 0.f ? 1.f / l2 : 0.f;
#pragma unroll
    for (int reg = 0; reg < 16; ++reg) { out0[reg] += g1 * inv * as.o0[reg]; out1[reg] += g1 * inv * as.o1[reg]; }
  }
  {
    AttnAcc aw; attn_init(aw);
    const u16* Kb = (const u16*)(PWS + OFF_KWC) + (size_t)b * SEQL * 64;
    const u16* Vtb = (const u16*)(PWS + OFF_VWT) + (size_t)b * 64 * SEQL;
    const int klo = tt - 16 > 0 ? tt - 16 : 0;
    for (int rep = 0; rep < DBG_SWA_REP; ++rep) { attn_init(aw);
    attn_run(aw, qf, Kb, 64, SEQL - 1, Vtb, SEQL, tt - klo + 1, [&](int i) { return klo + i; },
             [&](int kt) { int lo = t - 511 - kt * 32; unsigned lm = lo <= 0 ? 0xffffffffu : (lo >= 32 ? 0u : (0xffffffffu << lo)); return lowmask(t - kt * 32 + 1) & lm; }, kvs); }
    float l2 = aw.l + __shfl_xor(aw.l, 32);
    float inv = l2 > 0.f ? 1.f / l2 : 0.f;
#pragma unroll
    for (int reg = 0; reg < 16; ++reg) { out0[reg] += g2 * inv * aw.o0[reg]; out1[reg] += g2 * inv * aw.o1[reg]; }
  }
  u16* mixed = (u16*)(PWS + OFF_H);
  u16* orow = mixed + (size_t)(b * SEQL + t) * 1024 + 512 + w * 64;
#pragma unroll
  for (int g = 0; g < 4; ++g) {
    float x0[4], x1[4];
#pragma unroll
    for (int i = 0; i < 4; ++i) { x0[i] = out0[4 * g + i]; x1[i] = out1[4 * g + i]; }
    store4bf(orow + 8 * g + 4 * h, x0);
    store4bf(orow + 32 + 8 * g + 4 * h, x1);
  }
}

DI void job_xattn(const Params& p, int layer, int b, int hd, int tq, char* smem) {
  const int tid = otid(), lane = tid & 63, w = tid >> 6, r = lane & 31, h = lane >> 5;
  u16* Qs = (u16*)smem;
  u16* kvs = (u16*)(smem + 18432);
  const u16* xq = (const u16*)(PWS + OFF_XQ);
  const int tokbase = b * SEQL + tq * 128;
  auto src = [&](int slot, int rr) { return xq + (size_t)(tokbase + slot * 32 + rr) * 256 + hd * 64; };
  auto posf = [&](int slot, int rr) { return 0; };
  stage_q(Qs, src, posf, p.xa_q_gain + layer * 64, true, false, (const float2*)nullptr, 0.125f * 1.44269504f);
  __syncthreads();
  bf16x8 qf[4];
  load_qfrags(qf, Qs, w, r, h);
  const u16* Kb = (const u16*)(PWS + OFF_MEMKV) + ((size_t)(layer * 4 + b) * 256) * 512 + hd * 64;
  const u16* Vtb = (const u16*)(PWS + OFF_MEMVT) + ((size_t)(layer * 4 + b) * 256 + hd * 64) * 256;
  AttnAcc a; attn_init(a);
  attn_run(a, qf, Kb, 512, 255, Vtb, 256, 8, [&](int i) { return i; }, [&](int kt) { return 0xffffffffu; }, kvs);
  float lt = a.l + __shfl_xor(a.l, 32);
  float inv = 1.f / lt;
  u16* xo = (u16*)(PWS + OFF_XO);
  u16* orow = xo + (size_t)(tokbase + w * 32 + r) * 256 + hd * 64;
#pragma unroll
  for (int g = 0; g < 4; ++g) {
    float x0[4], x1[4];
#pragma unroll
    for (int i = 0; i < 4; ++i) { x0[i] = a.o0[4 * g + i] * inv; x1[i] = a.o1[4 * g + i] * inv; }
    store4bf(orow + 8 * g + 4 * h, x0);
    store4bf(orow + 32 + 8 * g + 4 * h, x1);
  }
}

DI void job_prep(const Params& p, int layer, int job, char* smem) {
  const int tid = otid();
  const int tok0 = job * 32;
  const int b = tok0 >> 12, pos0 = tok0 & 4095;
  u16* cols = (u16*)(PWS + OFF_COLS);
  const float2* rope64 = (const float2*)(PWS + OFF_ROPE64);
  const float2* rope32 = (const float2*)(PWS + OFF_ROPE32);
  float* ckvn = (float*)smem;
  float* kpre = ckvn + 32 * 128;
  float* vbuf = kpre + 32 * 64;
  for (int it = 0; it < 4; ++it) {
    int row = it * 16 + (tid >> 4), lg = tid & 15;
    int tk = row >> 1, which = row & 1;
    u16* ptr = cols + (size_t)(tok0 + tk) * NC + (which ? C_KW : C_KS) + lg * 4;
    float x[4]; load4bf(ptr, x);
    rowop<64>(x, lg, p.nsa_k_gains + layer * 192 + (which ? 128 : 64), true, true, pos0 + tk, rope64);
    store4bf((u16*)(PWS + (which ? OFF_KWC : OFF_KSC)) + (size_t)(tok0 + tk) * 64 + lg * 4, x);
  }
  for (int it = 0; it < 8; ++it) {
    int row = it * 32 + (tid >> 3), lg = tid & 7;
    int tk = row >> 3, hh = row & 7;
    u16* ptr = cols + (size_t)(tok0 + tk) * NC + C_IQ + hh * 32 + lg * 4;
    float x[4]; load4bf(ptr, x);
    rowop<32>(x, lg, nullptr, false, true, pos0 + tk, rope32);
    store4bf(ptr, x);
  }
  {
    int tk = tid >> 3, lg = tid & 7;
    u16* ptr = cols + (size_t)(tok0 + tk) * NC + C_IK + lg * 4;
    float x[4]; load4bf(ptr, x);
    rowop<32>(x, lg, p.dsa_idxk_gain + layer * 32, true, true, pos0 + tk, rope32);
    store4bf((u16*)(PWS + OFF_IKC) + (size_t)(tok0 + tk) * 32 + lg * 4, x);
  }
  u16* ckvb = (u16*)smem;
  for (int it = 0; it < 4; ++it) {
    int tk = it * 8 + (tid >> 5), lg = tid & 31;
    float x[4]; load4bf(cols + (size_t)(tok0 + tk) * NC + C_CKV + lg * 4, x);
    rowop<128>(x, lg, p.dsa_kv_gain + layer * 128, true, false, 0, rope64);
    store4bf(ckvb + tk * 136 + lg * 4, x);
  }
  __syncthreads();
  {
    const int lane = tid & 63, w = tid >> 6, r = lane & 31, h = lane >> 5;
    const u16* wt = (const u16*)(PWS + OFF_WUKV) + (size_t)layer * 128 * 128 + (size_t)(w * 32 + r) * 128;
    f32x16 acc = zero16();
#pragma unroll
    for (int s2 = 0; s2 < 8; ++s2) {
      bf16x8 af = *(const bf16x8*)(ckvb + r * 136 + s2 * 16 + h * 8);
      bf16x8 bfr = *(const bf16x8*)(wt + s2 * 16 + h * 8);
      acc = MFMA_BF(af, bfr, acc);
    }
#pragma unroll
    for (int reg = 0; reg < 16; ++reg) {
      int tk = crow(reg, h), n = w * 32 + r;
      if (n < 64) kpre[tk * 64 + n] = acc[reg]; else vbuf[tk * 65 + (n - 64)] = acc[reg];
    }
  }
  __syncthreads();
  u16* DK = (u16*)(PWS + OFF_DK);
  for (int it = 0; it < 2; ++it) {
    int tk = it * 16 + (tid >> 4), lg = tid & 15;
    float x[4];
#pragma unroll
    for (int i = 0; i < 4; ++i) x[i] = kpre[tk * 64 + lg * 4 + i];
    rowop<64>(x, lg, p.dsa_k_gain + layer * 64, true, true, pos0 + tk, rope64);
    store4bf(DK + (size_t)(tok0 + tk) * 64 + lg * 4, x);
  }
  for (int which = 0; which < 3; ++which) {
    if (which > 0) {
      __syncthreads();
      for (int i = 0; i < 8; ++i) { int e = tid + 256 * i; int tk = e >> 6, d = e & 63; vbuf[tk * 65 + d] = bf2f(cols[(size_t)(tok0 + tk) * NC + (which == 1 ? C_VS : C_VW) + d]); }
      __syncthreads();
    }
    u16* dst = (u16*)(PWS + (which == 0 ? OFF_DVT : (which == 1 ? OFF_VST : OFF_VWT)));
    int d = tid & 63, q = tid >> 6;
    uint4 o;
    o.x = pack2(vbuf[(q * 8 + 0) * 65 + d], vbuf[(q * 8 + 1) * 65 + d]);
    o.y = pack2(vbuf[(q * 8 + 2) * 65 + d], vbuf[(q * 8 + 3) * 65 + d]);
    o.z = pack2(vbuf[(q * 8 + 4) * 65 + d], vbuf[(q * 8 + 5) * 65 + d]);
    o.w = pack2(vbuf[(q * 8 + 6) * 65 + d], vbuf[(q * 8 + 7) * 65 + d]);
    *(uint4*)(dst + ((size_t)(b * 64 + d)) * SEQL + pos0 + q * 8) = o;
  }
}

DI void job_memkv_post(const Params& p, int job, char* smem) {
  const int tid = otid();
  const int l = job >> 5, row0 = (job & 31) * 32;
  u16* kv = (u16*)(PWS + OFF_MEMKV) + (size_t)l * 1024 * 512;
  u16* vt = (u16*)(PWS + OFF_MEMVT) + (size_t)l * 4 * 256 * 256;
  float* vbuf = (float*)smem;
  for (int it = 0; it < 8; ++it) {
    int row = it * 16 + (tid >> 4), lg = tid & 15;
    int rr = row >> 2, hd = row & 3;
    u16* ptr = kv + (size_t)(row0 + rr) * 512 + hd * 64 + lg * 4;
    float x[4]; load4bf(ptr, x);
    rowop<64>(x, lg, p.xa_k_gain + l * 64, true, false, 0, (const float2*)nullptr);
    store4bf(ptr, x);
  }
  for (int i = 0; i < 32; ++i) { int e = tid + 256 * i; int rr = e >> 8, c = e & 255; vbuf[rr * 257 + c] = bf2f(kv[(size_t)(row0 + rr) * 512 + 256 + c]); }
  __syncthreads();
  {
    int b = row0 >> 8, m0 = row0 & 255;
    int c = tid;
    for (int q = 0; q < 4; ++q) {
      uint4 o;
      o.x = pack2(vbuf[(q * 8 + 0) * 257 + c], vbuf[(q * 8 + 1) * 257 + c]);
      o.y = pack2(vbuf[(q * 8 + 2) * 257 + c], vbuf[(q * 8 + 3) * 257 + c]);
      o.z = pack2(vbuf[(q * 8 + 4) * 257 + c], vbuf[(q * 8 + 5) * 257 + c]);
      o.w = pack2(vbuf[(q * 8 + 6) * 257 + c], vbuf[(q * 8 + 7) * 257 + c]);
      *(uint4*)(vt + ((size_t)(b * 256 + c)) * 256 + m0 + q * 8) = o;
    }
  }
}

DI void job_cmp2(const Params& p, int layer, int job, char* smem) {
  const int tid = otid();
  const int rl = tid >> 5, nq = (tid >> 4) & 1, lg = tid & 15;
  const int gr0 = job * 8;
  const int gr = gr0 + rl;
  const int b = gr >> 8, j = gr & 255;
  const u16* hid = (const u16*)(PWS + OFF_HID);
  float* hs = (float*)smem;
  float* part = hs + 8 * 512;
  float* vb = part + 8 * 16 * 8;
  for (int i = 0; i < 2; ++i) {
    int c = tid + 256 * i; int row = c >> 6, seg = c & 63;
    int g2 = gr0 + row; int b2 = g2 >> 8, j2 = g2 & 255;
    float x[8];
    if (j2 < 255) ld8bf(hid + (size_t)(b2 * 255 + j2) * 512 + seg * 8, x);
    else { for (int k = 0; k < 8; ++k) x[k] = 0.f; }
#pragma unroll
    for (int k = 0; k < 8; ++k) hs[row * 512 + seg * 8 + k] = x[k];
  }
  __syncthreads();
  float ak[4] = {0.f, 0.f, 0.f, 0.f}, av[4] = {0.f, 0.f, 0.f, 0.f};
  {
    const float* w2k = p.nsa_k_w2 + (size_t)layer * 256 * 64 + lg * 4;
    const float* w2v = p.nsa_v_w2 + (size_t)layer * 256 * 64 + lg * 4;
    const float* hr = hs + rl * 512;
#pragma unroll 8
    for (int n = nq * 128; n < nq * 128 + 128; ++n) {
      float hk = hr[n], hv = hr[256 + n];
      float4 wk = *(const float4*)(w2k + n * 64), wv = *(const float4*)(w2v + n * 64);
      ak[0] = fmaf(hk, wk.x, ak[0]); ak[1] = fmaf(hk, wk.y, ak[1]); ak[2] = fmaf(hk, wk.z, ak[2]); ak[3] = fmaf(hk, wk.w, ak[3]);
      av[0] = fmaf(hv, wv.x, av[0]); av[1] = fmaf(hv, wv.y, av[1]); av[2] = fmaf(hv, wv.z, av[2]); av[3] = fmaf(hv, wv.w, av[3]);
    }
  }
  if (nq == 1) {
#pragma unroll
    for (int i = 0; i < 4; ++i) { part[(rl * 16 + lg) * 8 + i] = ak[i]; part[(rl * 16 + lg) * 8 + 4 + i] = av[i]; }
  }
  __syncthreads();
  if (nq == 0) {
#pragma unroll
    for (int i = 0; i < 4; ++i) { ak[i] += part[(rl * 16 + lg) * 8 + i]; av[i] += part[(rl * 16 + lg) * 8 + 4 + i]; }
  }
  rowop<64>(ak, lg, p.nsa_k_gains + layer * 192, true, false, 0, (const float2*)nullptr);
  if (nq == 0) {
    store4bf((u16*)(PWS + OFF_KCMP) + (size_t)gr * 64 + lg * 4, ak);
#pragma unroll
    for (int i = 0; i < 4; ++i) vb[rl * 65 + lg * 4 + i] = av[i];
  }
  __syncthreads();
  if (tid < 64) {
    int d = tid;
    uint4 o;
    o.x = pack2(vb[0 * 65 + d], vb[1 * 65 + d]);
    o.y = pack2(vb[2 * 65 + d], vb[3 * 65 + d]);
    o.z = pack2(vb[4 * 65 + d], vb[5 * 65 + d]);
    o.w = pack2(vb[6 * 65 + d], vb[7 * 65 + d]);
    int bb = gr0 >> 8, jb = gr0 & 255;
    *(uint4*)((u16*)(PWS + OFF_VCMPT) + ((size_t)(bb * 64 + d)) * 256 + jb) = o;
  }
}

DI float lb_of(const Params& p, int layer, int c) {
  if (layer == 0) return 0.f;
  float p0 = p.lb_param[c], p1 = p.lb_param[256 + c];
  return 1.f / (1.f + expf(p0 - p1));
}
DI void mm32(f32x16& acc, const float* Ap, int asi, int ask, const float* Bp, int bsk, int bsj, int r, int h) {
#pragma unroll 8
  for (int k = 0; k < 64; k += 2) {
    float a = Ap[r * asi + (k + h) * ask];
    float b = Bp[(k + h) * bsk + r * bsj];
    acc = MFMA_F32(a, b, acc);
  }
}
template <bool SILU_GATE>
DI void finish_rows(const float* ob, const float* gain, const u16* cols, int gate_col, u16* mixed, int mix_col, int tb, int hd) {
  const int tid = otid(), lg = tid & 15;
  for (int it = 0; it < 4; ++it) {
    int t = it * 16 + (tid >> 4);
    float x[4];
#pragma unroll
    for (int i = 0; i < 4; ++i) x[i] = ob[t * 65 + lg * 4 + i];
    rowop<64>(x, lg, gain, true, false, 0, (const float2*)nullptr);
    float g[4]; load4bf(cols + (size_t)(tb + t) * NC + gate_col + hd * 64 + lg * 4, g);
#pragma unroll
    for (int i = 0; i < 4; ++i) x[i] *= SILU_GATE ? siluf_(g[i]) : sigmoidf_(g[i]);
    store4bf(mixed + (size_t)(tb + t) * 1024 + mix_col + hd * 64 + lg * 4, x);
  }
}

DI void conv8(const u16* cols, const float (&cw)[4][8], const float (&cbias)[8], int tok, int pos, int coloff, float (&out)[8]) {
#pragma unroll
  for (int k = 0; k < 8; ++k) out[k] = cbias[k];
#pragma unroll
  for (int j = 0; j < 4; ++j) {
    int dp = j - 3;
    if (pos + dp >= 0) {
      float x[8]; ld8bf(cols + (size_t)(tok + dp) * NC + coloff, x);
#pragma unroll
      for (int k = 0; k < 8; ++k) out[k] = fmaf(cw[j][k], x[k], out[k]);
    }
  }
#pragma unroll
  for (int k = 0; k < 8; ++k) out[k] = siluf_(out[k]);
}
DI void load_convw(const Params& p, int layer, int ch0, float (&cw)[4][8], float (&cbias)[8]) {
  const float* w = p.ml_conv_w + (size_t)layer * 4 * 512 + ch0;
#pragma unroll
  for (int j = 0; j < 4; ++j) {
    float4 a = *(const float4*)(w + j * 512), b2 = *(const float4*)(w + j * 512 + 4);
    cw[j][0] = a.x; cw[j][1] = a.y; cw[j][2] = a.z; cw[j][3] = a.w; cw[j][4] = b2.x; cw[j][5] = b2.y; cw[j][6] = b2.z; cw[j][7] = b2.w;
  }
  const float* bb = p.ml_conv_b + layer * 512 + ch0;
  float4 a = *(const float4*)bb, b2 = *(const float4*)(bb + 4);
  cbias[0] = a.x; cbias[1] = a.y; cbias[2] = a.z; cbias[3] = a.w; cbias[4] = b2.x; cbias[5] = b2.y; cbias[6] = b2.z; cbias[7] = b2.w;
}
DI void load_state(float* dst, const float* src, int tid) {
#pragma unroll
  for (int i = 0; i < 4; ++i) { int e4 = tid + 256 * i; int row = e4 >> 4, c4 = (e4 & 15) * 4; float4 v = *(const float4*)(src + row * 64 + c4);
    dst[row * 65 + c4] = v.x; dst[row * 65 + c4 + 1] = v.y; dst[row * 65 + c4 + 2] = v.z; dst[row * 65 + c4 + 3] = v.w; }
}

DI void job_hg_A(const Params& p, int layer, int cid, char* smem) {
  const int tid = otid(), lane = tid & 63, w = tid >> 6, r = lane & 31, h = lane >> 5;
  const int bh = cid >> 6, c = cid & 63, b = bh >> 2, hd = bh & 3;
  const int tb = b * SEQL + c * 64;
  const u16* cols = (const u16*)(PWS + OFF_COLS);
  float* B0 = (float*)smem; float* B1 = B0 + 64 * 65; float* B2 = B1 + 64 * 65;
  {
    const int seg = tid & 7;
    float lbv[8];
#pragma unroll
    for (int k = 0; k < 8; ++k) lbv[k] = lb_of(p, layer, hd * 64 + seg * 8 + k);
#pragma unroll
    for (int i = 0; i < 2; ++i) {
      int s = (tid >> 3) + 32 * i;
      const u16* row = cols + (size_t)(tb + s) * NC + hd * 64 + seg * 8;
      float f[8], iv[8]; ld8bf(row + C_HGF, f); ld8bf(row + C_HGI, iv);
#pragma unroll
      for (int k = 0; k < 8; ++k) {
        float fg = lbv[k] + (1.f - lbv[k]) * sigmoidf_(f[k]);
        B0[s * 65 + seg * 8 + k] = logf(fg); B1[s * 65 + seg * 8 + k] = 1.f - fg; B2[s * 65 + seg * 8 + k] = iv[k];
      }
    }
  }
  __syncthreads();
  if (tid < 64) { float run = 0.f; for (int s = 0; s < 64; ++s) { run += B0[s * 65 + tid]; B0[s * 65 + tid] = run; } }
  __syncthreads();
  for (int e = tid; e < 4096; e += 256) { int s = e >> 6, kd = e & 63; B1[s * 65 + kd] *= expf(B0[63 * 65 + kd] - B0[s * 65 + kd]); }
  __syncthreads();
  const int ih = w >> 1, jh = w & 1;
  f32x16 acc = zero16();
  mm32(acc, B1 + ih * 32, 1, 65, B2 + jh * 32, 65, 1, r, h);
  float* st = (float*)(PWS + OFF_HGST) + (size_t)cid * 4096;
#pragma unroll
  for (int reg = 0; reg < 16; ++reg) st[(ih * 32 + crow(reg, h)) * 64 + jh * 32 + r] = acc[reg];
  if (tid < 64) ((float*)(PWS + OFF_HGD))[cid * 64 + tid] = expf(B0[63 * 65 + tid]);
}

DI void job_hg_scan(const Params& p, int job) {
  const int bh = job >> 4, e = (job & 15) * 256 + otid();
  float* st = (float*)(PWS + OFF_HGST);
  const float* dv = (const float*)(PWS + OFF_HGD);
  float S = 0.f;
  for (int c0 = 0; c0 < 64; c0 += 16) {
    float U[16], D[16];
#pragma unroll
    for (int i = 0; i < 16; ++i) { U[i] = st[(size_t)(bh * 64 + c0 + i) * 4096 + e]; D[i] = dv[(bh * 64 + c0 + i) * 64 + (e >> 6)]; }
#pragma unroll
    for (int i = 0; i < 16; ++i) { st[(size_t)(bh * 64 + c0 + i) * 4096 + e] = S; S = D[i] * S + U[i]; }
  }
}

DI void job_hg_C(const Params& p, int layer, int cid, char* smem) {
  const int tid = otid(), lane = tid & 63, w = tid >> 6, r = lane & 31, h = lane >> 5;
  const int bh = cid >> 6, c = cid & 63, b = bh >> 2, hd = bh & 3;
  const int tb = b * SEQL + c * 64;
  const u16* cols = (const u16*)(PWS + OFF_COLS);
  float* B0 = (float*)smem; float* B1 = B0 + 64 * 65; float* B2 = B1 + 64 * 65; float* B3 = B2 + 64 * 65;
  {
    const int seg = tid & 7;
    float lbv[8];
#pragma unroll
    for (int k = 0; k < 8; ++k) lbv[k] = lb_of(p, layer, hd * 64 + seg * 8 + k);
#pragma unroll
    for (int i = 0; i < 2; ++i) {
      int s = (tid >> 3) + 32 * i;
      const u16* row = cols + (size_t)(tb + s) * NC + hd * 64 + seg * 8;
      float f[8], iv[8], qr[8]; ld8bf(row + C_HGF, f); ld8bf(row + C_HGI, iv); ld8bf(row + C_HGQ, qr);
#pragma unroll
      for (int k = 0; k < 8; ++k) {
        float fg = lbv[k] + (1.f - lbv[k]) * sigmoidf_(f[k]);
        B0[s * 65 + seg * 8 + k] = logf(fg); B2[s * 65 + seg * 8 + k] = 1.f - fg;
        B1[s * 65 + seg * 8 + k] = siluf_(qr[k]) * 0.125f; B3[s * 65 + seg * 8 + k] = iv[k];
      }
    }
  }
  __syncthreads();
  if (tid < 64) { float run = 0.f; for (int s = 0; s < 64; ++s) { run += B0[s * 65 + tid]; B0[s * 65 + tid] = run; } }
  __syncthreads();
  for (int e = tid; e < 4096; e += 256) {
    int s = e >> 6, kd = e & 63;
    float bref = B0[31 * 65 + kd], bc = B0[s * 65 + kd];
    B1[s * 65 + kd] *= expf(bc - bref);
    B2[s * 65 + kd] *= expf(bref - bc);
  }
  __syncthreads();
  const int th = w >> 1, sh = w & 1;
  f32x16 at = zero16();
  if (!(th == 0 && sh == 1)) mm32(at, B1 + th * 32 * 65, 65, 1, B2 + sh * 32 * 65, 1, 65, r, h);
  __syncthreads();
  for (int e = tid; e < 4096; e += 256) { int s = e >> 6, kd = e & 63; B2[s * 65 + kd] = B1[s * 65 + kd] * expf(B0[31 * 65 + kd]); }
  __syncthreads();
#pragma unroll
  for (int reg = 0; reg < 16; ++reg) {
    int t = th * 32 + crow(reg, h), s = sh * 32 + r;
    B1[t * 65 + s] = (s <= t) ? at[reg] : 0.f;
  }
  load_state(B0, (const float*)(PWS + OFF_HGST) + (size_t)cid * 4096, tid);
  __syncthreads();
  const int vh = w & 1;
  f32x16 o = zero16();
  mm32(o, B2 + th * 32 * 65, 65, 1, B0 + vh * 32, 65, 1, r, h);
  mm32(o, B1 + th * 32 * 65, 65, 1, B3 + vh * 32, 65, 1, r, h);
  __syncthreads();
#pragma unroll
  for (int reg = 0; reg < 16; ++reg) B2[(th * 32 + crow(reg, h)) * 65 + vh * 32 + r] = o[reg];
  __syncthreads();
  finish_rows<true>(B2, p.hg_o_gain + layer * 64, cols, C_HGG, (u16*)(PWS + OFF_H), 0, tb, hd);
}

DI float conv_silu(const Params& p, int layer, const u16* cols, int tok, int pos, int ch) {
  const float* cw = p.ml_conv_w + (size_t)layer * 4 * 512;
  float a = p.ml_conv_b[layer * 512 + ch];
#pragma unroll
  for (int j = 0; j < 4; ++j) {
    int dp = j - 3;
    float xv = (pos + dp >= 0) ? bf2f(cols[(size_t)(tok + dp) * NC + C_MQ + ch]) : 0.f;
    a = fmaf(cw[j * 512 + ch], xv, a);
  }
  return siluf_(a);
}
DI float logsigmoidf_(float x) { return fminf(x, 0.f) - log1pf(expf(-fabsf(x))); }
DI float scan_add(float v, int lane) { for (int o = 1; o < 64; o <<= 1) { float u = __shfl_up(v, o); if (lane >= o) v += u; } return v; }
DI float scan_max(float v, int lane) { for (int o = 1; o < 64; o <<= 1) { float u = __shfl_up(v, o); if (lane >= o) v = fmaxf(v, u); } return v; }

DI void job_ml_A(const Params& p, int layer, int cid, char* smem) {
  const int tid = otid(), lane = tid & 63, w = tid >> 6, r = lane & 31, h = lane >> 5;
  const int bh = cid >> 6, c = cid & 63, b = bh >> 2, hd = bh & 3;
  const int tb = b * SEQL + c * 64;
  const u16* cols = (const u16*)(PWS + OFF_COLS);
  float* B1 = (float*)smem; float* B2 = B1 + 64 * 65; float* wsv = B2 + 64 * 65;
  float* mlsc = (float*)(PWS + OFF_MLSC);
  if (w == 0) {
    const u16* row = cols + (size_t)(tb + lane) * NC;
    float fgv = bf2f(row[C_FG + hd]) + p.ml_f_bias[layer * 4 + hd];
    float igv = bf2f(row[C_IG + hd]) + p.ml_i_bias[layer * 4 + hd];
    float lf = logsigmoidf_(fgv);
    float bc = scan_add(lf, lane);
    float blast = __shfl(bc, 63);
    float lw = blast - bc + igv;
    float Mc = wave_max(lw);
    wsv[lane] = expf(lw - Mc);
    if (lane == 0) { mlsc[cid] = Mc; mlsc[1024 + cid] = blast; }
  }
  {
    const int seg = tid & 7;
    float cw[4][8], cbias[8];
    load_convw(p, layer, 256 + hd * 64 + seg * 8, cw, cbias);
#pragma unroll
    for (int i = 0; i < 2; ++i) {
      int s = (tid >> 3) + 32 * i;
      float kv[8], vv[8];
      conv8(cols, cw, cbias, tb + s, c * 64 + s, C_MK + hd * 64 + seg * 8, kv);
      ld8bf(cols + (size_t)(tb + s) * NC + C_MV + hd * 64 + seg * 8, vv);
#pragma unroll
      for (int k = 0; k < 8; ++k) { B1[s * 65 + seg * 8 + k] = kv[k] * 0.125f; B2[s * 65 + seg * 8 + k] = vv[k]; }
    }
  }
  __syncthreads();
  for (int e = tid; e < 4096; e += 256) { int s = e >> 6, d = e & 63; B1[s * 65 + d] *= wsv[s]; }
  __syncthreads();
  const int ih = w >> 1, jh = w & 1;
  f32x16 acc = zero16();
  mm32(acc, B1 + ih * 32, 1, 65, B2 + jh * 32, 65, 1, r, h);
  float* st = (float*)(PWS + OFF_MLST) + (size_t)cid * 4096;
#pragma unroll
  for (int reg = 0; reg < 16; ++reg) st[(ih * 32 + crow(reg, h)) * 64 + jh * 32 + r] = acc[reg];
  if (tid < 64) { float sacc = 0.f; for (int s = 0; s < 64; ++s) sacc += B1[s * 65 + tid]; ((float*)(PWS + OFF_MLN))[cid * 64 + tid] = sacc; }
}

DI void job_ml_scan(const Params& p, int job) {
  const int bh = job >> 4, sl = job & 15, tid = otid(), e = sl * 256 + tid;
  float* st = (float*)(PWS + OFF_MLST);
  float* nv = (float*)(PWS + OFF_MLN);
  float* mlsc = (float*)(PWS + OFF_MLSC);
  float S = 0.f, nS = 0.f, m = -1e30f;
  const bool don = (sl == 0 && tid < 64);
  for (int c0 = 0; c0 < 64; c0 += 16) {
    float U[16], Mc[16], Bl[16], Nu[16];
#pragma unroll
    for (int i = 0; i < 16; ++i) {
      int cid = bh * 64 + c0 + i;
      U[i] = st[(size_t)cid * 4096 + e]; Mc[i] = mlsc[cid]; Bl[i] = mlsc[1024 + cid];
      Nu[i] = don ? nv[cid * 64 + tid] : 0.f;
    }
#pragma unroll
    for (int i = 0; i < 16; ++i) {
      int cid = bh * 64 + c0 + i;
      float mnew = fmaxf(Bl[i] + m, Mc[i]);
      float dec = expf(Bl[i] + m - mnew), us = expf(Mc[i] - mnew);
      st[(size_t)cid * 4096 + e] = S;
      S = dec * S + us * U[i];
      if (don) { nv[cid * 64 + tid] = nS; nS = dec * nS + us * Nu[i]; }
      if (sl == 0 && tid == 0) mlsc[2048 + cid] = m;
      m = mnew;
    }
  }
}

DI void job_ml_C(const Params& p, int layer, int cid, char* smem) {
  const int tid = otid(), lane = tid & 63, w = tid >> 6, r = lane & 31, h = lane >> 5;
  const int bh = cid >> 6, c = cid & 63, b = bh >> 2, hd = bh & 3;
  const int tb = b * SEQL + c * 64;
  const u16* cols = (const u16*)(PWS + OFF_COLS);
  float* B0 = (float*)smem; float* B1 = B0 + 64 * 65; float* B2 = B1 + 64 * 65; float* B3 = B2 + 64 * 65;
  float* s_bc = B3 + 64 * 65; float* s_as = s_bc + 64; float* s_mt = s_as + 64; float* s_wi = s_mt + 64; float* s_nv = s_wi + 64; float* s_den = s_nv + 64;
  const float* mlsc = (const float*)(PWS + OFF_MLSC);
  if (w == 0) {
    const u16* row = cols + (size_t)(tb + lane) * NC;
    float fgv = bf2f(row[C_FG + hd]) + p.ml_f_bias[layer * 4 + hd];
    float igv = bf2f(row[C_IG + hd]) + p.ml_i_bias[layer * 4 + hd];
    float lf = logsigmoidf_(fgv);
    float bc = scan_add(lf, lane);
    float as = igv - bc;
    float pm = scan_max(as, lane);
    float m = mlsc[2048 + cid];
    float inter = bc + m;
    float mt = fmaxf(inter, bc + pm);
    s_bc[lane] = bc; s_as[lane] = as; s_mt[lane] = mt; s_wi[lane] = expf(inter - mt);
    s_nv[lane] = ((const float*)(PWS + OFF_MLN))[cid * 64 + lane];
  }
  {
    const int seg = tid & 7;
    {
      float cw[4][8], cbias[8];
      load_convw(p, layer, hd * 64 + seg * 8, cw, cbias);
#pragma unroll
      for (int i = 0; i < 2; ++i) {
        int s = (tid >> 3) + 32 * i;
        float qv[8];
        conv8(cols, cw, cbias, tb + s, c * 64 + s, C_MQ + hd * 64 + seg * 8, qv);
#pragma unroll
        for (int k = 0; k < 8; ++k) B0[s * 65 + seg * 8 + k] = qv[k];
      }
    }
    {
      float cw[4][8], cbias[8];
      load_convw(p, layer, 256 + hd * 64 + seg * 8, cw, cbias);
#pragma unroll
      for (int i = 0; i < 2; ++i) {
        int s = (tid >> 3) + 32 * i;
        float kv[8], vv[8];
        conv8(cols, cw, cbias, tb + s, c * 64 + s, C_MK + hd * 64 + seg * 8, kv);
        ld8bf(cols + (size_t)(tb + s) * NC + C_MV + hd * 64 + seg * 8, vv);
#pragma unroll
        for (int k = 0; k < 8; ++k) { B1[s * 65 + seg * 8 + k] = kv[k] * 0.125f; B2[s * 65 + seg * 8 + k] = vv[k]; }
      }
    }
    load_state(B3, (const float*)(PWS + OFF_MLST) + (size_t)cid * 4096, tid);
  }
  __syncthreads();
  const int th = w >> 1, sh = w & 1;
  f32x16 qk = zero16();
  if (!(th == 0 && sh == 1)) mm32(qk, B0 + th * 32 * 65, 65, 1, B1 + sh * 32 * 65, 1, 65, r, h);
  __syncthreads();
#pragma unroll
  for (int reg = 0; reg < 16; ++reg) {
    int t = th * 32 + crow(reg, h), s = sh * 32 + r;
    float dm = (s <= t) ? expf(s_bc[t] + s_as[s] - s_mt[t]) : 0.f;
    B1[t * 65 + s] = qk[reg] * dm;
  }
  for (int e = tid; e < 4096; e += 256) { int t = e >> 6, d = e & 63; B0[t * 65 + d] *= s_wi[t]; }
  __syncthreads();
  const int vh = w & 1;
  f32x16 o = zero16();
  mm32(o, B0 + th * 32 * 65, 65, 1, B3 + vh * 32, 65, 1, r, h);
  mm32(o, B1 + th * 32 * 65, 65, 1, B2 + vh * 32, 65, 1, r, h);
  if (tid < 64) {
    float dsum = 0.f;
    for (int d = 0; d < 64; ++d) dsum = fmaf(B0[tid * 65 + d], s_nv[d], dsum);
    float ssum = 0.f;
    for (int s = 0; s < 64; ++s) ssum += B1[tid * 65 + s];
    s_den[tid] = dsum + ssum;
  }
  __syncthreads();
#pragma unroll
  for (int reg = 0; reg < 16; ++reg) {
    int t = th * 32 + crow(reg, h);
    float dn = fmaxf(fabsf(s_den[t]), expf(-s_mt[t]));
    B3[t * 65 + vh * 32 + r] = o[reg] / dn;
  }
  __syncthreads();
  finish_rows<false>(B3, p.ml_o_gain + layer * 64, cols, C_MOG, (u16*)(PWS + OFF_H), 768, tb, hd);
}


#define XB_TMO      128
#define XB_XCNT(j)  (256  + 64 * (j))
#define XB_XSUB(j)  (1280 + 64 * (j))
#define XB_XGEN(j)  (2304 + 64 * (j))
#define XB_TOP      3328
#define XB_TOPGEN   3392
#define XCD_BAR_WORDS 3456
#define XB_SPIN_CAP (1u << 20)
#define LAS __attribute__((address_space(3)))
DI unsigned xb_ld(unsigned* p) { return __hip_atomic_load(p, __ATOMIC_RELAXED, __HIP_MEMORY_SCOPE_AGENT); }
DI unsigned xb_add(unsigned* p, unsigned v) { return __hip_atomic_fetch_add(p, v, __ATOMIC_RELAXED, __HIP_MEMORY_SCOPE_AGENT); }
DI unsigned xb_xcc_id() { return (unsigned)__builtin_amdgcn_s_getreg((3 << 11) | 20) & 0xFu; }
#define XB_SPIN(cond, bar) do { unsigned _sp = 0; while (cond) { __builtin_amdgcn_s_sleep(1); \
    if ((++_sp & 255u) == 0u) { if (xb_ld(&(bar)[XB_TMO])) break; if (_sp > XB_SPIN_CAP) { atomicAdd(&(bar)[XB_TMO], 1u); break; } } } } while (0)
struct XcdBarrier { unsigned* bar; unsigned x; volatile LAS unsigned* st; };
DI XcdBarrier xcd_barrier_post(unsigned* bar, volatile LAS unsigned* st) {
  XcdBarrier b; b.bar = bar; b.x = xb_xcc_id(); b.st = st;
  if (__builtin_amdgcn_workitem_id_x() == 0) (void)xb_add(&bar[XB_XCNT(b.x)], 1u);
  return b;
}
DI void xcd_barrier_complete(unsigned* bar, unsigned x, unsigned& nloc, unsigned& nx) {
  const unsigned G = gridDim.x * gridDim.y * gridDim.z;
  unsigned sum, cnt, mine, sp = 0u;
  for (;;) {
    sum = 0u; cnt = 0u; mine = 0u;
#pragma unroll
    for (unsigned j = 0; j < 16; ++j) { const unsigned c = xb_ld(&bar[XB_XCNT(j)]); sum += c; cnt += (c > 0u) ? 1u : 0u; mine = (j == x) ? c : mine; }
    if (sum == G) break;
    __builtin_amdgcn_s_sleep(1);
    if ((++sp & 255u) == 0u) { if (xb_ld(&bar[XB_TMO])) break; if (sp > XB_SPIN_CAP) { atomicAdd(&bar[XB_TMO], 1u); break; } }
  }
  nloc = mine > 0u ? mine : 1u; nx = cnt > 0u ? cnt : 1u;
}
DI void xcd_barrier(const XcdBarrier& b) {
  asm volatile("s_waitcnt vmcnt(0)" ::: "memory");
  __syncthreads();
  if (__builtin_amdgcn_workitem_id_x() == 0) {
    unsigned* bar = b.bar;
    __builtin_amdgcn_s_waitcnt(0);
    unsigned nloc = b.st[0], nx = b.st[1];
    if (nloc == 0u) { xcd_barrier_complete(bar, b.x, nloc, nx); b.st[0] = nloc; b.st[1] = nx; }
    const unsigned old = xb_add(&bar[XB_XSUB(b.x)], 1u);
    const unsigned gen = old / nloc;
    if (old + 1u == (gen + 1u) * nloc) {
      __builtin_amdgcn_fence(__ATOMIC_RELEASE, "agent");
      asm volatile("s_waitcnt vmcnt(0)" ::: "memory");
      const unsigned og = xb_add(&bar[XB_TOP], 1u);
      const unsigned tg = og / nx;
      if (og + 1u == (tg + 1u) * nx) xb_add(&bar[XB_TOPGEN], 1u);
      else XB_SPIN(xb_ld(&bar[XB_TOPGEN]) == tg, bar);
      __builtin_amdgcn_fence(__ATOMIC_ACQUIRE, "agent");
      xb_add(&bar[XB_XGEN(b.x)], 1u);
      asm volatile("s_waitcnt vmcnt(0)" ::: "memory");
    } else {
      XB_SPIN(xb_ld(&bar[XB_XGEN(b.x)]) == gen, bar);
      __builtin_amdgcn_fence(__ATOMIC_ACQUIRE, "agent");
      asm volatile("s_waitcnt vmcnt(0)" ::: "memory");
    }
  }
  __syncthreads();
}

DI int next_job(int* ctr, int* s_job) {
  __syncthreads();
  if (otid() == 0) *s_job = atomicAdd(ctr, 1);
  __syncthreads();
  return *s_job;
}

struct ConvDesc { const float* src; int K, Nsrc, Ndst, mode; size_t dst; };

__global__ void __launch_bounds__(256, 2) fwd_megakernel(Params p) {
  p.x = asg(p.x);
  p.mem = asg(p.mem);
  p.lb_param = asg(p.lb_param);
  p.norm_mix = asg(p.norm_mix);
  p.w_in = asg(p.w_in);
  p.w_out = asg(p.w_out);
  p.hg_o_gain = asg(p.hg_o_gain);
  p.dsa_kv_gain = asg(p.dsa_kv_gain);
  p.dsa_w_uk = asg(p.dsa_w_uk);
  p.dsa_w_uv = asg(p.dsa_w_uv);
  p.dsa_q_gain = asg(p.dsa_q_gain);
  p.dsa_k_gain = asg(p.dsa_k_gain);
  p.dsa_idxk_gain = asg(p.dsa_idxk_gain);
  p.nsa_pos_k = asg(p.nsa_pos_k);
  p.nsa_pos_v = asg(p.nsa_pos_v);
  p.nsa_k_w1 = asg(p.nsa_k_w1);
  p.nsa_k_w2 = asg(p.nsa_k_w2);
  p.nsa_v_w1 = asg(p.nsa_v_w1);
  p.nsa_v_w2 = asg(p.nsa_v_w2);
  p.nsa_q_gain = asg(p.nsa_q_gain);
  p.nsa_k_gains = asg(p.nsa_k_gains);
  p.ml_conv_w = asg(p.ml_conv_w);
  p.ml_conv_b = asg(p.ml_conv_b);
  p.ml_i_bias = asg(p.ml_i_bias);
  p.ml_f_bias = asg(p.ml_f_bias);
  p.ml_o_gain = asg(p.ml_o_gain);
  p.norm_xa = asg(p.norm_xa);
  p.norm_mem = asg(p.norm_mem);
  p.xa_wq = asg(p.xa_wq);
  p.xa_wkv = asg(p.xa_wkv);
  p.xa_wo = asg(p.xa_wo);
  p.xa_q_gain = asg(p.xa_q_gain);
  p.xa_k_gain = asg(p.xa_k_gain);
  p.norm_ffn = asg(p.norm_ffn);
  p.ffn_w13 = asg(p.ffn_w13);
  p.ffn_w2 = asg(p.ffn_w2);
  p.out = asg(p.out);
  cg::grid_group grid = cg::this_grid();
  __shared__ __attribute__((aligned(16))) char smem[SMEM_BYTES];
  int* s_job = (int*)(smem + SMEM_BYTES - 16);
  volatile LAS unsigned* xst = (volatile LAS unsigned*)(smem + SMEM_BYTES - 32);
  if (otid() == 0) { xst[0] = 0u; xst[1] = 0u; }
  __syncthreads();
  XcdBarrier xb = xcd_barrier_post((unsigned*)(p.ws + OFF_BAR), xst);
  int* ctr0 = (int*)(PWS + OFF_CTR);
  u16* WB = (u16*)(PWS + OFF_WB);
  u16* cols = (u16*)(PWS + OFF_COLS);
  u16* Hb = (u16*)(PWS + OFF_H);
  const int tid = otid();

  for (int ph2 = 0; ph2 < 2 * NPHASE; ++ph2) {
    const int ph = ph2 >> 1;
    const int layer = ph == 0 ? 0 : (ph - 1) / 14;
    const int kind = ph == 0 ? -1 : (ph - 1) % 14;
    if ((ph2 & 1) && DBG_REP == 99) { xcd_barrier(xb); continue; }
    if ((ph2 & 1) && kind != DBG_REP) continue;
    int* ctr = ctr0 + ((ph2 & 1) ? 32 : 0);
    const int sub = (ph2 & 1) ? DBG_SUB : 15;
    const u16* WL = WB + (size_t)layer * W_LAYER;
    int j;
    if (ph == 0) {
      const int NBIAS = 64, NUKV = 2, NROPE = 192, NMEM = 128, NCONV = 936 * 2, NX = 1024;
      const int total = NBIAS + NUKV + NROPE + NMEM + NCONV + NX;
      while ((j = next_job(&ctr[ph], s_job)) < total) {
        if (j < NBIAS) {
          int l = j >> 5, kv = (j >> 4) & 1, ng = j & 15;
          const float* pe = (kv ? p.nsa_pos_v : p.nsa_pos_k) + (size_t)l * 2048;
          const float* w1 = (kv ? p.nsa_v_w1 : p.nsa_k_w1) + (size_t)l * 2048 * 256;
          int nl = tid & 15, kp = tid >> 4;
          float a = 0.f;
#pragma unroll 8
          for (int k = kp * 128; k < kp * 128 + 128; ++k) a = fmaf(pe[k], w1[(size_t)k * 256 + ng * 16 + nl], a);
          float* red = (float*)smem;
          red[kp * 16 + nl] = a;
          __syncthreads();
          if (tid < 16) {
            float t = 0.f;
            for (int q = 0; q < 16; ++q) t += red[q * 16 + tid];
            ((float*)(PWS + OFF_BIAS1))[(l * 2 + kv) * 256 + ng * 16 + tid] = t;
          }
        } else if ((j -= NBIAS) < NUKV) {
          u16* wt = (u16*)(PWS + OFF_WUKV) + (size_t)j * 128 * 128;
          const float* uk = p.dsa_w_uk + (size_t)j * 128 * 64;
          const float* uv = p.dsa_w_uv + (size_t)j * 128 * 64;
          for (int e = tid; e < 128 * 128; e += 256) { int n = e >> 7, k = e & 127; wt[e] = f2bf(n < 64 ? uk[k * 64 + n] : uv[k * 64 + (n - 64)]); }
        } else if ((j -= NUKV) < NROPE) {
          int e = j * 256 + tid;
          int pos = e / 12, f = e % 12;
          float inv = f < 8 ? exp2f(-(float)f * (18.931568569324174f / 8.f)) : exp2f(-(float)(f - 8) * (18.931568569324174f / 4.f));
          float angf = (float)pos * inv;
          double ang = (double)angf;
          double k = rint(ang * 0.15915494309189535);
          float rr = (float)(ang - k * 6.283185307179586);
          float2 cs = make_float2(cosf(rr), sinf(rr));
          if (f < 8) ((float2*)(PWS + OFF_ROPE64))[pos * 8 + f] = cs; else ((float2*)(PWS + OFF_ROPE32))[pos * 4 + (f - 8)] = cs;
        } else if ((j -= NROPE) < NMEM) {
          int l = j >> 6, row0 = (j & 63) * 16;
          job_rmsnorm(p.mem, p.norm_mem + l * 1024, (u16*)(PWS + OFF_MEMH) + (size_t)l * 1024 * 1024, nullptr, row0);
        } else if ((j -= NMEM) < NCONV) {
          int l = j / 936, q = j % 936;
          const float* src; int K, Nsrc, mode, ntn; size_t dst;
          if (q < 216) { src = p.w_in + (size_t)l * 1024 * IN_COLS; K = 1024; Nsrc = IN_COLS; mode = 1; dst = WO_IN; ntn = 54; }
          else if ((q -= 216) < 64) { src = p.w_out + (size_t)l * 1024 * 1024; K = 1024; Nsrc = 1024; mode = 0; dst = WO_OUT; ntn = 16; }
          else if ((q -= 64) < 16) { src = p.xa_wq + (size_t)l * 1024 * 256; K = 1024; Nsrc = 256; mode = 0; dst = WO_Q; ntn = 4; }
          else if ((q -= 16) < 32) { src = p.xa_wkv + (size_t)l * 1024 * 512; K = 1024; Nsrc = 512; mode = 0; dst = WO_KV; ntn = 8; }
          else if ((q -= 32) < 16) { src = p.xa_wo + (size_t)l * 256 * 1024; K = 256; Nsrc = 1024; mode = 0; dst = WO_O; ntn = 16; }
          else if ((q -= 16) < 352) { src = p.ffn_w13 + (size_t)l * 1024 * 5632; K = 1024; Nsrc = 5632; mode = 2; dst = WO_13; ntn = 88; }
          else if ((q -= 352) < 176) { src = p.ffn_w2 + (size_t)l * 2816 * 1024; K = 2816; Nsrc = 1024; mode = 0; dst = WO_2; ntn = 16; }
          else if ((q -= 176) < 32) { src = p.nsa_k_w1 + (size_t)l * 2048 * 256; K = 2048; Nsrc = 256; mode = 0; dst = WO_KW1; ntn = 4; }
          else { q -= 32; src = p.nsa_v_w1 + (size_t)l * 2048 * 256; K = 2048; Nsrc = 256; mode = 0; dst = WO_VW1; ntn = 4; }
          job_convert(src, K, Nsrc, WB + (size_t)l * W_LAYER + dst, mode, q % ntn, q / ntn, (float*)smem);
        } else {
          j -= NCONV;
          job_rmsnorm(p.x, p.norm_mix, Hb, p.out, j * 16);
        }
      }
    } else if (kind == 0) {
      const int NG = 128 * 27, NM = layer == 0 ? 2 * 8 * 4 : 0;
      while ((j = next_job(&ctr[ph], s_job)) < NG + NM) {
        if (j < NG) gemm_tile<0, 0>(Hb, 1024, WL + WO_IN, 1024, j / 27, j % 27, smem, cols, NC, nullptr, 0);
        else { int q = j - NG; int l = q >> 5, tm = (q >> 2) & 7, tn = q & 3;
          gemm_tile<0, 0>((const u16*)(PWS + OFF_MEMH) + (size_t)l * 1024 * 1024, 1024, WB + (size_t)l * W_LAYER + WO_KV, 1024, tm, tn, smem,
                          (u16*)(PWS + OFF_MEMKV) + (size_t)l * 1024 * 512, 512, nullptr, 0); }
      }
    } else if (kind == 1) {
      const int NP = 512, NM = layer == 0 ? 64 : 0;
      while ((j = next_job(&ctr[ph], s_job)) < NP + NM) {
        if (j < NP) job_prep(p, layer, j, smem); else job_memkv_post(p, j - NP, smem);
      }
    } else if (kind == 2) {
      const int ND = 512, NCG = 32, NML = 1024, NHG = 1024;
      while ((j = next_job(&ctr[ph], s_job)) < ND + NCG + NML + NHG) {
        if (j < ND) { if (sub & 1) job_dsa(p, layer, j & 3, 127 - (j >> 2), smem, 0); }
        else if ((j -= ND) < NCG) { if (sub & 2) {
          int kv = j >> 4, tm = (j >> 1) & 7, tn = j & 1;
          gemm_tile<3, 1>(cols, 0, WL + (kv ? WO_VW1 : WO_KW1), 2048, tm, tn, smem, (u16*)(PWS + OFF_HID) + kv * 256, 512,
                          (const float*)(PWS + OFF_BIAS1) + (layer * 2 + kv) * 256, kv ? C_VC : C_KC); }
        } else if ((j -= NCG) < NML) { if (sub & 4) job_ml_A(p, layer, j, smem); }
        else { if (sub & 8) job_hg_A(p, layer, j - NML, smem); }
      }
    } else if (kind == 3) {
      const int NS = 256, NC2 = 128;
      while ((j = next_job(&ctr[ph], s_job)) < 512 + 2 * NS + NC2) {
        if (j < 512) job_dsa(p, layer, j & 3, 127 - (j >> 2), smem, 1);
        else if ((j -= 512) < NS) job_ml_scan(p, j); else if (j < 2 * NS) job_hg_scan(p, j - NS); else job_cmp2(p, layer, j - 2 * NS, smem);
      }
    } else if (kind == 4) {
      const int NN = 512, NML = 1024, NHG = 1024;
      while ((j = next_job(&ctr[ph], s_job)) < NN + NML + NHG) {
        if (j < NN) { if (sub & 1) job_nsa(p, layer, j & 3, 127 - (j >> 2), smem); }
        else if ((j -= NN) < NML) { if (sub & 2) job_ml_C(p, layer, j, smem); }
        else { if (sub & 4) job_hg_C(p, layer, j - NML, smem); }
      }
    } else if (kind == 5) {
      if (!(DBG_SKIP & 1)) while ((j = next_job(&ctr[ph], s_job)) < 128 * 8) gemm_tile<1, 0>(Hb, 1024, WL + WO_OUT, 1024, j >> 3, j & 7, smem, p.out, 1024, nullptr, 0, DBG_MK0, DBG_MK1);
    } else if (kind == 6 || kind == 10 || kind == 13) {
      if (kind == 13 && layer == 1) {   }
      else {
        const float* g = kind == 6 ? p.norm_xa + layer * 1024 : (kind == 10 ? p.norm_ffn + layer * 1024 : p.norm_mix + (layer + 1) * 1024);
        while ((j = next_job(&ctr[ph], s_job)) < 1024) job_rmsnorm(p.out, g, Hb, nullptr, j * 16);
      }
    } else if (kind == 7) {
      while ((j = next_job(&ctr[ph], s_job)) < 128 * 2) gemm_tile<0, 0>(Hb, 1024, WL + WO_Q, 1024, j >> 1, j & 1, smem, (u16*)(PWS + OFF_XQ), 256, nullptr, 0);
    } else if (kind == 8) {
      while ((j = next_job(&ctr[ph], s_job)) < 512) job_xattn(p, layer, j >> 7, (j >> 5) & 3, j & 31, smem);
    } else if (kind == 9) {
      if (!(DBG_SKIP & 2)) while ((j = next_job(&ctr[ph], s_job)) < 128 * 8) gemm_tile<1, 0>((const u16*)(PWS + OFF_XO), 256, WL + WO_O, 256, j >> 3, j & 7, smem, p.out, 1024, nullptr, 0);
    } else if (kind == 11) {
      while ((j = next_job(&ctr[ph], s_job)) < 128 * 44) gemm_tile<2, 0>(Hb, 1024, WL + WO_13, 1024, j / 44, j % 44, smem, (u16*)(PWS + OFF_G), DFF, nullptr, 0);
    } else if (kind == 12) {
      if (!(DBG_SKIP & 4)) while ((j = next_job(&ctr[ph], s_job)) < 128 * 8) gemm_tile<1, 0>((const u16*)(PWS + OFF_G), DFF, WL + WO_2, DFF, j >> 3, j & 7, smem, p.out, 1024, nullptr, 0);
    }
    if (ph2 + 1 < 2 * NPHASE) { if (p.use_cg) grid.sync(); else xcd_barrier(xb); }
  }
}

extern "C" void kernel_launch(void* const* d_in, const int* in_sizes, int n_in, void* d_out, int out_size, void* d_ws, size_t ws_size,
                              hipStream_t stream) {
  static int grid_blocks = 0;
  if (!grid_blocks) {
    int dev = 0, cus = 0, per_cu = 0;
    hipGetDevice(&dev);
    hipDeviceGetAttribute(&cus, hipDeviceAttributeMultiprocessorCount, dev);
    hipOccupancyMaxActiveBlocksPerMultiprocessor(&per_cu, fwd_megakernel, 256, 0);
    if (per_cu > 2) per_cu = 2;
    if (per_cu < 1) per_cu = 1;
    grid_blocks = cus * per_cu;
  }
  Params p{};
  const float** pp = (const float**)&p;
  for (int i = 0; i < 36; ++i) pp[i] = (const float*)d_in[i];
  p.out = (float*)d_out;
  p.ws = (char*)d_ws;
  p.use_cg = 0; p.pad_ = 0;
  hipMemsetAsync(d_ws, 0, 4096 + 16384, stream);
  void* args[] = {&p};
  hipError_t e = hipLaunchCooperativeKernel((void*)fwd_megakernel, dim3(grid_blocks), dim3(256), args, 0, stream);
  if (e != hipSuccess) fprintf(stderr, "cooperative launch failed: %s (grid %d)\n", hipGetErrorString(e), grid_blocks);
}
```

```cpp
#include <hip/hip_runtime.h>
#include <hip/hip_bf16.h>
#include <hip/hip_cooperative_groups.h>
#include <cstdio>
namespace cg = cooperative_groups;

#define DI __device__ __forceinline__
typedef unsigned short u16;
typedef unsigned long long u64;
typedef __attribute__((ext_vector_type(8))) short bf16x8;
typedef __attribute__((ext_vector_type(4))) short s16x4;
typedef __attribute__((ext_vector_type(16))) float f32x16;
typedef __attribute__((ext_vector_type(2))) float f32x2;
typedef __attribute__((ext_vector_type(4))) unsigned u32x4;
typedef __attribute__((ext_vector_type(4))) float f32x4v;
typedef __attribute__((ext_vector_type(2))) __bf16 bf16x2v;

constexpr int T_TOK = 16384, SEQL = 4096, NBATCH = 4, DM = 1024;
constexpr int NC = 3456;
constexpr int C_HGQ = 0, C_HGF = 256, C_HGI = 512, C_HGG = 768;
constexpr int C_DQ = 1024, C_CKV = 1280, C_IQ = 1408;
constexpr int C_NQ = 1664, C_KC = 1920, C_VC = 1984, C_KS = 2048, C_VS = 2112, C_KW = 2176, C_VW = 2240;
constexpr int C_MQ = 2304, C_MK = 2560, C_MV = 2816, C_MOG = 3072;
constexpr int C_IK = 3328, C_IW = 3360, C_GATES = 3368, C_IG = 3380, C_FG = 3384;
constexpr int IN_COLS = 3388, DFF = 2816;

constexpr size_t WO_IN = 0;
constexpr size_t WO_OUT = WO_IN + (size_t)NC * 1024;
constexpr size_t WO_Q = WO_OUT + 1024 * 1024;
constexpr size_t WO_KV = WO_Q + 256 * 1024;
constexpr size_t WO_O = WO_KV + 512 * 1024;
constexpr size_t WO_13 = WO_O + 1024 * 256;
constexpr size_t WO_2 = WO_13 + (size_t)5632 * 1024;
constexpr size_t WO_KW1 = WO_2 + (size_t)1024 * 2816;
constexpr size_t WO_VW1 = WO_KW1 + 256 * 2048;
constexpr size_t W_LAYER = WO_VW1 + 256 * 2048;

constexpr size_t al256(size_t x) { return (x + 255) & ~(size_t)255; }
constexpr size_t OFF_CTR = 0;
constexpr size_t OFF_BAR = 4096;
constexpr size_t OFF_ROPE64 = 4096 + 16384;
constexpr size_t OFF_ROPE32 = OFF_ROPE64 + 4096 * 8 * 8;
constexpr size_t OFF_BIAS1 = OFF_ROPE32 + 4096 * 4 * 8;
constexpr size_t OFF_WB = al256(OFF_BIAS1 + 4096);
constexpr size_t OFF_COLS = al256(OFF_WB + 2 * W_LAYER * 2);
constexpr size_t OFF_H = al256(OFF_COLS + (size_t)T_TOK * NC * 2);
constexpr size_t OFF_HGST = al256(OFF_H + (size_t)T_TOK * 1024 * 2);
constexpr size_t OFF_MLST = al256(OFF_HGST + (size_t)1024 * 4096 * 4);
constexpr size_t OFF_HGD = al256(OFF_MLST + (size_t)1024 * 4096 * 4);
constexpr size_t OFF_MLN = al256(OFF_HGD + 1024 * 64 * 4);
constexpr size_t OFF_MLSC = al256(OFF_MLN + 1024 * 64 * 4);
constexpr size_t OFF_DK = al256(OFF_MLSC + 3 * 1024 * 4);
constexpr size_t OFF_DVT = al256(OFF_DK + (size_t)T_TOK * 64 * 2);
constexpr size_t OFF_VST = al256(OFF_DVT + (size_t)T_TOK * 64 * 2);
constexpr size_t OFF_VWT = al256(OFF_VST + (size_t)T_TOK * 64 * 2);
constexpr size_t OFF_KCMP = al256(OFF_VWT + (size_t)T_TOK * 64 * 2);
constexpr size_t OFF_VCMPT = al256(OFF_KCMP + 4 * 256 * 64 * 2);
constexpr size_t OFF_HID = al256(OFF_VCMPT + 4 * 256 * 64 * 2);
constexpr size_t OFF_MEMH = al256(OFF_HID + 1024 * 512 * 2);
constexpr size_t OFF_MEMKV = al256(OFF_MEMH + 2 * 1024 * 1024 * 2);
constexpr size_t OFF_MEMVT = al256(OFF_MEMKV + 2 * 1024 * 512 * 2);
constexpr size_t OFF_IKC = al256(OFF_MEMVT + 2 * 4 * 256 * 256 * 2);
constexpr size_t OFF_WUKV = al256(OFF_IKC + (size_t)T_TOK * 32 * 2);
constexpr size_t OFF_KSC = al256(OFF_WUKV + 2 * 128 * 128 * 2);
constexpr size_t OFF_KWC = al256(OFF_KSC + (size_t)T_TOK * 64 * 2);
constexpr size_t OFF_END = al256(OFF_KWC + (size_t)T_TOK * 64 * 2);
static_assert(OFF_END <= (size_t)256 * 1024 * 1024, "workspace overflow");
constexpr size_t OFF_XQ = OFF_HGST;
constexpr size_t OFF_XO = OFF_MLST;
constexpr size_t OFF_G = OFF_COLS;

constexpr int SMEM_BYTES = 75776;
constexpr int NPHASE = 28;
#define DBG_SKIP 0
#define DBG_REP -2
#define DBG_SUB 15
#define DBG_ATT_REP 1
#define DBG_EPI_REP 1
#define DBG_SELREP 1
#define DBG_SLC_REP 1
#define DBG_SWA_REP 1
#define DBG_MK0 0
#define DBG_MK1 16

struct Params {
  const float* x; const float* mem; const float* lb_param; const float* norm_mix; const float* w_in; const float* w_out;
  const float* hg_o_gain; const float* dsa_kv_gain; const float* dsa_w_uk; const float* dsa_w_uv; const float* dsa_q_gain;
  const float* dsa_k_gain; const float* dsa_idxk_gain; const float* nsa_pos_k; const float* nsa_pos_v; const float* nsa_k_w1;
  const float* nsa_k_w2; const float* nsa_v_w1; const float* nsa_v_w2; const float* nsa_q_gain; const float* nsa_k_gains;
  const float* ml_conv_w; const float* ml_conv_b; const float* ml_i_bias; const float* ml_f_bias; const float* ml_o_gain;
  const float* norm_xa; const float* norm_mem; const float* xa_wq; const float* xa_wkv; const float* xa_wo; const float* xa_q_gain;
  const float* xa_k_gain; const float* norm_ffn; const float* ffn_w13; const float* ffn_w2;
  float* out; char* ws;
  int use_cg; int pad_;
};

DI int otid() { int t = __builtin_amdgcn_workitem_id_x(); asm volatile("" : "+v"(t)); return t; }
typedef __attribute__((address_space(1))) char gchar_t;
DI char* oq(char* x) { gchar_t* g = (gchar_t*)x; asm volatile("" : "+s"(g)); return (char*)g; }
template <class T> DI T* asg(T* q) { return (T*)(__attribute__((address_space(1))) T*)q; }
#define PWS (oq(p.ws))
DI float bf2f(u16 v) { return __uint_as_float(((unsigned)v) << 16); }
DI unsigned pack2(float a, float b) { f32x2 v = {a, b}; return __builtin_bit_cast(unsigned, __builtin_convertvector(v, bf16x2v)); }
DI u16 f2bf(float a) { return (u16)(pack2(a, 0.f) & 0xffffu); }
DI float sigmoidf_(float x) { return 1.f / (1.f + expf(-x)); }
DI float siluf_(float x) { return x / (1.f + expf(-x)); }
DI int crow(int reg, int h) { return (reg & 3) + 8 * (reg >> 2) + 4 * h; }
DI f32x16 zero16() { f32x16 z; for (int i = 0; i < 16; ++i) z[i] = 0.f; return z; }
#define MFMA_BF(a, b, c) __builtin_amdgcn_mfma_f32_32x32x16_bf16((a), (b), (c), 0, 0, 0)
#define MFMA_F32(a, b, c) __builtin_amdgcn_mfma_f32_32x32x2f32((a), (b), (c), 0, 0, 0)
DI float wave_sum(float v) { for (int o = 32; o; o >>= 1) v += __shfl_xor(v, o); return v; }
DI float wave_max(float v) { for (int o = 32; o; o >>= 1) v = fmaxf(v, __shfl_xor(v, o)); return v; }
DI void load4bf(const u16* p, float (&x)[4]) { uint2 v = *(const uint2*)p; x[0] = __uint_as_float(v.x << 16); x[1] = __uint_as_float(v.x & 0xffff0000u); x[2] = __uint_as_float(v.y << 16); x[3] = __uint_as_float(v.y & 0xffff0000u); }
DI void ld8bf(const u16* p, float (&x)[8]) {
  u32x4 v = *(const u32x4*)p;
  x[0] = __uint_as_float(v.x << 16); x[1] = __uint_as_float(v.x & 0xffff0000u);
  x[2] = __uint_as_float(v.y << 16); x[3] = __uint_as_float(v.y & 0xffff0000u);
  x[4] = __uint_as_float(v.z << 16); x[5] = __uint_as_float(v.z & 0xffff0000u);
  x[6] = __uint_as_float(v.w << 16); x[7] = __uint_as_float(v.w & 0xffff0000u);
}
DI void store4bf(u16* p, const float (&x)[4]) { uint2 v; v.x = pack2(x[0], x[1]); v.y = pack2(x[2], x[3]); *(uint2*)p = v; }

template <int W>
DI void rowop(float (&x)[4], int lg, const float* gain, bool do_norm, bool do_rope, int pos, const float2* ropetab) {
  if (do_norm) {
    float ss = x[0] * x[0] + x[1] * x[1] + x[2] * x[2] + x[3] * x[3];
#pragma unroll
    for (int o = W / 8; o >= 1; o >>= 1) ss += __shfl_xor(ss, o);
    float rstd = rsqrtf(ss * (1.f / W) + 1e-6f);
#pragma unroll
    for (int i = 0; i < 4; ++i) x[i] = x[i] * rstd * gain[lg * 4 + i];
  }
  if (do_rope) {
    constexpr int HALF = W / 8, LPH = HALF / 4;
    float xp[4];
#pragma unroll
    for (int i = 0; i < 4; ++i) xp[i] = __shfl_xor(x[i], LPH);
    const float4* tp = (const float4*)(ropetab + pos * HALF + (lg % LPH) * 4);
    const float4 c01 = tp[0], c23 = tp[1];
    const float cs[4] = {c01.x, c01.z, c23.x, c23.z};
    const float sn[4] = {c01.y, c01.w, c23.y, c23.w};
    const bool rot = lg < 2 * LPH;
    const bool isx2 = lg >= LPH;
#pragma unroll
    for (int i = 0; i < 4; ++i) {
      float rv = isx2 ? (x[i] * cs[i] + xp[i] * sn[i]) : (x[i] * cs[i] - xp[i] * sn[i]);
      x[i] = rot ? rv : x[i];
    }
  }
}

DI int map_in(int n) {
  if (n < 1664) return n;
  if (n < 2304) return n + 40;
  if (n < 3328) return n + 52;
  if (n < 3360) return 1664 + (n - 3328);
  if (n < 3368) return 1696 + (n - 3360);
  if (n < 3380) return 2344 + (n - 3368);
  if (n < 3388) return n;
  return -1;
}
DI int map_w13(int n) { int blk = n >> 6, w = n & 63; return w < 32 ? blk * 32 + w : 2816 + blk * 32 + (w - 32); }

DI void job_convert(const float* src, int K, int Nsrc, u16* dst, int mode, int tile_n, int tile_k4, float* sm) {
  const int tid = otid(), tx = tid & 15, ty = tid >> 4;
  int n = tile_n * 64 + tx * 4;
  int sn = mode == 0 ? n : (mode == 1 ? map_in(n) : map_w13(n));
  float4 v[16];
#pragma unroll
  for (int i = 0; i < 16; ++i) {
    int kl = ty + 16 * i;
    v[i] = sn >= 0 ? *(const float4*)(src + (size_t)(tile_k4 * 256 + kl) * Nsrc + sn) : make_float4(0.f, 0.f, 0.f, 0.f);
  }
#pragma unroll
  for (int i = 0; i < 16; ++i) {
    int kl = ty + 16 * i;
    float* t = sm + (kl >> 6) * (64 * 65) + (kl & 63) * 65 + tx * 4;
    t[0] = v[i].x; t[1] = v[i].y; t[2] = v[i].z; t[3] = v[i].w;
  }
  __syncthreads();
  int row = tid >> 2, seg = tid & 3;
#pragma unroll
  for (int q = 0; q < 4; ++q) {
    const float* t = sm + q * (64 * 65);
    unsigned pk[8];
#pragma unroll
    for (int i = 0; i < 8; ++i) pk[i] = pack2(t[(seg * 16 + 2 * i) * 65 + row], t[(seg * 16 + 2 * i + 1) * 65 + row]);
    uint4* d = (uint4*)(dst + (size_t)(tile_n * 64 + row) * K + tile_k4 * 256 + q * 64 + seg * 16);
    d[0] = make_uint4(pk[0], pk[1], pk[2], pk[3]);
    d[1] = make_uint4(pk[4], pk[5], pk[6], pk[7]);
  }
}

DI void job_rmsnorm(const float* X, const float* gain, u16* H, float* copy_out, int row0) {
  const int tid = otid(), lane = tid & 63, w = tid >> 6;
  for (int i = 0; i < 4; ++i) {
    int row = row0 + w * 4 + i;
    const float4* xr = (const float4*)(X + (size_t)row * 1024);
    float4 v[4];
    float ss = 0.f;
#pragma unroll
    for (int j = 0; j < 4; ++j) { v[j] = xr[lane + 64 * j]; ss += v[j].x * v[j].x + v[j].y * v[j].y + v[j].z * v[j].z + v[j].w * v[j].w; }
    ss = wave_sum(ss);
    float rstd = rsqrtf(ss * (1.f / 1024.f) + 1e-6f);
#pragma unroll
    for (int j = 0; j < 4; ++j) {
      float4 g = ((const float4*)gain)[lane + 64 * j];
      uint2 o; o.x = pack2(v[j].x * rstd * g.x, v[j].y * rstd * g.y); o.y = pack2(v[j].z * rstd * g.z, v[j].w * rstd * g.w);
      *(uint2*)(H + (size_t)row * 1024 + (lane + 64 * j) * 4) = o;
      if (copy_out) ((float4*)(copy_out + (size_t)row * 1024))[lane + 64 * j] = v[j];
    }
  }
}

template <int EPI, int AMODE>
DI void gemm_tile(const u16* __restrict__ A, int lda, const u16* __restrict__ Bt, int K, int tm, int tn, char* smem,
                  void* Cp, int ldc, const float* bias, int coff, int kt0 = 0, int kt1 = -1) {
  char* As = smem;
  char* Bs = smem + 32768;
  const int tid = otid(), lane = tid & 63, w = tid >> 6;
  const int r = lane & 31, h = lane >> 5, wm = w >> 1, wn = w & 1;
  const int lr8 = lane >> 3, lc = (lane & 7) ^ lr8;
  const u16* ap[4];
  const u16* bp[4];
#pragma unroll
  for (int q = 0; q < 4; ++q) {
    int rowl = (w * 4 + q) * 8 + lr8;
    int row = tm * 128 + rowl;
    if (AMODE == 0) ap[q] = A + (size_t)row * lda + lc * 8;
    else { int m = row < 1019 ? row : 1019; int b = m / 255, j = m % 255; ap[q] = A + ((size_t)(b * 4096 + 16 * j)) * NC + coff + lc * 8; }
    bp[q] = Bt + (size_t)(tn * 128 + rowl) * K + lc * 8;
  }
  const size_t akstep = AMODE == 0 ? 64 : NC;
  f32x4v acc[4][4];
#pragma unroll
  for (int a = 0; a < 4; ++a)
#pragma unroll
    for (int b = 0; b < 4; ++b) acc[a][b] = f32x4v{0.f, 0.f, 0.f, 0.f};
  const int nk = kt1 < 0 ? K / 64 : kt1;
#define G_ISSUE(BUF, KT) _Pragma("unroll") for (int q = 0; q < 4; ++q) { \
    __builtin_amdgcn_global_load_lds((const unsigned*)(ap[q] + (size_t)(KT) * akstep), (unsigned*)(As + (BUF) * 16384 + (w * 4 + q) * 1024), 16, 0, 0); \
    __builtin_amdgcn_global_load_lds((const unsigned*)(bp[q] + (size_t)(KT) * 64), (unsigned*)(Bs + (BUF) * 16384 + (w * 4 + q) * 1024), 16, 0, 0); }
  const int l15 = lane & 15, lq = lane >> 4, l7 = lane & 7;
  G_ISSUE(0, kt0)
  __syncthreads();
  for (int kt = kt0; kt < nk; ++kt) {
    const int cur = (kt - kt0) & 1;
    if (kt + 1 < nk) { G_ISSUE(cur ^ 1, kt + 1) }
    const char* Ac = As + cur * 16384;
    const char* Bc = Bs + cur * 16384;
#pragma unroll
    for (int s = 0; s < 2; ++s) {
      const int co = ((4 * s + lq) ^ l7) * 16;
      bf16x8 af[4], bfr[4];
#pragma unroll
      for (int mt = 0; mt < 4; ++mt) af[mt] = *(const bf16x8*)(Ac + (wm * 64 + mt * 16 + l15) * 128 + co);
#pragma unroll
      for (int nt = 0; nt < 4; ++nt) bfr[nt] = *(const bf16x8*)(Bc + (wn * 64 + nt * 16 + l15) * 128 + co);
#pragma unroll
      for (int mt = 0; mt < 4; ++mt)
#pragma unroll
        for (int nt = 0; nt < 4; ++nt) acc[mt][nt] = __builtin_amdgcn_mfma_f32_16x16x32_bf16(af[mt], bfr[nt], acc[mt][nt], 0, 0, 0);
    }
    __syncthreads();
  }
#undef G_ISSUE
#pragma unroll
  for (int mt = 0; mt < 4; ++mt) {
#pragma unroll
    for (int reg = 0; reg < 4; ++reg) {
      const int row = tm * 128 + wm * 64 + mt * 16 + lq * 4 + reg;
      if (EPI == 0) {
        u16* C = (u16*)Cp;
#pragma unroll
        for (int nt = 0; nt < 4; ++nt) C[(size_t)row * ldc + tn * 128 + wn * 64 + nt * 16 + l15] = f2bf(acc[mt][nt][reg]);
      } else if (EPI == 1) {
        float* C = (float*)Cp;
#pragma unroll
        for (int nt = 0; nt < 4; ++nt) { float* q = C + (size_t)row * ldc + tn * 128 + wn * 64 + nt * 16 + l15; *q = *q + acc[mt][nt][reg]; }
      } else if (EPI == 2) {
        u16* C = (u16*)Cp;
#pragma unroll
        for (int nt = 0; nt < 2; ++nt) {
          float av = acc[mt][nt][reg], bv = acc[mt][nt + 2][reg];
          C[(size_t)row * ldc + (tn * 2 + wn) * 32 + nt * 16 + l15] = f2bf(siluf_(av) * bv);
        }
      } else {
        u16* C = (u16*)Cp;
        if (row < 1020) {
#pragma unroll
          for (int nt = 0; nt < 4; ++nt) {
            int col = tn * 128 + wn * 64 + nt * 16 + l15;
            C[(size_t)row * ldc + col] = f2bf(fmaxf(acc[mt][nt][reg] + bias[col], 0.f));
          }
        }
      }
    }
  }
}

struct AttnAcc { f32x16 o0, o1; float m, l; };
DI void attn_init(AttnAcc& a) { a.o0 = zero16(); a.o1 = zero16(); a.m = -INFINITY; a.l = 0.f; }

template <class SrcF, class PosF>
DI void stage_q(u16* Qs, SrcF src, PosF posf, const float* gain, bool do_norm, bool do_rope, const float2* rope64, float scale) {
  const int tid = otid(), lg = tid & 15;
#pragma unroll
  for (int it = 0; it < 8; ++it) {
    int row = it * 16 + (tid >> 4);
    int slot = row >> 5, r = row & 31;
    float x[4];
    load4bf(src(slot, r) + lg * 4, x);
    rowop<64>(x, lg, gain, do_norm, do_rope, posf(slot, r), rope64);
#pragma unroll
    for (int i = 0; i < 4; ++i) x[i] *= scale;
    store4bf(Qs + (slot * 32 + r) * 72 + lg * 4, x);
  }
}
DI void load_qfrags(bf16x8 (&qf)[4], const u16* Qs, int slot, int r, int h) {
#pragma unroll
  for (int s = 0; s < 4; ++s) qf[s] = *(const bf16x8*)(Qs + (slot * 32 + r) * 72 + s * 16 + h * 8);
}

constexpr int KV_BUF = 32 * 72 + 64 * 40;

template <class TileF, class MaskF>
DI void attn_run(AttnAcc& a, const bf16x8 (&qf)[4], const u16* Kb, size_t kstride, int kmaxrow, const u16* Vtb, size_t vstride,
                 int ntiles, TileF tile_at, MaskF mask_at, u16* kvs) {
  const int tid = otid(), lane = tid & 63;
  const int r = lane & 31, h = lane >> 5;
  const int krow = tid >> 3, kseg = tid & 7, vrow = tid >> 2, vseg = tid & 3;
  if (ntiles <= 0) return;
  u32x4 rk, rv;
  {
    int kt = tile_at(0);
    int kr = kt * 32 + krow; kr = kr < kmaxrow ? kr : kmaxrow;
    rk = *(const u32x4*)(Kb + (size_t)kr * kstride + kseg * 8);
    rv = *(const u32x4*)(Vtb + (size_t)vrow * vstride + kt * 32 + vseg * 8);
  }
  __syncthreads();
  *(u32x4*)(kvs + krow * 72 + kseg * 8) = rk;
  *(u32x4*)(kvs + 32 * 72 + vrow * 40 + vseg * 8) = rv;
  __syncthreads();
  for (int i = 0; i < ntiles; ++i) {
    const int kt = tile_at(i);
    const int cur = i & 1;
    if (i + 1 < ntiles) {
      int kn = tile_at(i + 1);
      int kr = kn * 32 + krow; kr = kr < kmaxrow ? kr : kmaxrow;
      rk = *(const u32x4*)(Kb + (size_t)kr * kstride + kseg * 8);
      rv = *(const u32x4*)(Vtb + (size_t)vrow * vstride + kn * 32 + vseg * 8);
    }
    const u16* Kc = kvs + cur * KV_BUF;
    const u16* Vc = Kc + 32 * 72;
    f32x16 s = zero16();
#pragma unroll
    for (int ks = 0; ks < 4; ++ks) {
      bf16x8 kf = *(const bf16x8*)(Kc + r * 72 + ks * 16 + h * 8);
      s = MFMA_BF(kf, qf[ks], s);
    }
    unsigned mw = mask_at(kt);
    float mx = -INFINITY;
#pragma unroll
    for (int reg = 0; reg < 16; ++reg) {
      bool bit = (mw >> crow(reg, h)) & 1u;
      s[reg] = bit ? s[reg] : -INFINITY;
      mx = fmaxf(mx, s[reg]);
    }
    mx = fmaxf(mx, __shfl_xor(mx, 32));
    float mnew = fmaxf(a.m, mx);
    float mb = (mnew == -INFINITY) ? 0.f : mnew;
    float alpha = __builtin_amdgcn_exp2f(a.m - mb);
    float psum = 0.f;
#pragma unroll
    for (int reg = 0; reg < 16; ++reg) { float pv = __builtin_amdgcn_exp2f(s[reg] - mb); psum += pv; s[reg] = pv; }
    a.l = a.l * alpha + psum;
    a.m = mnew;
#pragma unroll
    for (int reg = 0; reg < 16; ++reg) { a.o0[reg] *= alpha; a.o1[reg] *= alpha; }
#pragma unroll
    for (int s2 = 0; s2 < 2; ++s2) {
      uint4 pu;
      pu.x = pack2(s[8 * s2 + 0], s[8 * s2 + 1]); pu.y = pack2(s[8 * s2 + 2], s[8 * s2 + 3]);
      pu.z = pack2(s[8 * s2 + 4], s[8 * s2 + 5]); pu.w = pack2(s[8 * s2 + 6], s[8 * s2 + 7]);
      bf16x8 pf = __builtin_bit_cast(bf16x8, pu);
#pragma unroll
      for (int dt = 0; dt < 2; ++dt) {
        uint2 lo = *(const uint2*)(Vc + (dt * 32 + r) * 40 + 16 * s2 + 4 * h);
        uint2 hi = *(const uint2*)(Vc + (dt * 32 + r) * 40 + 16 * s2 + 8 + 4 * h);
        uint4 vu = make_uint4(lo.x, lo.y, hi.x, hi.y);
        bf16x8 vf = __builtin_bit_cast(bf16x8, vu);
        if (dt == 0) a.o0 = MFMA_BF(vf, pf, a.o0); else a.o1 = MFMA_BF(vf, pf, a.o1);
      }
    }
    if (i + 1 < ntiles) {
      u16* Kn = kvs + (cur ^ 1) * KV_BUF;
      *(u32x4*)(Kn + krow * 72 + kseg * 8) = rk;
      *(u32x4*)(Kn + 32 * 72 + vrow * 40 + vseg * 8) = rv;
    }
    __syncthreads();
  }
}

DI unsigned lowmask(int n) { return n <= 0 ? 0u : (n >= 32 ? 0xffffffffu : ((1u << n) - 1u)); }

DI void dsa_scores(f32x16& sc, const bf16x8& kf0, const bf16x8& kf1, int h, const u16* iqrow, const float (&wq)[8]) {
  {
    bf16x8 q0 = *(const bf16x8*)(iqrow + 256 + h * 8);
    bf16x8 q1 = *(const bf16x8*)(iqrow + 256 + 16 + h * 8);
    sc = zero16();
    sc = MFMA_BF(kf0, q0, sc);
    sc = MFMA_BF(kf1, q1, sc);
  }
#pragma unroll
  for (int hh = 0; hh < 8; ++hh) {
    bf16x8 q0 = *(const bf16x8*)(iqrow + hh * 32 + h * 8);
    bf16x8 q1 = *(const bf16x8*)(iqrow + hh * 32 + 16 + h * 8);
    f32x16 a = zero16();
    a = MFMA_BF(kf0, q0, a);
    a = MFMA_BF(kf1, q1, a);
#pragma unroll
    for (int reg = 0; reg < 16; ++reg) sc[reg] = fmaf(wq[hh], __builtin_fabsf(a[reg]), sc[reg]);
    if (hh & 1) __builtin_amdgcn_sched_barrier(0);
  }
}
DI unsigned okey_of(float s) {
  unsigned u = __float_as_uint(s + 0.f);
  return u ^ ((unsigned)((int)u >> 31) | 0x80000000u);
}

template <int MODE>
DI void dsa_hist_tiles(unsigned* hist, const u16* ikc, const u16* iqrow, const float (&wq)[8], int w, int r, int h, int lane, int ntile, int tq,
                       unsigned mhi, unsigned mlo, int shm, int shd, bool last_idx) {
  int kt = w;
  bf16x8 n0, n1;
  if (kt < ntile) { const u16* kp = ikc + (size_t)(kt * 32 + r) * 32 + h * 8; n0 = *(const bf16x8*)kp; n1 = *(const bf16x8*)(kp + 16); }
  for (; kt < ntile; kt += 4) {
    bf16x8 kf0 = n0, kf1 = n1;
    if (kt + 4 < ntile) { const u16* kp = ikc + (size_t)((kt + 4) * 32 + r) * 32 + h * 8; n0 = *(const bf16x8*)kp; n1 = *(const bf16x8*)(kp + 16); }
    f32x16 sc;
    dsa_scores(sc, kf0, kf1, h, iqrow, wq);
#pragma unroll
    for (int reg = 0; reg < 16; ++reg) {
      const int sidx = kt * 32 + crow(reg, h);
      const unsigned ok = okey_of(sc[reg]);
      bool sel = sidx <= tq;
      unsigned digit;
      if (MODE == 0) { digit = ok >> 24; }
      else if (MODE == 1) { sel = sel && ((ok >> shm) == mhi); digit = (ok >> shd) & 255u; }
      else { const unsigned ri = 4095u - (unsigned)sidx; sel = sel && (ok == mhi) && (last_idx ? ((ri >> 4) == mlo) : true); digit = last_idx ? (ri & 15u) : (ri >> 4); }
      const int addr = sel ? (r * 257 + (int)digit) : (32 * 257 + lane);
      atomicAdd(&hist[addr], 1u);
    }
  }
}

constexpr int DSA_CAP = 64;

DI void job_dsa(const Params& p, int layer, int b, int tt, char* smem, int mode) {
  const int tid = otid(), lane = tid & 63, w = tid >> 6, r = lane & 31, h = lane >> 5;
  const int t0 = tt * 32, ntile = tt + 1;
  u16* cols = (u16*)(PWS + OFF_COLS);
  const u16* cb = cols + (size_t)b * SEQL * NC;
  const u16* ikc = (const u16*)(PWS + OFF_IKC) + (size_t)b * SEQL * 32;
  unsigned* hist = (unsigned*)smem;
  unsigned* candk = (unsigned*)smem;
  unsigned* candi = (unsigned*)(smem + 8192);
  unsigned* candn = (unsigned*)(smem + 16384);
  u16* Qs = (u16*)smem;
  u16* kvs = (u16*)(smem + 18432);
  unsigned* maskw = (unsigned*)(smem + 37888);
  unsigned* segs = (unsigned*)(smem + 54272);
  unsigned* prehi = (unsigned*)(smem + 55296);
  unsigned* prelo = (unsigned*)(smem + 55424);
  unsigned* need = (unsigned*)(smem + 55552);
  int* flags = (int*)(smem + 55680);
  const float2* rope64 = (const float2*)(PWS + OFF_ROPE64);

  unsigned* gmask = (unsigned*)((u16*)(PWS + OFF_H) + (size_t)(b * SEQL + t0) * 1024 + 256);
  if (mode == 0) {
  const u16* qrow = cb + (size_t)(t0 + r) * NC;
  u16* iqs = (u16*)(smem + 55808);
  for (int i = 0; i < 4; ++i) {
    int c = tid + 256 * i; int row = c >> 5, seg = c & 31;
    *(u32x4*)(iqs + row * 296 + seg * 8) = *(const u32x4*)(cb + (size_t)(t0 + row) * NC + C_IQ + seg * 8);
  }
  const u16* iqrow = iqs + r * 296;
  float wq[8];
  { float a[4], c[4]; load4bf(qrow + C_IW, a); load4bf(qrow + C_IW + 4, c);
#pragma unroll
    for (int i = 0; i < 4; ++i) { wq[i] = 0.5f * a[i]; wq[4 + i] = 0.5f * c[i]; } }

  if (tid < 32) { prehi[tid] = 0; prelo[tid] = 0; int nd = t0 + tid + 1; need[tid] = nd < 256 ? nd : 256; }
  if (tid < 16) flags[tid] = 0;
  __syncthreads();
  {
    int row = tid >> 3, lg = tid & 7;
    const u16* wr = cb + (size_t)(t0 + row) * NC + C_IW;
    float acc4[4] = {0.f, 0.f, 0.f, 0.f};
#pragma unroll
    for (int hh = 0; hh < 8; ++hh) {
      float wv = 0.5f * bf2f(wr[hh]);
      float x[4]; load4bf(iqs + row * 296 + hh * 32 + lg * 4, x);
#pragma unroll
      for (int i = 0; i < 4; ++i) acc4[i] = fmaf(wv, x[i], acc4[i]);
    }
    store4bf(iqs + row * 296 + 256 + lg * 4, acc4);
  }
  const int tq = t0 + r;
  int lastpass = 0;
  bool fast = false;
  for (int pass = 0; pass < 6; ++pass) {
    for (int i = tid; i < 32 * 257 + 64; i += 256) hist[i] = 0;
    __syncthreads();
    const unsigned mhi = prehi[r], mlo = prelo[r];
    if (pass == 0) dsa_hist_tiles<0>(hist, ikc, iqrow, wq, w, r, h, lane, ntile, tq, mhi, mlo, 0, 0, false);
    else if (pass < 4) dsa_hist_tiles<1>(hist, ikc, iqrow, wq, w, r, h, lane, ntile, tq, mhi, mlo, 32 - 8 * pass, 24 - 8 * pass, false);
    else dsa_hist_tiles<2>(hist, ikc, iqrow, wq, w, r, h, lane, ntile, tq, mhi, mlo, 0, 0, pass == 5);
    __syncthreads();
    {
      int row = tid >> 3, part = tid & 7;
      unsigned sum = 0;
      for (int i = 0; i < 32; ++i) sum += hist[row * 257 + part * 32 + i];
      segs[row * 8 + part] = sum;
    }
    __syncthreads();
    if ((tid & 7) == 0) {
      int row = tid >> 3;
      unsigned nd = need[row], cum = 0;
      int pt = 7;
      for (; pt > 0; --pt) { unsigned c = segs[row * 8 + pt]; if (cum + c >= nd) break; cum += c; }
      int bin = pt * 32 + 31;
      for (; bin > pt * 32; --bin) { unsigned c = hist[row * 257 + bin]; if (cum + c >= nd) break; cum += c; }
      unsigned cnt = hist[row * 257 + bin];
      if (pass < 4) prehi[row] = (prehi[row] << 8) | (unsigned)bin;
      else if (pass == 4) prelo[row] = (unsigned)bin;
      else prelo[row] = (prelo[row] << 4) | (unsigned)bin;
      need[row] = nd - cum;
      if (cnt != nd - cum) atomicOr(&flags[pass], 1);
      if (pass == 1 && cnt > (unsigned)DSA_CAP) atomicOr(&flags[8], 1);
    }
    __syncthreads();
    lastpass = pass;
    if (flags[pass] == 0) break;
    if (pass == 1 && flags[8] == 0) { fast = true; break; }
  }
  if (fast) {
    if (tid < 32) candn[tid] = 0;
    __syncthreads();
    const unsigned t16 = prehi[r];
    int kt = w;
    bf16x8 n0, n1;
    if (kt < ntile) { const u16* kp = ikc + (size_t)(kt * 32 + r) * 32 + h * 8; n0 = *(const bf16x8*)kp; n1 = *(const bf16x8*)(kp + 16); }
    for (; kt < ntile; kt += 4) {
      bf16x8 kf0 = n0, kf1 = n1;
      if (kt + 4 < ntile) { const u16* kp = ikc + (size_t)((kt + 4) * 32 + r) * 32 + h * 8; n0 = *(const bf16x8*)kp; n1 = *(const bf16x8*)(kp + 16); }
      f32x16 sc;
      dsa_scores(sc, kf0, kf1, h, iqrow, wq);
      unsigned word = 0;
#pragma unroll
      for (int reg = 0; reg < 16; ++reg) {
        const int sidx = kt * 32 + crow(reg, h);
        const unsigned ok = okey_of(sc[reg]);
        const unsigned hi16 = ok >> 16;
        const bool valid = sidx <= tq;
        word |= (valid && hi16 > t16) ? (1u << crow(reg, h)) : 0u;
        if (valid && hi16 == t16) {
          unsigned slot = atomicAdd(&candn[r], 1u);
          if (slot < (unsigned)DSA_CAP) { candk[r * 64 + slot] = ok; candi[r * 64 + slot] = (unsigned)sidx; }
        }
      }
      word |= __shfl_xor(word, 32);
      if (h == 0) maskw[kt * 32 + r] = word;
    }
    __syncthreads();
    {
      int row = tid >> 3, j8 = tid & 7;
      unsigned nc = candn[row]; nc = nc < (unsigned)DSA_CAP ? nc : (unsigned)DSA_CAP;
      const unsigned nd = need[row];
      for (unsigned i = j8; i < nc; i += 8) {
        unsigned ki = candk[row * 64 + i], ii = candi[row * 64 + i];
        unsigned rank = 0;
        for (unsigned k = 0; k < nc; ++k) { unsigned kk = candk[row * 64 + k], ik2 = candi[row * 64 + k]; rank += (kk > ki || (kk == ki && ik2 < ii)) ? 1u : 0u; }
        if (rank < nd) atomicOr(&maskw[(ii >> 5) * 32 + row], 1u << (ii & 31u));
      }
    }
  } else {
    unsigned thi = prehi[r], tlo = prelo[r];
    if (lastpass < 3) thi <<= (24 - 8 * lastpass);
    if (lastpass < 4) tlo = 0; else if (lastpass == 4) tlo <<= 4;
    int kt = w;
    bf16x8 n0, n1;
    if (kt < ntile) { const u16* kp = ikc + (size_t)(kt * 32 + r) * 32 + h * 8; n0 = *(const bf16x8*)kp; n1 = *(const bf16x8*)(kp + 16); }
    for (; kt < ntile; kt += 4) {
      bf16x8 kf0 = n0, kf1 = n1;
      if (kt + 4 < ntile) { const u16* kp = ikc + (size_t)((kt + 4) * 32 + r) * 32 + h * 8; n0 = *(const bf16x8*)kp; n1 = *(const bf16x8*)(kp + 16); }
      f32x16 sc;
      dsa_scores(sc, kf0, kf1, h, iqrow, wq);
      unsigned word = 0;
#pragma unroll
      for (int reg = 0; reg < 16; ++reg) {
        const int sidx = kt * 32 + crow(reg, h);
        const unsigned ok = okey_of(sc[reg]);
        const unsigned ri = 4095u - (unsigned)sidx;
        bool sel = (sidx <= tq) && (ok > thi || (ok == thi && ri >= tlo));
        word |= sel ? (1u << crow(reg, h)) : 0u;
      }
      word |= __shfl_xor(word, 32);
      if (h == 0) maskw[kt * 32 + r] = word;
    }
  }
  __syncthreads();
  for (int i = 0; i < 16; ++i) {
    int idx = tid + 256 * i; int rr = idx >> 7, kt = idx & 127;
    if (kt < ntile) gmask[(size_t)rr * 512 + kt] = maskw[kt * 32 + rr];
  }
  return;
  }
  for (int i = 0; i < 16; ++i) {
    int idx = tid + 256 * i; int rr = idx >> 7, kt = idx & 127;
    if (kt < ntile) maskw[kt * 32 + rr] = gmask[(size_t)rr * 512 + kt];
  }
  __syncthreads();
  {
    const int tokbase = b * SEQL + t0;
    auto src = [&](int slot, int rr) { return cols + (size_t)(tokbase + rr) * NC + C_DQ + slot * 64; };
    auto posf = [&](int slot, int rr) { return t0 + rr; };
    stage_q(Qs, src, posf, p.dsa_q_gain + layer * 64, true, true, rope64, 0.125f * 1.44269504f);
  }
  __syncthreads();
  bf16x8 qf[4];
  load_qfrags(qf, Qs, w, r, h);
  AttnAcc acc; attn_init(acc);
  const u16* Kb = (const u16*)(PWS + OFF_DK) + (size_t)b * SEQL * 64;
  const u16* Vtb = (const u16*)(PWS + OFF_DVT) + (size_t)b * 64 * SEQL;
  for (int rep = 0; rep < DBG_ATT_REP; ++rep) { attn_init(acc);
  attn_run(acc, qf, Kb, 64, SEQL - 1, Vtb, SEQL, ntile, [&](int i) { return i; }, [&](int kt) { return maskw[kt * 32 + r]; }, kvs); }
  float lt = acc.l + __shfl_xor(acc.l, 32);
  float inv = lt > 0.f ? 1.f / lt : 0.f;
  u16* mixed = (u16*)(PWS + OFF_H);
  u16* orow = mixed + (size_t)(b * SEQL + t0 + r) * 1024 + 256 + w * 64;
#pragma unroll
  for (int g = 0; g < 4; ++g) {
    float x0[4], x1[4];
#pragma unroll
    for (int i = 0; i < 4; ++i) { x0[i] = acc.o0[4 * g + i] * inv; x1[i] = acc.o1[4 * g + i] * inv; }
    store4bf(orow + 8 * g + 4 * h, x0);
    store4bf(orow + 32 + 8 * g + 4 * h, x1);
  }
}

DI void job_nsa(const Params& p, int layer, int b, int tt, char* smem) {
  const int tid = otid(), lane = tid & 63, w = tid >> 6, r = lane & 31, h = lane >> 5;
  const int t0 = tt * 32;
  const int t = t0 + r;
  u16* cols = (u16*)(PWS + OFF_COLS);
  const u16* cb = cols + (size_t)b * SEQL * NC;
  u16* Qs = (u16*)smem;
  u16* kvs = (u16*)(smem + 18432);
  float* stage = (float*)(smem + 37888);
  float* imp = (float*)(smem + 54272);
  unsigned* selm = (unsigned*)(smem + 62464);
  int* tlist = (int*)(smem + 62720);
  int* nlist = (int*)(smem + 63744);
  const float2* rope64 = (const float2*)(PWS + OFF_ROPE64);
  const float qscale = 0.125f * 1.44269504f;
  const int tokbase = b * SEQL + t0;
  auto src = [&](int slot, int rr) { return cols + (size_t)(tokbase + rr) * NC + C_NQ + slot * 64; };
  auto posf = [&](int slot, int rr) { return t0 + rr; };

  stage_q(Qs, src, posf, p.nsa_q_gain + layer * 64, true, false, rope64, qscale);
  __syncthreads();
  bf16x8 qf[4];
  load_qfrags(qf, Qs, w, r, h);
  const u16* Kc_g = (const u16*)(PWS + OFF_KCMP) + (size_t)b * 256 * 64;
  const u16* Vc_g = (const u16*)(PWS + OFF_VCMPT) + (size_t)b * 64 * 256;
  const int jmax = t >= 31 ? ((t - 31) >> 4) : -1;
  const int ntc = ((2 * tt) >> 5) + 1;
  AttnAcc ac; attn_init(ac);
  attn_run(ac, qf, Kc_g, 64, 255, Vc_g, 256, ntc, [&](int i) { return i; }, [&](int kt) { return lowmask(jmax + 1 - kt * 32); }, kvs);
  float lt = ac.l + __shfl_xor(ac.l, 32);
  float inv_c = lt > 0.f ? 1.f / lt : 0.f;
  float mb_c = (ac.m == -INFINITY) ? 0.f : ac.m;
  for (int i = tid; i < 64 * 32; i += 256) imp[i] = 0.f;
  if (tid < 64) selm[tid] = 0;
  {
    const int krow = tid >> 3, kseg = tid & 7;
    u32x4 rk = *(const u32x4*)(Kc_g + (size_t)krow * 64 + kseg * 8);
    __syncthreads();
    *(u32x4*)(kvs + krow * 72 + kseg * 8) = rk;
    __syncthreads();
    for (int kt = 0; kt < ntc; ++kt) {
      const u16* Kc = kvs + (kt & 1) * KV_BUF;
      if (kt + 1 < ntc) rk = *(const u32x4*)(Kc_g + (size_t)((kt + 1) * 32 + krow) * 64 + kseg * 8);
      f32x16 s = zero16();
#pragma unroll
      for (int ks = 0; ks < 4; ++ks) { bf16x8 kf = *(const bf16x8*)(Kc + r * 72 + ks * 16 + h * 8); s = MFMA_BF(kf, qf[ks], s); }
      unsigned mw = lowmask(jmax + 1 - kt * 32);
#pragma unroll
      for (int reg = 0; reg < 16; ++reg) {
        bool bit = (mw >> crow(reg, h)) & 1u;
        float pv = bit ? __builtin_amdgcn_exp2f(s[reg] - mb_c) * inv_c : 0.f;
        stage[w * 1024 + crow(reg, h) * 32 + r] = pv;
      }
      if (kt + 1 < ntc) *(u32x4*)(kvs + ((kt + 1) & 1) * KV_BUF + krow * 72 + kseg * 8) = rk;
      __syncthreads();
      int tq = tid & 31, ng = tid >> 5, n = kt * 8 + ng;
      float ps[4];
#pragma unroll
      for (int i = 0; i < 4; ++i) { int j = 4 * ng + i; ps[i] = ((stage[j * 32 + tq] + stage[1024 + j * 32 + tq]) + stage[2048 + j * 32 + tq]) + stage[3072 + j * 32 + tq]; }
      imp[n * 32 + tq] += ((ps[0] + ps[1]) + ps[2]) + ps[3];
      __syncthreads();
      if (n + 1 < 64) imp[(n + 1) * 32 + tq] += ps[3];
    }
  }
  __syncthreads();
  {
    int tq = tid & 31, sub = tid >> 5;
    int cur = (t0 + tq) >> 6;
    float v[8];
#pragma unroll
    for (int k = 0; k < 8; ++k) {
      int n = sub * 8 + k;
      bool forced = (n == 0) || (n == cur) || (n == cur - 1);
      float val = forced ? INFINITY : (n > cur ? -INFINITY : imp[n * 32 + tq]);
      v[k] = val;
    }
    __syncthreads();
#pragma unroll
    for (int k = 0; k < 8; ++k) imp[(sub * 8 + k) * 32 + tq] = v[k];
    __syncthreads();
    int rank[8];
#pragma unroll
    for (int k = 0; k < 8; ++k) rank[k] = 0;
    for (int n2 = 0; n2 < 64; ++n2) {
      float v2 = imp[n2 * 32 + tq];
#pragma unroll
      for (int k = 0; k < 8; ++k) { int n = sub * 8 + k; rank[k] += (v2 > v[k] || (v2 == v[k] && n2 < n)) ? 1 : 0; }
    }
    unsigned bits = 0;
#pragma unroll
    for (int k = 0; k < 8; ++k) if (rank[k] < 16) bits |= 1u << ((sub * 8 + k) & 31);
    if (bits) atomicOr(&selm[tq * 2 + (sub >> 2)], bits);
  }
  __syncthreads();
  if (tid == 0) {
    unsigned lo = 0, hi = 0;
    for (int i = 0; i < 32; ++i) { lo |= selm[2 * i]; hi |= selm[2 * i + 1]; }
    int cnt = 0;
    for (int n = 0; n < 64; ++n) {
      bool on = n < 32 ? ((lo >> n) & 1u) : ((hi >> (n - 32)) & 1u);
      if (on) { if (2 * n <= tt) tlist[cnt++] = 2 * n; if (2 * n + 1 <= tt) tlist[cnt++] = 2 * n + 1; }
    }
    nlist[0] = cnt;
  }
  const u16* grow = cb + (size_t)t * NC + C_GATES;
  float g0 = sigmoidf_(bf2f(grow[w])), g1 = sigmoidf_(bf2f(grow[4 + w])), g2 = sigmoidf_(bf2f(grow[8 + w]));
  f32x16 out0, out1;
#pragma unroll
  for (int reg = 0; reg < 16; ++reg) { out0[reg] = g0 * inv_c * ac.o0[reg]; out1[reg] = g0 * inv_c * ac.o1[reg]; }
  __syncthreads();
  stage_q(Qs, src, posf, p.nsa_q_gain + layer * 64, true, true, rope64, qscale);
  __syncthreads();
  load_qfrags(qf, Qs, w, r, h);
  const unsigned mylo = selm[2 * r], myhi = selm[2 * r + 1];
  const int nsl = nlist[0];
  {
    AttnAcc as; attn_init(as);
    const u16* Kb = (const u16*)(PWS + OFF_KSC) + (size_t)b * SEQL * 64;
    const u16* Vtb = (const u16*)(PWS + OFF_VST) + (size_t)b * 64 * SEQL;
    for (int rep = 0; rep < DBG_SLC_REP; ++rep) { attn_init(as);
    attn_run(as, qf, Kb, 64, SEQL - 1, Vtb, SEQL, nsl, [&](int i) { return tlist[i]; },
             [&](int kt) { int n = kt >> 1; bool sel = n < 32 ? ((mylo >> n) & 1u) : ((myhi >> (n - 32)) & 1u); return sel ? lowmask(t - kt * 32 + 1) : 0u; }, kvs); }
    float l2 = as.l + __shfl_xor(as.l, 32);
    float inv = l2 > 0.f ? 1.f / l2 : 0.f;
#pragma unroll
    for (int reg = 0; reg < 16; ++reg) { out0[reg] += g1 * inv * as.o0[reg]; out1[reg] += g1 * inv * as.o1[reg]; }
  }
  {
    AttnAcc aw; attn_init(aw);
    const u16* Kb = (const u16*)(PWS + OFF_KWC) + (size_t)b * SEQL * 64;
    const u16* Vtb = (const u16*)(PWS + OFF_VWT) + (size_t)b * 64 * SEQL;
    const int klo = tt - 16 > 0 ? tt - 16 : 0;
    for (int rep = 0; rep < DBG_SWA_REP; ++rep) { attn_init(aw);
    attn_run(aw, qf, Kb, 64, SEQL - 1, Vtb, SEQL, tt - klo + 1, [&](int i) { return klo + i; },
             [&](int kt) { int lo = t - 511 - kt * 32; unsigned lm = lo <= 0 ? 0xffffffffu : (lo >= 32 ? 0u : (0xffffffffu << lo)); return lowmask(t - kt * 32 + 1) & lm; }, kvs); }
    float l2 = aw.l + __shfl_xor(aw.l, 32);
    float inv = l2 > 0.f ? 1.f / l2 : 0.f;
#pragma unroll
    for (int reg = 0; reg < 16; ++reg) { out0[reg] += g2 * inv * aw.o0[reg]; out1[reg] += g2 * inv * aw.o1[reg]; }
  }
  u16* mixed = (u16*)(PWS + OFF_H);
  u16* orow = mixed + (size_t)(b * SEQL + t) * 1024 + 512 + w * 64;
#pragma unroll
  for (int g = 0; g < 4; ++g) {
    float x0[4], x1[4];
#pragma unroll
    for (int i = 0; i < 4; ++i) { x0[i] = out0[4 * g + i]; x1[i] = out1[4 * g + i]; }
    store4bf(orow + 8 * g + 4 * h, x0);
    store4bf(orow + 32 + 8 * g + 4 * h, x1);
  }
}

DI void job_xattn(const Params& p, int layer, int b, int hd, int tq, char* smem) {
  const int tid = otid(), lane = tid & 63, w = tid >> 6, r = lane & 31, h = lane >> 5;
  u16* Qs = (u16*)smem;
  u16* kvs = (u16*)(smem + 18432);
  const u16* xq = (const u16*)(PWS + OFF_XQ);
  const int tokbase = b * SEQL + tq * 128;
  auto src = [&](int slot, int rr) { return xq + (size_t)(tokbase + slot * 32 + rr) * 256 + hd * 64; };
  auto posf = [&](int slot, int rr) { return 0; };
  stage_q(Qs, src, posf, p.xa_q_gain + layer * 64, true, false, (const float2*)nullptr, 0.125f * 1.44269504f);
  __syncthreads();
  bf16x8 qf[4];
  load_qfrags(qf, Qs, w, r, h);
  const u16* Kb = (const u16*)(PWS + OFF_MEMKV) + ((size_t)(layer * 4 + b) * 256) * 512 + hd * 64;
  const u16* Vtb = (const u16*)(PWS + OFF_MEMVT) + ((size_t)(layer * 4 + b) * 256 + hd * 64) * 256;
  AttnAcc a; attn_init(a);
  attn_run(a, qf, Kb, 512, 255, Vtb, 256, 8, [&](int i) { return i; }, [&](int kt) { return 0xffffffffu; }, kvs);
  float lt = a.l + __shfl_xor(a.l, 32);
  float inv = 1.f / lt;
  u16* xo = (u16*)(PWS + OFF_XO);
  u16* orow = xo + (size_t)(tokbase + w * 32 + r) * 256 + hd * 64;
#pragma unroll
  for (int g = 0; g < 4; ++g) {
    float x0[4], x1[4];
#pragma unroll
    for (int i = 0; i < 4; ++i) { x0[i] = a.o0[4 * g + i] * inv; x1[i] = a.o1[4 * g + i] * inv; }
    store4bf(orow + 8 * g + 4 * h, x0);
    store4bf(orow + 32 + 8 * g + 4 * h, x1);
  }
}

DI void job_prep(const Params& p, int layer, int job, char* smem) {
  const int tid = otid();
  const int tok0 = job * 32;
  const int b = tok0 >> 12, pos0 = tok0 & 4095;
  u16* cols = (u16*)(PWS + OFF_COLS);
  const float2* rope64 = (const float2*)(PWS + OFF_ROPE64);
  const float2* rope32 = (const float2*)(PWS + OFF_ROPE32);
  float* ckvn = (float*)smem;
  float* kpre = ckvn + 32 * 128;
  float* vbuf = kpre + 32 * 64;
  for (int it = 0; it < 4; ++it) {
    int row = it * 16 + (tid >> 4), lg = tid & 15;
    int tk = row >> 1, which = row & 1;
    u16* ptr = cols + (size_t)(tok0 + tk) * NC + (which ? C_KW : C_KS) + lg * 4;
    float x[4]; load4bf(ptr, x);
    rowop<64>(x, lg, p.nsa_k_gains + layer * 192 + (which ? 128 : 64), true, true, pos0 + tk, rope64);
    store4bf((u16*)(PWS + (which ? OFF_KWC : OFF_KSC)) + (size_t)(tok0 + tk) * 64 + lg * 4, x);
  }
  for (int it = 0; it < 8; ++it) {
    int row = it * 32 + (tid >> 3), lg = tid & 7;
    int tk = row >> 3, hh = row & 7;
    u16* ptr = cols + (size_t)(tok0 + tk) * NC + C_IQ + hh * 32 + lg * 4;
    float x[4]; load4bf(ptr, x);
    rowop<32>(x, lg, nullptr, false, true, pos0 + tk, rope32);
    store4bf(ptr, x);
  }
  {
    int tk = tid >> 3, lg = tid & 7;
    u16* ptr = cols + (size_t)(tok0 + tk) * NC + C_IK + lg * 4;
    float x[4]; load4bf(ptr, x);
    rowop<32>(x, lg, p.dsa_idxk_gain + layer * 32, true, true, pos0 + tk, rope32);
    store4bf((u16*)(PWS + OFF_IKC) + (size_t)(tok0 + tk) * 32 + lg * 4, x);
  }
  u16* ckvb = (u16*)smem;
  for (int it = 0; it < 4; ++it) {
    int tk = it * 8 + (tid >> 5), lg = tid & 31;
    float x[4]; load4bf(cols + (size_t)(tok0 + tk) * NC + C_CKV + lg * 4, x);
    rowop<128>(x, lg, p.dsa_kv_gain + layer * 128, true, false, 0, rope64);
    store4bf(ckvb + tk * 136 + lg * 4, x);
  }
  __syncthreads();
  {
    const int lane = tid & 63, w = tid >> 6, r = lane & 31, h = lane >> 5;
    const u16* wt = (const u16*)(PWS + OFF_WUKV) + (size_t)layer * 128 * 128 + (size_t)(w * 32 + r) * 128;
    f32x16 acc = zero16();
#pragma unroll
    for (int s2 = 0; s2 < 8; ++s2) {
      bf16x8 af = *(const bf16x8*)(ckvb + r * 136 + s2 * 16 + h * 8);
      bf16x8 bfr = *(const bf16x8*)(wt + s2 * 16 + h * 8);
      acc = MFMA_BF(af, bfr, acc);
    }
#pragma unroll
    for (int reg = 0; reg < 16; ++reg) {
      int tk = crow(reg, h), n = w * 32 + r;
      if (n < 64) kpre[tk * 64 + n] = acc[reg]; else vbuf[tk * 65 + (n - 64)] = acc[reg];
    }
  }
  __syncthreads();
  u16* DK = (u16*)(PWS + OFF_DK);
  for (int it = 0; it < 2; ++it) {
    int tk = it * 16 + (tid >> 4), lg = tid & 15;
    float x[4];
#pragma unroll
    for (int i = 0; i < 4; ++i) x[i] = kpre[tk * 64 + lg * 4 + i];
    rowop<64>(x, lg, p.dsa_k_gain + layer * 64, true, true, pos0 + tk, rope64);
    store4bf(DK + (size_t)(tok0 + tk) * 64 + lg * 4, x);
  }
  for (int which = 0; which < 3; ++which) {
    if (which > 0) {
      __syncthreads();
      for (int i = 0; i < 8; ++i) { int e = tid + 256 * i; int tk = e >> 6, d = e & 63; vbuf[tk * 65 + d] = bf2f(cols[(size_t)(tok0 + tk) * NC + (which == 1 ? C_VS : C_VW) + d]); }
      __syncthreads();
    }
    u16* dst = (u16*)(PWS + (which == 0 ? OFF_DVT : (which == 1 ? OFF_VST : OFF_VWT)));
    int d = tid & 63, q = tid >> 6;
    uint4 o;
    o.x = pack2(vbuf[(q * 8 + 0) * 65 + d], vbuf[(q * 8 + 1) * 65 + d]);
    o.y = pack2(vbuf[(q * 8 + 2) * 65 + d], vbuf[(q * 8 + 3) * 65 + d]);
    o.z = pack2(vbuf[(q * 8 + 4) * 65 + d], vbuf[(q * 8 + 5) * 65 + d]);
    o.w = pack2(vbuf[(q * 8 + 6) * 65 + d], vbuf[(q * 8 + 7) * 65 + d]);
    *(uint4*)(dst + ((size_t)(b * 64 + d)) * SEQL + pos0 + q * 8) = o;
  }
}

DI void job_memkv_post(const Params& p, int job, char* smem) {
  const int tid = otid();
  const int l = job >> 5, row0 = (job & 31) * 32;
  u16* kv = (u16*)(PWS + OFF_MEMKV) + (size_t)l * 1024 * 512;
  u16* vt = (u16*)(PWS + OFF_MEMVT) + (size_t)l * 4 * 256 * 256;
  float* vbuf = (float*)smem;
  for (int it = 0; it < 8; ++it) {
    int row = it * 16 + (tid >> 4), lg = tid & 15;
    int rr = row >> 2, hd = row & 3;
    u16* ptr = kv + (size_t)(row0 + rr) * 512 + hd * 64 + lg * 4;
    float x[4]; load4bf(ptr, x);
    rowop<64>(x, lg, p.xa_k_gain + l * 64, true, false, 0, (const float2*)nullptr);
    store4bf(ptr, x);
  }
  for (int i = 0; i < 32; ++i) { int e = tid + 256 * i; int rr = e >> 8, c = e & 255; vbuf[rr * 257 + c] = bf2f(kv[(size_t)(row0 + rr) * 512 + 256 + c]); }
  __syncthreads();
  {
    int b = row0 >> 8, m0 = row0 & 255;
    int c = tid;
    for (int q = 0; q < 4; ++q) {
      uint4 o;
      o.x = pack2(vbuf[(q * 8 + 0) * 257 + c], vbuf[(q * 8 + 1) * 257 + c]);
      o.y = pack2(vbuf[(q * 8 + 2) * 257 + c], vbuf[(q * 8 + 3) * 257 + c]);
      o.z = pack2(vbuf[(q * 8 + 4) * 257 + c], vbuf[(q * 8 + 5) * 257 + c]);
      o.w = pack2(vbuf[(q * 8 + 6) * 257 + c], vbuf[(q * 8 + 7) * 257 + c]);
      *(uint4*)(vt + ((size_t)(b * 256 + c)) * 256 + m0 + q * 8) = o;
    }
  }
}

DI void job_cmp2(const Params& p, int layer, int job, char* smem) {
  const int tid = otid();
  const int rl = tid >> 5, nq = (tid >> 4) & 1, lg = tid & 15;
  const int gr0 = job * 8;
  const int gr = gr0 + rl;
  const int b = gr >> 8, j = gr & 255;
  const u16* hid = (const u16*)(PWS + OFF_HID);
  float* hs = (float*)smem;
  float* part = hs + 8 * 512;
  float* vb = part + 8 * 16 * 8;
  for (int i = 0; i < 2; ++i) {
    int c = tid + 256 * i; int row = c >> 6, seg = c & 63;
    int g2 = gr0 + row; int b2 = g2 >> 8, j2 = g2 & 255;
    float x[8];
    if (j2 < 255) ld8bf(hid + (size_t)(b2 * 255 + j2) * 512 + seg * 8, x);
    else { for (int k = 0; k < 8; ++k) x[k] = 0.f; }
#pragma unroll
    for (int k = 0; k < 8; ++k) hs[row * 512 + seg * 8 + k] = x[k];
  }
  __syncthreads();
  float ak[4] = {0.f, 0.f, 0.f, 0.f}, av[4] = {0.f, 0.f, 0.f, 0.f};
  {
    const float* w2k = p.nsa_k_w2 + (size_t)layer * 256 * 64 + lg * 4;
    const float* w2v = p.nsa_v_w2 + (size_t)layer * 256 * 64 + lg * 4;
    const float* hr = hs + rl * 512;
#pragma unroll 8
    for (int n = nq * 128; n < nq * 128 + 128; ++n) {
      float hk = hr[n], hv = hr[256 + n];
      float4 wk = *(const float4*)(w2k + n * 64), wv = *(const float4*)(w2v + n * 64);
      ak[0] = fmaf(hk, wk.x, ak[0]); ak[1] = fmaf(hk, wk.y, ak[1]); ak[2] = fmaf(hk, wk.z, ak[2]); ak[3] = fmaf(hk, wk.w, ak[3]);
      av[0] = fmaf(hv, wv.x, av[0]); av[1] = fmaf(hv, wv.y, av[1]); av[2] = fmaf(hv, wv.z, av[2]); av[3] = fmaf(hv, wv.w, av[3]);
    }
  }
  if (nq == 1) {
#pragma unroll
    for (int i = 0; i < 4; ++i) { part[(rl * 16 + lg) * 8 + i] = ak[i]; part[(rl * 16 + lg) * 8 + 4 + i] = av[i]; }
  }
  __syncthreads();
  if (nq == 0) {
#pragma unroll
    for (int i = 0; i < 4; ++i) { ak[i] += part[(rl * 16 + lg) * 8 + i]; av[i] += part[(rl * 16 + lg) * 8 + 4 + i]; }
  }
  rowop<64>(ak, lg, p.nsa_k_gains + layer * 192, true, false, 0, (const float2*)nullptr);
  if (nq == 0) {
    store4bf((u16*)(PWS + OFF_KCMP) + (size_t)gr * 64 + lg * 4, ak);
#pragma unroll
    for (int i = 0; i < 4; ++i) vb[rl * 65 + lg * 4 + i] = av[i];
  }
  __syncthreads();
  if (tid < 64) {
    int d = tid;
    uint4 o;
    o.x = pack2(vb[0 * 65 + d], vb[1 * 65 + d]);
    o.y = pack2(vb[2 * 65 + d], vb[3 * 65 + d]);
    o.z = pack2(vb[4 * 65 + d], vb[5 * 65 + d]);
    o.w = pack2(vb[6 * 65 + d], vb[7 * 65 + d]);
    int bb = gr0 >> 8, jb = gr0 & 255;
    *(uint4*)((u16*)(PWS + OFF_VCMPT) + ((size_t)(bb * 64 + d)) * 256 + jb) = o;
  }
}

DI float lb_of(const Params& p, int layer, int c) {
  if (layer == 0) return 0.f;
  float p0 = p.lb_param[c], p1 = p.lb_param[256 + c];
  return 1.f / (1.f + expf(p0 - p1));
}
DI void mm32(f32x16& acc, const float* Ap, int asi, int ask, const float* Bp, int bsk, int bsj, int r, int h) {
#pragma unroll 8
  for (int k = 0; k < 64; k += 2) {
    float a = Ap[r * asi + (k + h) * ask];
    float b = Bp[(k + h) * bsk + r * bsj];
    acc = MFMA_F32(a, b, acc);
  }
}
template <bool SILU_GATE>
DI void finish_rows(const float* ob, const float* gain, const u16* cols, int gate_col, u16* mixed, int mix_col, int tb, int hd) {
  const int tid = otid(), lg = tid & 15;
  for (int it = 0; it < 4; ++it) {
    int t = it * 16 + (tid >> 4);
    float x[4];
#pragma unroll
    for (int i = 0; i < 4; ++i) x[i] = ob[t * 65 + lg * 4 + i];
    rowop<64>(x, lg, gain, true, false, 0, (const float2*)nullptr);
    float g[4]; load4bf(cols + (size_t)(tb + t) * NC + gate_col + hd * 64 + lg * 4, g);
#pragma unroll
    for (int i = 0; i < 4; ++i) x[i] *= SILU_GATE ? siluf_(g[i]) : sigmoidf_(g[i]);
    store4bf(mixed + (size_t)(tb + t) * 1024 + mix_col + hd * 64 + lg * 4, x);
  }
}

DI void conv8(const u16* cols, const float (&cw)[4][8], const float (&cbias)[8], int tok, int pos, int coloff, float (&out)[8]) {
#pragma unroll
  for (int k = 0; k < 8; ++k) out[k] = cbias[k];
#pragma unroll
  for (int j = 0; j < 4; ++j) {
    int dp = j - 3;
    if (pos + dp >= 0) {
      float x[8]; ld8bf(cols + (size_t)(tok + dp) * NC + coloff, x);
#pragma unroll
      for (int k = 0; k < 8; ++k) out[k] = fmaf(cw[j][k], x[k], out[k]);
    }
  }
#pragma unroll
  for (int k = 0; k < 8; ++k) out[k] = siluf_(out[k]);
}
DI void load_convw(const Params& p, int layer, int ch0, float (&cw)[4][8], float (&cbias)[8]) {
  const float* w = p.ml_conv_w + (size_t)layer * 4 * 512 + ch0;
#pragma unroll
  for (int j = 0; j < 4; ++j) {
    float4 a = *(const float4*)(w + j * 512), b2 = *(const float4*)(w + j * 512 + 4);
    cw[j][0] = a.x; cw[j][1] = a.y; cw[j][2] = a.z; cw[j][3] = a.w; cw[j][4] = b2.x; cw[j][5] = b2.y; cw[j][6] = b2.z; cw[j][7] = b2.w;
  }
  const float* bb = p.ml_conv_b + layer * 512 + ch0;
  float4 a = *(const float4*)bb, b2 = *(const float4*)(bb + 4);
  cbias[0] = a.x; cbias[1] = a.y; cbias[2] = a.z; cbias[3] = a.w; cbias[4] = b2.x; cbias[5] = b2.y; cbias[6] = b2.z; cbias[7] = b2.w;
}
DI void load_state(float* dst, const float* src, int tid) {
#pragma unroll
  for (int i = 0; i < 4; ++i) { int e4 = tid + 256 * i; int row = e4 >> 4, c4 = (e4 & 15) * 4; float4 v = *(const float4*)(src + row * 64 + c4);
    dst[row * 65 + c4] = v.x; dst[row * 65 + c4 + 1] = v.y; dst[row * 65 + c4 + 2] = v.z; dst[row * 65 + c4 + 3] = v.w; }
}

DI void job_hg_A(const Params& p, int layer, int cid, char* smem) {
  const int tid = otid(), lane = tid & 63, w = tid >> 6, r = lane & 31, h = lane >> 5;
  const int bh = cid >> 6, c = cid & 63, b = bh >> 2, hd = bh & 3;
  const int tb = b * SEQL + c * 64;
  const u16* cols = (const u16*)(PWS + OFF_COLS);
  float* B0 = (float*)smem; float* B1 = B0 + 64 * 65; float* B2 = B1 + 64 * 65;
  {
    const int seg = tid & 7;
    float lbv[8];
#pragma unroll
    for (int k = 0; k < 8; ++k) lbv[k] = lb_of(p, layer, hd * 64 + seg * 8 + k);
#pragma unroll
    for (int i = 0; i < 2; ++i) {
      int s = (tid >> 3) + 32 * i;
      const u16* row = cols + (size_t)(tb + s) * NC + hd * 64 + seg * 8;
      float f[8], iv[8]; ld8bf(row + C_HGF, f); ld8bf(row + C_HGI, iv);
#pragma unroll
      for (int k = 0; k < 8; ++k) {
        float fg = lbv[k] + (1.f - lbv[k]) * sigmoidf_(f[k]);
        B0[s * 65 + seg * 8 + k] = logf(fg); B1[s * 65 + seg * 8 + k] = 1.f - fg; B2[s * 65 + seg * 8 + k] = iv[k];
      }
    }
  }
  __syncthreads();
  if (tid < 64) { float run = 0.f; for (int s = 0; s < 64; ++s) { run += B0[s * 65 + tid]; B0[s * 65 + tid] = run; } }
  __syncthreads();
  for (int e = tid; e < 4096; e += 256) { int s = e >> 6, kd = e & 63; B1[s * 65 + kd] *= expf(B0[63 * 65 + kd] - B0[s * 65 + kd]); }
  __syncthreads();
  const int ih = w >> 1, jh = w & 1;
  f32x16 acc = zero16();
  mm32(acc, B1 + ih * 32, 1, 65, B2 + jh * 32, 65, 1, r, h);
  float* st = (float*)(PWS + OFF_HGST) + (size_t)cid * 4096;
#pragma unroll
  for (int reg = 0; reg < 16; ++reg) st[(ih * 32 + crow(reg, h)) * 64 + jh * 32 + r] = acc[reg];
  if (tid < 64) ((float*)(PWS + OFF_HGD))[cid * 64 + tid] = expf(B0[63 * 65 + tid]);
}

DI void job_hg_scan(const Params& p, int job) {
  const int bh = job >> 4, e = (job & 15) * 256 + otid();
  float* st = (float*)(PWS + OFF_HGST);
  const float* dv = (const float*)(PWS + OFF_HGD);
  float S = 0.f;
  for (int c0 = 0; c0 < 64; c0 += 16) {
    float U[16], D[16];
#pragma unroll
    for (int i = 0; i < 16; ++i) { U[i] = st[(size_t)(bh * 64 + c0 + i) * 4096 + e]; D[i] = dv[(bh * 64 + c0 + i) * 64 + (e >> 6)]; }
#pragma unroll
    for (int i = 0; i < 16; ++i) { st[(size_t)(bh * 64 + c0 + i) * 4096 + e] = S; S = D[i] * S + U[i]; }
  }
}

DI void job_hg_C(const Params& p, int layer, int cid, char* smem) {
  const int tid = otid(), lane = tid & 63, w = tid >> 6, r = lane & 31, h = lane >> 5;
  const int bh = cid >> 6, c = cid & 63, b = bh >> 2, hd = bh & 3;
  const int tb = b * SEQL + c * 64;
  const u16* cols = (const u16*)(PWS + OFF_COLS);
  float* B0 = (float*)smem; float* B1 = B0 + 64 * 65; float* B2 = B1 + 64 * 65; float* B3 = B2 + 64 * 65;
  {
    const int seg = tid & 7;
    float lbv[8];
#pragma unroll
    for (int k = 0; k < 8; ++k) lbv[k] = lb_of(p, layer, hd * 64 + seg * 8 + k);
#pragma unroll
    for (int i = 0; i < 2; ++i) {
      int s = (tid >> 3) + 32 * i;
      const u16* row = cols + (size_t)(tb + s) * NC + hd * 64 + seg * 8;
      float f[8], iv[8], qr[8]; ld8bf(row + C_HGF, f); ld8bf(row + C_HGI, iv); ld8bf(row + C_HGQ, qr);
#pragma unroll
      for (int k = 0; k < 8; ++k) {
        float fg = lbv[k] + (1.f - lbv[k]) * sigmoidf_(f[k]);
        B0[s * 65 + seg * 8 + k] = logf(fg); B2[s * 65 + seg * 8 + k] = 1.f - fg;
        B1[s * 65 + seg * 8 + k] = siluf_(qr[k]) * 0.125f; B3[s * 65 + seg * 8 + k] = iv[k];
      }
    }
  }
  __syncthreads();
  if (tid < 64) { float run = 0.f; for (int s = 0; s < 64; ++s) { run += B0[s * 65 + tid]; B0[s * 65 + tid] = run; } }
  __syncthreads();
  for (int e = tid; e < 4096; e += 256) {
    int s = e >> 6, kd = e & 63;
    float bref = B0[31 * 65 + kd], bc = B0[s * 65 + kd];
    B1[s * 65 + kd] *= expf(bc - bref);
    B2[s * 65 + kd] *= expf(bref - bc);
  }
  __syncthreads();
  const int th = w >> 1, sh = w & 1;
  f32x16 at = zero16();
  if (!(th == 0 && sh == 1)) mm32(at, B1 + th * 32 * 65, 65, 1, B2 + sh * 32 * 65, 1, 65, r, h);
  __syncthreads();
  for (int e = tid; e < 4096; e += 256) { int s = e >> 6, kd = e & 63; B2[s * 65 + kd] = B1[s * 65 + kd] * expf(B0[31 * 65 + kd]); }
  __syncthreads();
#pragma unroll
  for (int reg = 0; reg < 16; ++reg) {
    int t = th * 32 + crow(reg, h), s = sh * 32 + r;
    B1[t * 65 + s] = (s <= t) ? at[reg] : 0.f;
  }
  load_state(B0, (const float*)(PWS + OFF_HGST) + (size_t)cid * 4096, tid);
  __syncthreads();
  const int vh = w & 1;
  f32x16 o = zero16();
  mm32(o, B2 + th * 32 * 65, 65, 1, B0 + vh * 32, 65, 1, r, h);
  mm32(o, B1 + th * 32 * 65, 65, 1, B3 + vh * 32, 65, 1, r, h);
  __syncthreads();
#pragma unroll
  for (int reg = 0; reg < 16; ++reg) B2[(th * 32 + crow(reg, h)) * 65 + vh * 32 + r] = o[reg];
  __syncthreads();
  finish_rows<true>(B2, p.hg_o_gain + layer * 64, cols, C_HGG, (u16*)(PWS + OFF_H), 0, tb, hd);
}

DI float conv_silu(const Params& p, int layer, const u16* cols, int tok, int pos, int ch) {
  const float* cw = p.ml_conv_w + (size_t)layer * 4 * 512;
  float a = p.ml_conv_b[layer * 512 + ch];
#pragma unroll
  for (int j = 0; j < 4; ++j) {
    int dp = j - 3;
    float xv = (pos + dp >= 0) ? bf2f(cols[(size_t)(tok + dp) * NC + C_MQ + ch]) : 0.f;
    a = fmaf(cw[j * 512 + ch], xv, a);
  }
  return siluf_(a);
}
DI float logsigmoidf_(float x) { return fminf(x, 0.f) - log1pf(expf(-fabsf(x))); }
DI float scan_add(float v, int lane) { for (int o = 1; o < 64; o <<= 1) { float u = __shfl_up(v, o); if (lane >= o) v += u; } return v; }
DI float scan_max(float v, int lane) { for (int o = 1; o < 64; o <<= 1) { float u = __shfl_up(v, o); if (lane >= o) v = fmaxf(v, u); } return v; }

DI void job_ml_A(const Params& p, int layer, int cid, char* smem) {
  const int tid = otid(), lane = tid & 63, w = tid >> 6, r = lane & 31, h = lane >> 5;
  const int bh = cid >> 6, c = cid & 63, b = bh >> 2, hd = bh & 3;
  const int tb = b * SEQL + c * 64;
  const u16* cols = (const u16*)(PWS + OFF_COLS);
  float* B1 = (float*)smem; float* B2 = B1 + 64 * 65; float* wsv = B2 + 64 * 65;
  float* mlsc = (float*)(PWS + OFF_MLSC);
  if (w == 0) {
    const u16* row = cols + (size_t)(tb + lane) * NC;
    float fgv = bf2f(row[C_FG + hd]) + p.ml_f_bias[layer * 4 + hd];
    float igv = bf2f(row[C_IG + hd]) + p.ml_i_bias[layer * 4 + hd];
    float lf = logsigmoidf_(fgv);
    float bc = scan_add(lf, lane);
    float blast = __shfl(bc, 63);
    float lw = blast - bc + igv;
    float Mc = wave_max(lw);
    wsv[lane] = expf(lw - Mc);
    if (lane == 0) { mlsc[cid] = Mc; mlsc[1024 + cid] = blast; }
  }
  {
    const int seg = tid & 7;
    float cw[4][8], cbias[8];
    load_convw(p, layer, 256 + hd * 64 + seg * 8, cw, cbias);
#pragma unroll
    for (int i = 0; i < 2; ++i) {
      int s = (tid >> 3) + 32 * i;
      float kv[8], vv[8];
      conv8(cols, cw, cbias, tb + s, c * 64 + s, C_MK + hd * 64 + seg * 8, kv);
      ld8bf(cols + (size_t)(tb + s) * NC + C_MV + hd * 64 + seg * 8, vv);
#pragma unroll
      for (int k = 0; k < 8; ++k) { B1[s * 65 + seg * 8 + k] = kv[k] * 0.125f; B2[s * 65 + seg * 8 + k] = vv[k]; }
    }
  }
  __syncthreads();
  for (int e = tid; e < 4096; e += 256) { int s = e >> 6, d = e & 63; B1[s * 65 + d] *= wsv[s]; }
  __syncthreads();
  const int ih = w >> 1, jh = w & 1;
  f32x16 acc = zero16();
  mm32(acc, B1 + ih * 32, 1, 65, B2 + jh * 32, 65, 1, r, h);
  float* st = (float*)(PWS + OFF_MLST) + (size_t)cid * 4096;
#pragma unroll
  for (int reg = 0; reg < 16; ++reg) st[(ih * 32 + crow(reg, h)) * 64 + jh * 32 + r] = acc[reg];
  if (tid < 64) { float sacc = 0.f; for (int s = 0; s < 64; ++s) sacc += B1[s * 65 + tid]; ((float*)(PWS + OFF_MLN))[cid * 64 + tid] = sacc; }
}

DI void job_ml_scan(const Params& p, int job) {
  const int bh = job >> 4, sl = job & 15, tid = otid(), e = sl * 256 + tid;
  float* st = (float*)(PWS + OFF_MLST);
  float* nv = (float*)(PWS + OFF_MLN);
  float* mlsc = (float*)(PWS + OFF_MLSC);
  float S = 0.f, nS = 0.f, m = -1e30f;
  const bool don = (sl == 0 && tid < 64);
  for (int c0 = 0; c0 < 64; c0 += 16) {
    float U[16], Mc[16], Bl[16], Nu[16];
#pragma unroll
    for (int i = 0; i < 16; ++i) {
      int cid = bh * 64 + c0 + i;
      U[i] = st[(size_t)cid * 4096 + e]; Mc[i] = mlsc[cid]; Bl[i] = mlsc[1024 + cid];
      Nu[i] = don ? nv[cid * 64 + tid] : 0.f;
    }
#pragma unroll
    for (int i = 0; i < 16; ++i) {
      int cid = bh * 64 + c0 + i;
      float mnew = fmaxf(Bl[i] + m, Mc[i]);
      float dec = expf(Bl[i] + m - mnew), us = expf(Mc[i] - mnew);
      st[(size_t)cid * 4096 + e] = S;
      S = dec * S + us * U[i];
      if (don) { nv[cid * 64 + tid] = nS; nS = dec * nS + us * Nu[i]; }
      if (sl == 0 && tid == 0) mlsc[2048 + cid] = m;
      m = mnew;
    }
  }
}

DI void job_ml_C(const Params& p, int layer, int cid, char* smem) {
  const int tid = otid(), lane = tid & 63, w = tid >> 6, r = lane & 31, h = lane >> 5;
  const int bh = cid >> 6, c = cid & 63, b = bh >> 2, hd = bh & 3;
  const int tb = b * SEQL + c * 64;
  const u16* cols = (const u16*)(PWS + OFF_COLS);
  float* B0 = (float*)smem; float* B1 = B0 + 64 * 65; float* B2 = B1 + 64 * 65; float* B3 = B2 + 64 * 65;
  float* s_bc = B3 + 64 * 65; float* s_as = s_bc + 64; float* s_mt = s_as + 64; float* s_wi = s_mt + 64; float* s_nv = s_wi + 64; float* s_den = s_nv + 64;
  const float* mlsc = (const float*)(PWS + OFF_MLSC);
  if (w == 0) {
    const u16* row = cols + (size_t)(tb + lane) * NC;
    float fgv = bf2f(row[C_FG + hd]) + p.ml_f_bias[layer * 4 + hd];
    float igv = bf2f(row[C_IG + hd]) + p.ml_i_bias[layer * 4 + hd];
    float lf = logsigmoidf_(fgv);
    float bc = scan_add(lf, lane);
    float as = igv - bc;
    float pm = scan_max(as, lane);
    float m = mlsc[2048 + cid];
    float inter = bc + m;
    float mt = fmaxf(inter, bc + pm);
    s_bc[lane] = bc; s_as[lane] = as; s_mt[lane] = mt; s_wi[lane] = expf(inter - mt);
    s_nv[lane] = ((const float*)(PWS + OFF_MLN))[cid * 64 + lane];
  }
  {
    const int seg = tid & 7;
    {
      float cw[4][8], cbias[8];
      load_convw(p, layer, hd * 64 + seg * 8, cw, cbias);
#pragma unroll
      for (int i = 0; i < 2; ++i) {
        int s = (tid >> 3) + 32 * i;
        float qv[8];
        conv8(cols, cw, cbias, tb + s, c * 64 + s, C_MQ + hd * 64 + seg * 8, qv);
#pragma unroll
        for (int k = 0; k < 8; ++k) B0[s * 65 + seg * 8 + k] = qv[k];
      }
    }
    {
      float cw[4][8], cbias[8];
      load_convw(p, layer, 256 + hd * 64 + seg * 8, cw, cbias);
#pragma unroll
      for (int i = 0; i < 2; ++i) {
        int s = (tid >> 3) + 32 * i;
        float kv[8], vv[8];
        conv8(cols, cw, cbias, tb + s, c * 64 + s, C_MK + hd * 64 + seg * 8, kv);
        ld8bf(cols + (size_t)(tb + s) * NC + C_MV + hd * 64 + seg * 8, vv);
#pragma unroll
        for (int k = 0; k < 8; ++k) { B1[s * 65 + seg * 8 + k] = kv[k] * 0.125f; B2[s * 65 + seg * 8 + k] = vv[k]; }
      }
    }
    load_state(B3, (const float*)(PWS + OFF_MLST) + (size_t)cid * 4096, tid);
  }
  __syncthreads();
  const int th = w >> 1, sh = w & 1;
  f32x16 qk = zero16();
  if (!(th == 0 && sh == 1)) mm32(qk, B0 + th * 32 * 65, 65, 1, B1 + sh * 32 * 65, 1, 65, r, h);
  __syncthreads();
#pragma unroll
  for (int reg = 0; reg < 16; ++reg) {
    int t = th * 32 + crow(reg, h), s = sh * 32 + r;
    float dm = (s <= t) ? expf(s_bc[t] + s_as[s] - s_mt[t]) : 0.f;
    B1[t * 65 + s] = qk[reg] * dm;
  }
  for (int e = tid; e < 4096; e += 256) { int t = e >> 6, d = e & 63; B0[t * 65 + d] *= s_wi[t]; }
  __syncthreads();
  const int vh = w & 1;
  f32x16 o = zero16();
  mm32(o, B0 + th * 32 * 65, 65, 1, B3 + vh * 32, 65, 1, r, h);
  mm32(o, B1 + th * 32 * 65, 65, 1, B2 + vh * 32, 65, 1, r, h);
  if (tid < 64) {
    float dsum = 0.f;
    for (int d = 0; d < 64; ++d) dsum = fmaf(B0[tid * 65 + d], s_nv[d], dsum);
    float ssum = 0.f;
    for (int s = 0; s < 64; ++s) ssum += B1[tid * 65 + s];
    s_den[tid] = dsum + ssum;
  }
  __syncthreads();
#pragma unroll
  for (int reg = 0; reg < 16; ++reg) {
    int t = th * 32 + crow(reg, h);
    float dn = fmaxf(fabsf(s_den[t]), expf(-s_mt[t]));
    B3[t * 65 + vh * 32 + r] = o[reg] / dn;
  }
  __syncthreads();
  finish_rows<false>(B3, p.ml_o_gain + layer * 64, cols, C_MOG, (u16*)(PWS + OFF_H), 768, tb, hd);
}


#define XB_TMO      128
#define XB_XCNT(j)  (256  + 64 * (j))
#define XB_XSUB(j)  (1280 + 64 * (j))
#define XB_XGEN(j)  (2304 + 64 * (j))
#define XB_TOP      3328
#define XB_TOPGEN   3392
#define XCD_BAR_WORDS 3456
#define XB_SPIN_CAP (1u << 20)
#define LAS __attribute__((address_space(3)))
DI unsigned xb_ld(unsigned* p) { return __hip_atomic_load(p, __ATOMIC_RELAXED, __HIP_MEMORY_SCOPE_AGENT); }
DI unsigned xb_add(unsigned* p, unsigned v) { return __hip_atomic_fetch_add(p, v, __ATOMIC_RELAXED, __HIP_MEMORY_SCOPE_AGENT); }
DI unsigned xb_xcc_id() { return (unsigned)__builtin_amdgcn_s_getreg((3 << 11) | 20) & 0xFu; }
#define XB_SPIN(cond, bar) do { unsigned _sp = 0; while (cond) { __builtin_amdgcn_s_sleep(1); \
    if ((++_sp & 255u) == 0u) { if (xb_ld(&(bar)[XB_TMO])) break; if (_sp > XB_SPIN_CAP) { atomicAdd(&(bar)[XB_TMO], 1u); break; } } } } while (0)
struct XcdBarrier { unsigned* bar; unsigned x; volatile LAS unsigned* st; };
DI XcdBarrier xcd_barrier_post(unsigned* bar, volatile LAS unsigned* st) {
  XcdBarrier b; b.bar = bar; b.x = xb_xcc_id(); b.st = st;
  if (__builtin_amdgcn_workitem_id_x() == 0) (void)xb_add(&bar[XB_XCNT(b.x)], 1u);
  return b;
}
DI void xcd_barrier_complete(unsigned* bar, unsigned x, unsigned& nloc, unsigned& nx) {
  const unsigned G = gridDim.x * gridDim.y * gridDim.z;
  unsigned sum, cnt, mine, sp = 0u;
  for (;;) {
    sum = 0u; cnt = 0u; mine = 0u;
#pragma unroll
    for (unsigned j = 0; j < 16; ++j) { const unsigned c = xb_ld(&bar[XB_XCNT(j)]); sum += c; cnt += (c > 0u) ? 1u : 0u; mine = (j == x) ? c : mine; }
    if (sum == G) break;
    __builtin_amdgcn_s_sleep(1);
    if ((++sp & 255u) == 0u) { if (xb_ld(&bar[XB_TMO])) break; if (sp > XB_SPIN_CAP) { atomicAdd(&bar[XB_TMO], 1u); break; } }
  }
  nloc = mine > 0u ? mine : 1u; nx = cnt > 0u ? cnt : 1u;
}
DI void xcd_barrier(const XcdBarrier& b) {
  asm volatile("s_waitcnt vmcnt(0)" ::: "memory");
  __syncthreads();
  if (__builtin_amdgcn_workitem_id_x() == 0) {
    unsigned* bar = b.bar;
    __builtin_amdgcn_s_waitcnt(0);
    unsigned nloc = b.st[0], nx = b.st[1];
    if (nloc == 0u) { xcd_barrier_complete(bar, b.x, nloc, nx); b.st[0] = nloc; b.st[1] = nx; }
    const unsigned old = xb_add(&bar[XB_XSUB(b.x)], 1u);
    const unsigned gen = old / nloc;
    if (old + 1u == (gen + 1u) * nloc) {
      __builtin_amdgcn_fence(__ATOMIC_RELEASE, "agent");
      asm volatile("s_waitcnt vmcnt(0)" ::: "memory");
      const unsigned og = xb_add(&bar[XB_TOP], 1u);
      const unsigned tg = og / nx;
      if (og + 1u == (tg + 1u) * nx) xb_add(&bar[XB_TOPGEN], 1u);
      else XB_SPIN(xb_ld(&bar[XB_TOPGEN]) == tg, bar);
      __builtin_amdgcn_fence(__ATOMIC_ACQUIRE, "agent");
      xb_add(&bar[XB_XGEN(b.x)], 1u);
      asm volatile("s_waitcnt vmcnt(0)" ::: "memory");
    } else {
      XB_SPIN(xb_ld(&bar[XB_XGEN(b.x)]) == gen, bar);
      __builtin_amdgcn_fence(__ATOMIC_ACQUIRE, "agent");
      asm volatile("s_waitcnt vmcnt(0)" ::: "memory");
    }
  }
  __syncthreads();
}

DI int next_job(int* ctr, int* s_job) {
  __syncthreads();
  if (otid() == 0) *s_job = atomicAdd(ctr, 1);
  __syncthreads();
  return *s_job;
}

struct ConvDesc { const float* src; int K, Nsrc, Ndst, mode; size_t dst; };

__global__ void __launch_bounds__(256, 2) fwd_megakernel(Params p) {
  p.x = asg(p.x);
  p.mem = asg(p.mem);
  p.lb_param = asg(p.lb_param);
  p.norm_mix = asg(p.norm_mix);
  p.w_in = asg(p.w_in);
  p.w_out = asg(p.w_out);
  p.hg_o_gain = asg(p.hg_o_gain);
  p.dsa_kv_gain = asg(p.dsa_kv_gain);
  p.dsa_w_uk = asg(p.dsa_w_uk);
  p.dsa_w_uv = asg(p.dsa_w_uv);
  p.dsa_q_gain = asg(p.dsa_q_gain);
  p.dsa_k_gain = asg(p.dsa_k_gain);
  p.dsa_idxk_gain = asg(p.dsa_idxk_gain);
  p.nsa_pos_k = asg(p.nsa_pos_k);
  p.nsa_pos_v = asg(p.nsa_pos_v);
  p.nsa_k_w1 = asg(p.nsa_k_w1);
  p.nsa_k_w2 = asg(p.nsa_k_w2);
  p.nsa_v_w1 = asg(p.nsa_v_w1);
  p.nsa_v_w2 = asg(p.nsa_v_w2);
  p.nsa_q_gain = asg(p.nsa_q_gain);
  p.nsa_k_gains = asg(p.nsa_k_gains);
  p.ml_conv_w = asg(p.ml_conv_w);
  p.ml_conv_b = asg(p.ml_conv_b);
  p.ml_i_bias = asg(p.ml_i_bias);
  p.ml_f_bias = asg(p.ml_f_bias);
  p.ml_o_gain = asg(p.ml_o_gain);
  p.norm_xa = asg(p.norm_xa);
  p.norm_mem = asg(p.norm_mem);
  p.xa_wq = asg(p.xa_wq);
  p.xa_wkv = asg(p.xa_wkv);
  p.xa_wo = asg(p.xa_wo);
  p.xa_q_gain = asg(p.xa_q_gain);
  p.xa_k_gain = asg(p.xa_k_gain);
  p.norm_ffn = asg(p.norm_ffn);
  p.ffn_w13 = asg(p.ffn_w13);
  p.ffn_w2 = asg(p.ffn_w2);
  p.out = asg(p.out);
  cg::grid_group grid = cg::this_grid();
  __shared__ __attribute__((aligned(16))) char smem[SMEM_BYTES];
  int* s_job = (int*)(smem + SMEM_BYTES - 16);
  volatile LAS unsigned* xst = (volatile LAS unsigned*)(smem + SMEM_BYTES - 32);
  if (otid() == 0) { xst[0] = 0u; xst[1] = 0u; }
  __syncthreads();
  XcdBarrier xb = xcd_barrier_post((unsigned*)(p.ws + OFF_BAR), xst);
  int* ctr0 = (int*)(PWS + OFF_CTR);
  u16* WB = (u16*)(PWS + OFF_WB);
  u16* cols = (u16*)(PWS + OFF_COLS);
  u16* Hb = (u16*)(PWS + OFF_H);
  const int tid = otid();

  for (int ph2 = 0; ph2 < 2 * NPHASE; ++ph2) {
    const int ph = ph2 >> 1;
    const int layer = ph == 0 ? 0 : (ph - 1) / 14;
    const int kind = ph == 0 ? -1 : (ph - 1) % 14;
    if ((ph2 & 1) && DBG_REP == 99) { xcd_barrier(xb); continue; }
    if ((ph2 & 1) && kind != DBG_REP) continue;
    int* ctr = ctr0 + ((ph2 & 1) ? 32 : 0);
    const int sub = (ph2 & 1) ? DBG_SUB : 15;
    const u16* WL = WB + (size_t)layer * W_LAYER;
    int j;
    if (ph == 0) {
      const int NBIAS = 64, NUKV = 2, NROPE = 192, NMEM = 128, NCONV = 936 * 2, NX = 1024;
      const int total = NBIAS + NUKV + NROPE + NMEM + NCONV + NX;
      while ((j = next_job(&ctr[ph], s_job)) < total) {
        if (j < NBIAS) {
          int l = j >> 5, kv = (j >> 4) & 1, ng = j & 15;
          const float* pe = (kv ? p.nsa_pos_v : p.nsa_pos_k) + (size_t)l * 2048;
          const float* w1 = (kv ? p.nsa_v_w1 : p.nsa_k_w1) + (size_t)l * 2048 * 256;
          int nl = tid & 15, kp = tid >> 4;
          float a = 0.f;
#pragma unroll 8
          for (int k = kp * 128; k < kp * 128 + 128; ++k) a = fmaf(pe[k], w1[(size_t)k * 256 + ng * 16 + nl], a);
          float* red = (float*)smem;
          red[kp * 16 + nl] = a;
          __syncthreads();
          if (tid < 16) {
            float t = 0.f;
            for (int q = 0; q < 16; ++q) t += red[q * 16 + tid];
            ((float*)(PWS + OFF_BIAS1))[(l * 2 + kv) * 256 + ng * 16 + tid] = t;
          }
        } else if ((j -= NBIAS) < NUKV) {
          u16* wt = (u16*)(PWS + OFF_WUKV) + (size_t)j * 128 * 128;
          const float* uk = p.dsa_w_uk + (size_t)j * 128 * 64;
          const float* uv = p.dsa_w_uv + (size_t)j * 128 * 64;
          for (int e = tid; e < 128 * 128; e += 256) { int n = e >> 7, k = e & 127; wt[e] = f2bf(n < 64 ? uk[k * 64 + n] : uv[k * 64 + (n - 64)]); }
        } else if ((j -= NUKV) < NROPE) {
          int e = j * 256 + tid;
          int pos = e / 12, f = e % 12;
          float inv = f < 8 ? exp2f(-(float)f * (18.931568569324174f / 8.f)) : exp2f(-(float)(f - 8) * (18.931568569324174f / 4.f));
          float angf = (float)pos * inv;
          double ang = (double)angf;
          double k = rint(ang * 0.15915494309189535);
          float rr = (float)(ang - k * 6.283185307179586);
          float2 cs = make_float2(cosf(rr), sinf(rr));
          if (f < 8) ((float2*)(PWS + OFF_ROPE64))[pos * 8 + f] = cs; else ((float2*)(PWS + OFF_ROPE32))[pos * 4 + (f - 8)] = cs;
        } else if ((j -= NROPE) < NMEM) {
          int l = j >> 6, row0 = (j & 63) * 16;
          job_rmsnorm(p.mem, p.norm_mem + l * 1024, (u16*)(PWS + OFF_MEMH) + (size_t)l * 1024 * 1024, nullptr, row0);
        } else if ((j -= NMEM) < NCONV) {
          int l = j / 936, q = j % 936;
          const float* src; int K, Nsrc, mode, ntn; size_t dst;
          if (q < 216) { src = p.w_in + (size_t)l * 1024 * IN_COLS; K = 1024; Nsrc = IN_COLS; mode = 1; dst = WO_IN; ntn = 54; }
          else if ((q -= 216) < 64) { src = p.w_out + (size_t)l * 1024 * 1024; K = 1024; Nsrc = 1024; mode = 0; dst = WO_OUT; ntn = 16; }
          else if ((q -= 64) < 16) { src = p.xa_wq + (size_t)l * 1024 * 256; K = 1024; Nsrc = 256; mode = 0; dst = WO_Q; ntn = 4; }
          else if ((q -= 16) < 32) { src = p.xa_wkv + (size_t)l * 1024 * 512; K = 1024; Nsrc = 512; mode = 0; dst = WO_KV; ntn = 8; }
          else if ((q -= 32) < 16) { src = p.xa_wo + (size_t)l * 256 * 1024; K = 256; Nsrc = 1024; mode = 0; dst = WO_O; ntn = 16; }
          else if ((q -= 16) < 352) { src = p.ffn_w13 + (size_t)l * 1024 * 5632; K = 1024; Nsrc = 5632; mode = 2; dst = WO_13; ntn = 88; }
          else if ((q -= 352) < 176) { src = p.ffn_w2 + (size_t)l * 2816 * 1024; K = 2816; Nsrc = 1024; mode = 0; dst = WO_2; ntn = 16; }
          else if ((q -= 176) < 32) { src = p.nsa_k_w1 + (size_t)l * 2048 * 256; K = 2048; Nsrc = 256; mode = 0; dst = WO_KW1; ntn = 4; }
          else { q -= 32; src = p.nsa_v_w1 + (size_t)l * 2048 * 256; K = 2048; Nsrc = 256; mode = 0; dst = WO_VW1; ntn = 4; }
          job_convert(src, K, Nsrc, WB + (size_t)l * W_LAYER + dst, mode, q % ntn, q / ntn, (float*)smem);
        } else {
          j -= NCONV;
          job_rmsnorm(p.x, p.norm_mix, Hb, p.out, j * 16);
        }
      }
    } else if (kind == 0) {
      const int NG = 128 * 27, NM = layer == 0 ? 2 * 8 * 4 : 0;
      while ((j = next_job(&ctr[ph], s_job)) < NG + NM) {
        if (j < NG) gemm_tile<0, 0>(Hb, 1024, WL + WO_IN, 1024, j / 27, j % 27, smem, cols, NC, nullptr, 0);
        else { int q = j - NG; int l = q >> 5, tm = (q >> 2) & 7, tn = q & 3;
          gemm_tile<0, 0>((const u16*)(PWS + OFF_MEMH) + (size_t)l * 1024 * 1024, 1024, WB + (size_t)l * W_LAYER + WO_KV, 1024, tm, tn, smem,
                          (u16*)(PWS + OFF_MEMKV) + (size_t)l * 1024 * 512, 512, nullptr, 0); }
      }
    } else if (kind == 1) {
      const int NP = 512, NM = layer == 0 ? 64 : 0;
      while ((j = next_job(&ctr[ph], s_job)) < NP + NM) {
        if (j < NP) job_prep(p, layer, j, smem); else job_memkv_post(p, j - NP, smem);
      }
    } else if (kind == 2) {
      const int ND = 512, NCG = 32, NML = 1024, NHG = 1024;
      while ((j = next_job(&ctr[ph], s_job)) < ND + NCG + NML + NHG) {
        if (j < ND) { if (sub & 1) job_dsa(p, layer, j & 3, 127 - (j >> 2), smem, 0); }
        else if ((j -= ND) < NCG) { if (sub & 2) {
          int kv = j >> 4, tm = (j >> 1) & 7, tn = j & 1;
          gemm_tile<3, 1>(cols, 0, WL + (kv ? WO_VW1 : WO_KW1), 2048, tm, tn, smem, (u16*)(PWS + OFF_HID) + kv * 256, 512,
                          (const float*)(PWS + OFF_BIAS1) + (layer * 2 + kv) * 256, kv ? C_VC : C_KC); }
        } else if ((j -= NCG) < NML) { if (sub & 4) job_ml_A(p, layer, j, smem); }
        else { if (sub & 8) job_hg_A(p, layer, j - NML, smem); }
      }
    } else if (kind == 3) {
      const int NS = 256, NC2 = 128;
      while ((j = next_job(&ctr[ph], s_job)) < 512 + 2 * NS + NC2) {
        if (j < 512) job_dsa(p, layer, j & 3, 127 - (j >> 2), smem, 1);
        else if ((j -= 512) < NS) job_ml_scan(p, j); else if (j < 2 * NS) job_hg_scan(p, j - NS); else job_cmp2(p, layer, j - 2 * NS, smem);
      }
    } else if (kind == 4) {
      const int NN = 512, NML = 1024, NHG = 1024;
      while ((j = next_job(&ctr[ph], s_job)) < NN + NML + NHG) {
        if (j < NN) { if (sub & 1) job_nsa(p, layer, j & 3, 127 - (j >> 2), smem); }
        else if ((j -= NN) < NML) { if (sub & 2) job_ml_C(p, layer, j, smem); }
        else { if (sub & 4) job_hg_C(p, layer, j - NML, smem); }
      }
    } else if (kind == 5) {
      if (!(DBG_SKIP & 1)) while ((j = next_job(&ctr[ph], s_job)) < 128 * 8) gemm_tile<1, 0>(Hb, 1024, WL + WO_OUT, 1024, j >> 3, j & 7, smem, p.out, 1024, nullptr, 0, DBG_MK0, DBG_MK1);
    } else if (kind == 6 || kind == 10 || kind == 13) {
      if (kind == 13 && layer == 1) {   }
      else {
        const float* g = kind == 6 ? p.norm_xa + layer * 1024 : (kind == 10 ? p.norm_ffn + layer * 1024 : p.norm_mix + (layer + 1) * 1024);
        while ((j = next_job(&ctr[ph], s_job)) < 1024) job_rmsnorm(p.out, g, Hb, nullptr, j * 16);
      }
    } else if (kind == 7) {
      while ((j = next_job(&ctr[ph], s_job)) < 128 * 2) gemm_tile<0, 0>(Hb, 1024, WL + WO_Q, 1024, j >> 1, j & 1, smem, (u16*)(PWS + OFF_XQ), 256, nullptr, 0);
    } else if (kind == 8) {
      while ((j = next_job(&ctr[ph], s_job)) < 512) job_xattn(p, layer, j >> 7, (j >> 5) & 3, j & 31, smem);
    } else if (kind == 9) {
      if (!(DBG_SKIP & 2)) while ((j = next_job(&ctr[ph], s_job)) < 128 * 8) gemm_tile<1, 0>((const u16*)(PWS + OFF_XO), 256, WL + WO_O, 256, j >> 3, j & 7, smem, p.out, 1024, nullptr, 0);
    } else if (kind == 11) {
      while ((j = next_job(&ctr[ph], s_job)) < 128 * 44) gemm_tile<2, 0>(Hb, 1024, WL + WO_13, 1024, j / 44, j % 44, smem, (u16*)(PWS + OFF_G), DFF, nullptr, 0);
    } else if (kind == 12) {
      if (!(DBG_SKIP & 4)) while ((j = next_job(&ctr[ph], s_job)) < 128 * 8) gemm_tile<1, 0>((const u16*)(PWS + OFF_G), DFF, WL + WO_2, DFF, j >> 3, j & 7, smem, p.out, 1024, nullptr, 0);
    }
    if (ph2 + 1 < 2 * NPHASE) { if (p.use_cg) grid.sync(); else xcd_barrier(xb); }
  }
}

extern "C" void kernel_launch(void* const* d_in, const int* in_sizes, int n_in, void* d_out, int out_size, void* d_ws, size_t ws_size,
                              hipStream_t stream) {
  static int grid_blocks = 0;
  if (!grid_blocks) {
    int dev = 0, cus = 0, per_cu = 0;
    hipGetDevice(&dev);
    hipDeviceGetAttribute(&cus, hipDeviceAttributeMultiprocessorCount, dev);
    hipOccupancyMaxActiveBlocksPerMultiprocessor(&per_cu, fwd_megakernel, 256, 0);
    if (per_cu > 2) per_cu = 2;
    if (per_cu < 1) per_cu = 1;
    grid_blocks = cus * per_cu;
  }
  Params p{};
  const float** pp = (const float**)&p;
  for (int i = 0; i < 36; ++i) pp[i] = (const float*)d_in[i];
  p.out = (float*)d_out;
  p.ws = (char*)d_ws;
  p.use_cg = 0; p.pad_ = 0;
  hipMemsetAsync(d_ws, 0, 4096 + 16384, stream);
  void* args[] = {&p};
  hipError_t e = hipLaunchCooperativeKernel((void*)fwd_megakernel, dim3(grid_blocks), dim3(256), args, 0, stream);
  if (e != hipSuccess) fprintf(stderr, "cooperative launch failed: %s (grid %d)\n", hipGetErrorString(e), grid_blocks);
}
```

```cpp
#include <hip/hip_runtime.h>
#include <hip/hip_bf16.h>
#include <hip/hip_cooperative_groups.h>
#include <cstdio>
namespace cg = cooperative_groups;

#define DI __device__ __forceinline__
typedef unsigned short u16;
typedef unsigned long long u64;
typedef __attribute__((ext_vector_type(8))) short bf16x8;
typedef __attribute__((ext_vector_type(4))) short s16x4;
typedef __attribute__((ext_vector_type(16))) float f32x16;
typedef __attribute__((ext_vector_type(2))) float f32x2;
typedef __attribute__((ext_vector_type(4))) unsigned u32x4;
typedef __attribute__((ext_vector_type(4))) float f32x4v;
typedef __attribute__((ext_vector_type(2))) __bf16 bf16x2v;

constexpr int T_TOK = 16384, SEQL = 4096, NBATCH = 4, DM = 1024;
constexpr int NC = 3456;
constexpr int C_HGQ = 0, C_HGF = 256, C_HGI = 512, C_HGG = 768;
constexpr int C_DQ = 1024, C_CKV = 1280, C_IQ = 1408;
constexpr int C_NQ = 1664, C_KC = 1920, C_VC = 1984, C_KS = 2048, C_VS = 2112, C_KW = 2176, C_VW = 2240;
constexpr int C_MQ = 2304, C_MK = 2560, C_MV = 2816, C_MOG = 3072;
constexpr int C_IK = 3328, C_IW = 3360, C_GATES = 3368, C_IG = 3380, C_FG = 3384;
constexpr int IN_COLS = 3388, DFF = 2816;

constexpr size_t WO_IN = 0;
constexpr size_t WO_OUT = WO_IN + (size_t)NC * 1024;
constexpr size_t WO_Q = WO_OUT + 1024 * 1024;
constexpr size_t WO_KV = WO_Q + 256 * 1024;
constexpr size_t WO_O = WO_KV + 512 * 1024;
constexpr size_t WO_13 = WO_O + 1024 * 256;
constexpr size_t WO_2 = WO_13 + (size_t)5632 * 1024;
constexpr size_t WO_KW1 = WO_2 + (size_t)1024 * 2816;
constexpr size_t WO_VW1 = WO_KW1 + 256 * 2048;
constexpr size_t W_LAYER = WO_VW1 + 256 * 2048;

constexpr size_t al256(size_t x) { return (x + 255) & ~(size_t)255; }
constexpr size_t OFF_CTR = 0;
constexpr size_t OFF_BAR = 4096;
constexpr size_t OFF_ROPE64 = 4096 + 16384;
constexpr size_t OFF_ROPE32 = OFF_ROPE64 + 4096 * 8 * 8;
constexpr size_t OFF_BIAS1 = OFF_ROPE32 + 4096 * 4 * 8;
constexpr size_t OFF_WB = al256(OFF_BIAS1 + 4096);
constexpr size_t OFF_COLS = al256(OFF_WB + 2 * W_LAYER * 2);
constexpr size_t OFF_H = al256(OFF_COLS + (size_t)T_TOK * NC * 2);
constexpr size_t OFF_HGST = al256(OFF_H + (size_t)T_TOK * 1024 * 2);
constexpr size_t OFF_MLST = al256(OFF_HGST + (size_t)1024 * 4096 * 4);
constexpr size_t OFF_HGD = al256(OFF_MLST + (size_t)1024 * 4096 * 4);
constexpr size_t OFF_MLN = al256(OFF_HGD + 1024 * 64 * 4);
constexpr size_t OFF_MLSC = al256(OFF_MLN + 1024 * 64 * 4);
constexpr size_t OFF_DK = al256(OFF_MLSC + 3 * 1024 * 4);
constexpr size_t OFF_DVT = al256(OFF_DK + (size_t)T_TOK * 64 * 2);
constexpr size_t OFF_VST = al256(OFF_DVT + (size_t)T_TOK * 64 * 2);
constexpr size_t OFF_VWT = al256(OFF_VST + (size_t)T_TOK * 64 * 2);
constexpr size_t OFF_KCMP = al256(OFF_VWT + (size_t)T_TOK * 64 * 2);
constexpr size_t OFF_VCMPT = al256(OFF_KCMP + 4 * 256 * 64 * 2);
constexpr size_t OFF_HID = al256(OFF_VCMPT + 4 * 256 * 64 * 2);
constexpr size_t OFF_MEMH = al256(OFF_HID + 1024 * 512 * 2);
constexpr size_t OFF_MEMKV = al256(OFF_MEMH + 2 * 1024 * 1024 * 2);
constexpr size_t OFF_MEMVT = al256(OFF_MEMKV + 2 * 1024 * 512 * 2);
constexpr size_t OFF_IKC = al256(OFF_MEMVT + 2 * 4 * 256 * 256 * 2);
constexpr size_t OFF_WUKV = al256(OFF_IKC + (size_t)T_TOK * 32 * 2);
constexpr size_t OFF_KSC = al256(OFF_WUKV + 2 * 128 * 128 * 2);
constexpr size_t OFF_KWC = al256(OFF_KSC + (size_t)T_TOK * 64 * 2);
constexpr size_t OFF_DSAST = al256(OFF_KWC + (size_t)T_TOK * 64 * 2);
constexpr size_t OFF_END = al256(OFF_DSAST + 512 * 128 * 4);
static_assert(OFF_END <= (size_t)256 * 1024 * 1024, "workspace overflow");
constexpr size_t OFF_XQ = OFF_HGST;
constexpr size_t OFF_XO = OFF_MLST;
constexpr size_t OFF_G = OFF_COLS;

constexpr int SMEM_BYTES = 75776;
constexpr int NPHASE = 28;
#define DBG_SKIP 0
#define DBG_REP -2
#define DBG_SUB 15
#define DBG_ATT_REP 1
#define DBG_EPI_REP 1
#define DBG_SELREP 1
#define DBG_SLC_REP 1
#define DBG_SWA_REP 1
#define DBG_MK0 0
#define DBG_MK1 16

struct Params {
  const float* x; const float* mem; const float* lb_param; const float* norm_mix; const float* w_in; const float* w_out;
  const float* hg_o_gain; const float* dsa_kv_gain; const float* dsa_w_uk; const float* dsa_w_uv; const float* dsa_q_gain;
  const float* dsa_k_gain; const float* dsa_idxk_gain; const float* nsa_pos_k; const float* nsa_pos_v; const float* nsa_k_w1;
  const float* nsa_k_w2; const float* nsa_v_w1; const float* nsa_v_w2; const float* nsa_q_gain; const float* nsa_k_gains;
  const float* ml_conv_w; const float* ml_conv_b; const float* ml_i_bias; const float* ml_f_bias; const float* ml_o_gain;
  const float* norm_xa; const float* norm_mem; const float* xa_wq; const float* xa_wkv; const float* xa_wo; const float* xa_q_gain;
  const float* xa_k_gain; const float* norm_ffn; const float* ffn_w13; const float* ffn_w2;
  float* out; char* ws;
  int use_cg; int pad_;
};

DI int otid() { int t = __builtin_amdgcn_workitem_id_x(); asm volatile("" : "+v"(t)); return t; }
typedef __attribute__((address_space(1))) char gchar_t;
DI char* oq(char* x) { gchar_t* g = (gchar_t*)x; asm volatile("" : "+s"(g)); return (char*)g; }
template <class T> DI T* asg(T* q) { return (T*)(__attribute__((address_space(1))) T*)q; }
#define PWS (oq(p.ws))
DI float bf2f(u16 v) { return __uint_as_float(((unsigned)v) << 16); }
DI unsigned pack2(float a, float b) { f32x2 v = {a, b}; return __builtin_bit_cast(unsigned, __builtin_convertvector(v, bf16x2v)); }
DI u16 f2bf(float a) { return (u16)(pack2(a, 0.f) & 0xffffu); }
DI float sigmoidf_(float x) { return 1.f / (1.f + expf(-x)); }
DI float siluf_(float x) { return x / (1.f + expf(-x)); }
DI int crow(int reg, int h) { return (reg & 3) + 8 * (reg >> 2) + 4 * h; }
DI f32x16 zero16() { f32x16 z; for (int i = 0; i < 16; ++i) z[i] = 0.f; return z; }
#define MFMA_BF(a, b, c) __builtin_amdgcn_mfma_f32_32x32x16_bf16((a), (b), (c), 0, 0, 0)
#define MFMA_F32(a, b, c) __builtin_amdgcn_mfma_f32_32x32x2f32((a), (b), (c), 0, 0, 0)
DI float wave_sum(float v) { for (int o = 32; o; o >>= 1) v += __shfl_xor(v, o); return v; }
DI float wave_max(float v) { for (int o = 32; o; o >>= 1) v = fmaxf(v, __shfl_xor(v, o)); return v; }
DI void load4bf(const u16* p, float (&x)[4]) { uint2 v = *(const uint2*)p; x[0] = __uint_as_float(v.x << 16); x[1] = __uint_as_float(v.x & 0xffff0000u); x[2] = __uint_as_float(v.y << 16); x[3] = __uint_as_float(v.y & 0xffff0000u); }
DI void ld8bf(const u16* p, float (&x)[8]) {
  u32x4 v = *(const u32x4*)p;
  x[0] = __uint_as_float(v.x << 16); x[1] = __uint_as_float(v.x & 0xffff0000u);
  x[2] = __uint_as_float(v.y << 16); x[3] = __uint_as_float(v.y & 0xffff0000u);
  x[4] = __uint_as_float(v.z << 16); x[5] = __uint_as_float(v.z & 0xffff0000u);
  x[6] = __uint_as_float(v.w << 16); x[7] = __uint_as_float(v.w & 0xffff0000u);
}
DI void store4bf(u16* p, const float (&x)[4]) { uint2 v; v.x = pack2(x[0], x[1]); v.y = pack2(x[2], x[3]); *(uint2*)p = v; }

template <int W>
DI void rowop(float (&x)[4], int lg, const float* gain, bool do_norm, bool do_rope, int pos, const float2* ropetab) {
  if (do_norm) {
    float ss = x[0] * x[0] + x[1] * x[1] + x[2] * x[2] + x[3] * x[3];
#pragma unroll
    for (int o = W / 8; o >= 1; o >>= 1) ss += __shfl_xor(ss, o);
    float rstd = rsqrtf(ss * (1.f / W) + 1e-6f);
#pragma unroll
    for (int i = 0; i < 4; ++i) x[i] = x[i] * rstd * gain[lg * 4 + i];
  }
  if (do_rope) {
    constexpr int HALF = W / 8, LPH = HALF / 4;
    float xp[4];
#pragma unroll
    for (int i = 0; i < 4; ++i) xp[i] = __shfl_xor(x[i], LPH);
    const float4* tp = (const float4*)(ropetab + pos * HALF + (lg % LPH) * 4);
    const float4 c01 = tp[0], c23 = tp[1];
    const float cs[4] = {c01.x, c01.z, c23.x, c23.z};
    const float sn[4] = {c01.y, c01.w, c23.y, c23.w};
    const bool rot = lg < 2 * LPH;
    const bool isx2 = lg >= LPH;
#pragma unroll
    for (int i = 0; i < 4; ++i) {
      float rv = isx2 ? (x[i] * cs[i] + xp[i] * sn[i]) : (x[i] * cs[i] - xp[i] * sn[i]);
      x[i] = rot ? rv : x[i];
    }
  }
}

DI int map_in(int n) {
  if (n < 1664) return n;
  if (n < 2304) return n + 40;
  if (n < 3328) return n + 52;
  if (n < 3360) return 1664 + (n - 3328);
  if (n < 3368) return 1696 + (n - 3360);
  if (n < 3380) return 2344 + (n - 3368);
  if (n < 3388) return n;
  return -1;
}
DI int map_w13(int n) { int blk = n >> 6, w = n & 63; return w < 32 ? blk * 32 + w : 2816 + blk * 32 + (w - 32); }

DI void job_convert(const float* src, int K, int Nsrc, u16* dst, int mode, int tile_n, int tile_k4, float* sm) {
  const int tid = otid(), tx = tid & 15, ty = tid >> 4;
  int n = tile_n * 64 + tx * 4;
  int sn = mode == 0 ? n : (mode == 1 ? map_in(n) : map_w13(n));
  float4 v[16];
#pragma unroll
  for (int i = 0; i < 16; ++i) {
    int kl = ty + 16 * i;
    v[i] = sn >= 0 ? *(const float4*)(src + (size_t)(tile_k4 * 256 + kl) * Nsrc + sn) : make_float4(0.f, 0.f, 0.f, 0.f);
  }
#pragma unroll
  for (int i = 0; i < 16; ++i) {
    int kl = ty + 16 * i;
    float* t = sm + (kl >> 6) * (64 * 65) + (kl & 63) * 65 + tx * 4;
    t[0] = v[i].x; t[1] = v[i].y; t[2] = v[i].z; t[3] = v[i].w;
  }
  __syncthreads();
  int row = tid >> 2, seg = tid & 3;
#pragma unroll
  for (int q = 0; q < 4; ++q) {
    const float* t = sm + q * (64 * 65);
    unsigned pk[8];
#pragma unroll
    for (int i = 0; i < 8; ++i) pk[i] = pack2(t[(seg * 16 + 2 * i) * 65 + row], t[(seg * 16 + 2 * i + 1) * 65 + row]);
    uint4* d = (uint4*)(dst + (size_t)(tile_n * 64 + row) * K + tile_k4 * 256 + q * 64 + seg * 16);
    d[0] = make_uint4(pk[0], pk[1], pk[2], pk[3]);
    d[1] = make_uint4(pk[4], pk[5], pk[6], pk[7]);
  }
}

DI void job_rmsnorm(const float* X, const float* gain, u16* H, float* copy_out, int row0) {
  const int tid = otid(), lane = tid & 63, w = tid >> 6;
  for (int i = 0; i < 4; ++i) {
    int row = row0 + w * 4 + i;
    const float4* xr = (const float4*)(X + (size_t)row * 1024);
    float4 v[4];
    float ss = 0.f;
#pragma unroll
    for (int j = 0; j < 4; ++j) { v[j] = xr[lane + 64 * j]; ss += v[j].x * v[j].x + v[j].y * v[j].y + v[j].z * v[j].z + v[j].w * v[j].w; }
    ss = wave_sum(ss);
    float rstd = rsqrtf(ss * (1.f / 1024.f) + 1e-6f);
#pragma unroll
    for (int j = 0; j < 4; ++j) {
      float4 g = ((const float4*)gain)[lane + 64 * j];
      uint2 o; o.x = pack2(v[j].x * rstd * g.x, v[j].y * rstd * g.y); o.y = pack2(v[j].z * rstd * g.z, v[j].w * rstd * g.w);
      *(uint2*)(H + (size_t)row * 1024 + (lane + 64 * j) * 4) = o;
      if (copy_out) ((float4*)(copy_out + (size_t)row * 1024))[lane + 64 * j] = v[j];
    }
  }
}

template <int EPI, int AMODE>
DI void gemm_tile(const u16* __restrict__ A, int lda, const u16* __restrict__ Bt, int K, int tm, int tn, char* smem,
                  void* Cp, int ldc, const float* bias, int coff, int kt0 = 0, int kt1 = -1) {
  char* As = smem;
  char* Bs = smem + 32768;
  const int tid = otid(), lane = tid & 63, w = tid >> 6;
  const int r = lane & 31, h = lane >> 5, wm = w >> 1, wn = w & 1;
  const int lr8 = lane >> 3, lc = (lane & 7) ^ lr8;
  const u16* ap[4];
  const u16* bp[4];
#pragma unroll
  for (int q = 0; q < 4; ++q) {
    int rowl = (w * 4 + q) * 8 + lr8;
    int row = tm * 128 + rowl;
    if (AMODE == 0) ap[q] = A + (size_t)row * lda + lc * 8;
    else { int m = row < 1019 ? row : 1019; int b = m / 255, j = m % 255; ap[q] = A + ((size_t)(b * 4096 + 16 * j)) * NC + coff + lc * 8; }
    bp[q] = Bt + (size_t)(tn * 128 + rowl) * K + lc * 8;
  }
  const size_t akstep = AMODE == 0 ? 64 : NC;
  f32x4v acc[4][4];
#pragma unroll
  for (int a = 0; a < 4; ++a)
#pragma unroll
    for (int b = 0; b < 4; ++b) acc[a][b] = f32x4v{0.f, 0.f, 0.f, 0.f};
  const int nk = kt1 < 0 ? K / 64 : kt1;
#define G_ISSUE(BUF, KT) _Pragma("unroll") for (int q = 0; q < 4; ++q) { \
    __builtin_amdgcn_global_load_lds((const unsigned*)(ap[q] + (size_t)(KT) * akstep), (unsigned*)(As + (BUF) * 16384 + (w * 4 + q) * 1024), 16, 0, 0); \
    __builtin_amdgcn_global_load_lds((const unsigned*)(bp[q] + (size_t)(KT) * 64), (unsigned*)(Bs + (BUF) * 16384 + (w * 4 + q) * 1024), 16, 0, 0); }
  const int l15 = lane & 15, lq = lane >> 4, l7 = lane & 7;
  G_ISSUE(0, kt0)
  __syncthreads();
  for (int kt = kt0; kt < nk; ++kt) {
    const int cur = (kt - kt0) & 1;
    if (kt + 1 < nk) { G_ISSUE(cur ^ 1, kt + 1) }
    const char* Ac = As + cur * 16384;
    const char* Bc = Bs + cur * 16384;
#pragma unroll
    for (int s = 0; s < 2; ++s) {
      const int co = ((4 * s + lq) ^ l7) * 16;
      bf16x8 af[4], bfr[4];
#pragma unroll
      for (int mt = 0; mt < 4; ++mt) af[mt] = *(const bf16x8*)(Ac + (wm * 64 + mt * 16 + l15) * 128 + co);
#pragma unroll
      for (int nt = 0; nt < 4; ++nt) bfr[nt] = *(const bf16x8*)(Bc + (wn * 64 + nt * 16 + l15) * 128 + co);
#pragma unroll
      for (int mt = 0; mt < 4; ++mt)
#pragma unroll
        for (int nt = 0; nt < 4; ++nt) acc[mt][nt] = __builtin_amdgcn_mfma_f32_16x16x32_bf16(af[mt], bfr[nt], acc[mt][nt], 0, 0, 0);
    }
    __syncthreads();
  }
#undef G_ISSUE
#pragma unroll
  for (int mt = 0; mt < 4; ++mt) {
#pragma unroll
    for (int reg = 0; reg < 4; ++reg) {
      const int row = tm * 128 + wm * 64 + mt * 16 + lq * 4 + reg;
      if (EPI == 0) {
        u16* C = (u16*)Cp;
#pragma unroll
        for (int nt = 0; nt < 4; ++nt) C[(size_t)row * ldc + tn * 128 + wn * 64 + nt * 16 + l15] = f2bf(acc[mt][nt][reg]);
      } else if (EPI == 1) {
        float* C = (float*)Cp;
#pragma unroll
        for (int nt = 0; nt < 4; ++nt) { float* q = C + (size_t)row * ldc + tn * 128 + wn * 64 + nt * 16 + l15; *q = *q + acc[mt][nt][reg]; }
      } else if (EPI == 2) {
        u16* C = (u16*)Cp;
#pragma unroll
        for (int nt = 0; nt < 2; ++nt) {
          float av = acc[mt][nt][reg], bv = acc[mt][nt + 2][reg];
          C[(size_t)row * ldc + (tn * 2 + wn) * 32 + nt * 16 + l15] = f2bf(siluf_(av) * bv);
        }
      } else {
        u16* C = (u16*)Cp;
        if (row < 1020) {
#pragma unroll
          for (int nt = 0; nt < 4; ++nt) {
            int col = tn * 128 + wn * 64 + nt * 16 + l15;
            C[(size_t)row * ldc + col] = f2bf(fmaxf(acc[mt][nt][reg] + bias[col], 0.f));
          }
        }
      }
    }
  }
}

struct AttnAcc { f32x16 o0, o1; float m, l; };
DI void attn_init(AttnAcc& a) { a.o0 = zero16(); a.o1 = zero16(); a.m = -INFINITY; a.l = 0.f; }

template <class SrcF, class PosF>
DI void stage_q(u16* Qs, SrcF src, PosF posf, const float* gain, bool do_norm, bool do_rope, const float2* rope64, float scale) {
  const int tid = otid(), lg = tid & 15;
#pragma unroll
  for (int it = 0; it < 8; ++it) {
    int row = it * 16 + (tid >> 4);
    int slot = row >> 5, r = row & 31;
    float x[4];
    load4bf(src(slot, r) + lg * 4, x);
    rowop<64>(x, lg, gain, do_norm, do_rope, posf(slot, r), rope64);
#pragma unroll
    for (int i = 0; i < 4; ++i) x[i] *= scale;
    store4bf(Qs + (slot * 32 + r) * 72 + lg * 4, x);
  }
}
DI void load_qfrags(bf16x8 (&qf)[4], const u16* Qs, int slot, int r, int h) {
#pragma unroll
  for (int s = 0; s < 4; ++s) qf[s] = *(const bf16x8*)(Qs + (slot * 32 + r) * 72 + s * 16 + h * 8);
}

constexpr int KV_BUF = 32 * 72 + 64 * 40;

template <class TileF, class MaskF>
DI void attn_run(AttnAcc& a, const bf16x8 (&qf)[4], const u16* Kb, size_t kstride, int kmaxrow, const u16* Vtb, size_t vstride,
                 int ntiles, TileF tile_at, MaskF mask_at, u16* kvs) {
  const int tid = otid(), lane = tid & 63;
  const int r = lane & 31, h = lane >> 5;
  const int krow = tid >> 3, kseg = tid & 7, vrow = tid >> 2, vseg = tid & 3;
  if (ntiles <= 0) return;
  u32x4 rk, rv;
  {
    int kt = tile_at(0);
    int kr = kt * 32 + krow; kr = kr < kmaxrow ? kr : kmaxrow;
    rk = *(const u32x4*)(Kb + (size_t)kr * kstride + kseg * 8);
    rv = *(const u32x4*)(Vtb + (size_t)vrow * vstride + kt * 32 + vseg * 8);
  }
  __syncthreads();
  *(u32x4*)(kvs + krow * 72 + kseg * 8) = rk;
  *(u32x4*)(kvs + 32 * 72 + vrow * 40 + vseg * 8) = rv;
  __syncthreads();
  for (int i = 0; i < ntiles; ++i) {
    const int kt = tile_at(i);
    const int cur = i & 1;
    if (i + 1 < ntiles) {
      int kn = tile_at(i + 1);
      int kr = kn * 32 + krow; kr = kr < kmaxrow ? kr : kmaxrow;
      rk = *(const u32x4*)(Kb + (size_t)kr * kstride + kseg * 8);
      rv = *(const u32x4*)(Vtb + (size_t)vrow * vstride + kn * 32 + vseg * 8);
    }
    const u16* Kc = kvs + cur * KV_BUF;
    const u16* Vc = Kc + 32 * 72;
    f32x16 s = zero16();
#pragma unroll
    for (int ks = 0; ks < 4; ++ks) {
      bf16x8 kf = *(const bf16x8*)(Kc + r * 72 + ks * 16 + h * 8);
      s = MFMA_BF(kf, qf[ks], s);
    }
    unsigned mw = mask_at(kt);
    float mx = -INFINITY;
#pragma unroll
    for (int reg = 0; reg < 16; ++reg) {
      bool bit = (mw >> crow(reg, h)) & 1u;
      s[reg] = bit ? s[reg] : -INFINITY;
      mx = fmaxf(mx, s[reg]);
    }
    mx = fmaxf(mx, __shfl_xor(mx, 32));
    float mnew = fmaxf(a.m, mx);
    float mb = (mnew == -INFINITY) ? 0.f : mnew;
    float alpha = __builtin_amdgcn_exp2f(a.m - mb);
    float psum = 0.f;
#pragma unroll
    for (int reg = 0; reg < 16; ++reg) { float pv = __builtin_amdgcn_exp2f(s[reg] - mb); psum += pv; s[reg] = pv; }
    a.l = a.l * alpha + psum;
    a.m = mnew;
#pragma unroll
    for (int reg = 0; reg < 16; ++reg) { a.o0[reg] *= alpha; a.o1[reg] *= alpha; }
#pragma unroll
    for (int s2 = 0; s2 < 2; ++s2) {
      uint4 pu;
      pu.x = pack2(s[8 * s2 + 0], s[8 * s2 + 1]); pu.y = pack2(s[8 * s2 + 2], s[8 * s2 + 3]);
      pu.z = pack2(s[8 * s2 + 4], s[8 * s2 + 5]); pu.w = pack2(s[8 * s2 + 6], s[8 * s2 + 7]);
      bf16x8 pf = __builtin_bit_cast(bf16x8, pu);
#pragma unroll
      for (int dt = 0; dt < 2; ++dt) {
        uint2 lo = *(const uint2*)(Vc + (dt * 32 + r) * 40 + 16 * s2 + 4 * h);
        uint2 hi = *(const uint2*)(Vc + (dt * 32 + r) * 40 + 16 * s2 + 8 + 4 * h);
        uint4 vu = make_uint4(lo.x, lo.y, hi.x, hi.y);
        bf16x8 vf = __builtin_bit_cast(bf16x8, vu);
        if (dt == 0) a.o0 = MFMA_BF(vf, pf, a.o0); else a.o1 = MFMA_BF(vf, pf, a.o1);
      }
    }
    if (i + 1 < ntiles) {
      u16* Kn = kvs + (cur ^ 1) * KV_BUF;
      *(u32x4*)(Kn + krow * 72 + kseg * 8) = rk;
      *(u32x4*)(Kn + 32 * 72 + vrow * 40 + vseg * 8) = rv;
    }
    __syncthreads();
  }
}

DI unsigned lowmask(int n) { return n <= 0 ? 0u : (n >= 32 ? 0xffffffffu : ((1u << n) - 1u)); }

DI void dsa_scores(f32x16& sc, const bf16x8& kf0, const bf16x8& kf1, int h, const u16* iqrow, const float (&wq)[8]) {
  {
    bf16x8 q0 = *(const bf16x8*)(iqrow + 256 + h * 8);
    bf16x8 q1 = *(const bf16x8*)(iqrow + 256 + 16 + h * 8);
    sc = zero16();
    sc = MFMA_BF(kf0, q0, sc);
    sc = MFMA_BF(kf1, q1, sc);
  }
#pragma unroll
  for (int hh = 0; hh < 8; ++hh) {
    bf16x8 q0 = *(const bf16x8*)(iqrow + hh * 32 + h * 8);
    bf16x8 q1 = *(const bf16x8*)(iqrow + hh * 32 + 16 + h * 8);
    f32x16 a = zero16();
    a = MFMA_BF(kf0, q0, a);
    a = MFMA_BF(kf1, q1, a);
#pragma unroll
    for (int reg = 0; reg < 16; ++reg) sc[reg] = fmaf(wq[hh], __builtin_fabsf(a[reg]), sc[reg]);
    if (hh & 1) __builtin_amdgcn_sched_barrier(0);
  }
}
DI unsigned okey_of(float s) {
  unsigned u = __float_as_uint(s + 0.f);
  return u ^ ((unsigned)((int)u >> 31) | 0x80000000u);
}

template <int MODE>
DI void dsa_hist_tiles(unsigned* hist, const u16* ikc, const u16* iqrow, const float (&wq)[8], int w, int r, int h, int lane, int ntile, int tq,
                       unsigned mhi, unsigned mlo, int shm, int shd, bool last_idx) {
  int kt = w;
  bf16x8 n0, n1;
  if (kt < ntile) { const u16* kp = ikc + (size_t)(kt * 32 + r) * 32 + h * 8; n0 = *(const bf16x8*)kp; n1 = *(const bf16x8*)(kp + 16); }
  for (; kt < ntile; kt += 4) {
    bf16x8 kf0 = n0, kf1 = n1;
    if (kt + 4 < ntile) { const u16* kp = ikc + (size_t)((kt + 4) * 32 + r) * 32 + h * 8; n0 = *(const bf16x8*)kp; n1 = *(const bf16x8*)(kp + 16); }
    f32x16 sc;
    dsa_scores(sc, kf0, kf1, h, iqrow, wq);
#pragma unroll
    for (int reg = 0; reg < 16; ++reg) {
      const int sidx = kt * 32 + crow(reg, h);
      const unsigned ok = okey_of(sc[reg]);
      bool sel = sidx <= tq;
      unsigned digit;
      if (MODE == 0) { digit = ok >> 24; }
      else if (MODE == 1) { sel = sel && ((ok >> shm) == mhi); digit = (ok >> shd) & 255u; }
      else { const unsigned ri = 4095u - (unsigned)sidx; sel = sel && (ok == mhi) && (last_idx ? ((ri >> 4) == mlo) : true); digit = last_idx ? (ri & 15u) : (ri >> 4); }
      const int addr = sel ? (r * 257 + (int)digit) : (32 * 257 + lane);
      atomicAdd(&hist[addr], 1u);
    }
  }
}

constexpr int DSA_CAP = 64;

DI void job_dsa(const Params& p, int layer, int b, int tt, char* smem, int mode) {
  const int tid = otid(), lane = tid & 63, w = tid >> 6, r = lane & 31, h = lane >> 5;
  const int t0 = tt * 32, ntile = tt + 1;
  u16* cols = (u16*)(PWS + OFF_COLS);
  const u16* cb = cols + (size_t)b * SEQL * NC;
  const u16* ikc = (const u16*)(PWS + OFF_IKC) + (size_t)b * SEQL * 32;
  unsigned* hist = (unsigned*)smem;
  unsigned* candk = (unsigned*)smem;
  unsigned* candi = (unsigned*)(smem + 8192);
  unsigned* candn = (unsigned*)(smem + 16384);
  u16* Qs = (u16*)smem;
  u16* kvs = (u16*)(smem + 18432);
  unsigned* maskw = (unsigned*)(smem + 37888);
  unsigned* segs = (unsigned*)(smem + 54272);
  unsigned* prehi = (unsigned*)(smem + 55296);
  unsigned* prelo = (unsigned*)(smem + 55424);
  unsigned* need = (unsigned*)(smem + 55552);
  int* flags = (int*)(smem + 55680);
  const float2* rope64 = (const float2*)(PWS + OFF_ROPE64);

  unsigned* gst = (unsigned*)(PWS + OFF_DSAST) + (size_t)(b * 128 + tt) * 128;
  const u16* qrow = cb + (size_t)(t0 + r) * NC;
  u16* iqs = (u16*)(smem + 55808);
  for (int i = 0; i < 4; ++i) {
    int c = tid + 256 * i; int row = c >> 5, seg = c & 31;
    *(u32x4*)(iqs + row * 296 + seg * 8) = *(const u32x4*)(cb + (size_t)(t0 + row) * NC + C_IQ + seg * 8);
  }
  const u16* iqrow = iqs + r * 296;
  float wq[8];
  { float a[4], c[4]; load4bf(qrow + C_IW, a); load4bf(qrow + C_IW + 4, c);
#pragma unroll
    for (int i = 0; i < 4; ++i) { wq[i] = 0.5f * a[i]; wq[4 + i] = 0.5f * c[i]; } }

  int lastpass = 0;
  bool fast = false, done = false;
  if (mode == 0) {
    if (tid < 32) { prehi[tid] = 0; prelo[tid] = 0; int nd = t0 + tid + 1; need[tid] = nd < 256 ? nd : 256; }
  } else {
    if (tid < 32) { prehi[tid] = gst[tid]; prelo[tid] = gst[32 + tid]; need[tid] = gst[64 + tid]; }
    lastpass = (int)gst[96]; done = gst[97] != 0u; fast = gst[98] != 0u;
    if (mode == 1 && done) return;
  }
  if (tid < 16) flags[tid] = 0;
  __syncthreads();
  {
    int row = tid >> 3, lg = tid & 7;
    const u16* wr = cb + (size_t)(t0 + row) * NC + C_IW;
    float acc4[4] = {0.f, 0.f, 0.f, 0.f};
#pragma unroll
    for (int hh = 0; hh < 8; ++hh) {
      float wv = 0.5f * bf2f(wr[hh]);
      float x[4]; load4bf(iqs + row * 296 + hh * 32 + lg * 4, x);
#pragma unroll
      for (int i = 0; i < 4; ++i) acc4[i] = fmaf(wv, x[i], acc4[i]);
    }
    store4bf(iqs + row * 296 + 256 + lg * 4, acc4);
  }
  const int tq = t0 + r;
  const int pbeg = mode == 0 ? 0 : (mode == 1 ? 1 : ((done || fast) ? 6 : 2));
  const int pend = mode == 0 ? 1 : (mode == 1 ? 2 : 6);
  for (int pass = pbeg; pass < pend; ++pass) {
    for (int i = tid; i < 32 * 257 + 64; i += 256) hist[i] = 0;
    __syncthreads();
    const unsigned mhi = prehi[r], mlo = prelo[r];
    if (pass == 0) dsa_hist_tiles<0>(hist, ikc, iqrow, wq, w, r, h, lane, ntile, tq, mhi, mlo, 0, 0, false);
    else if (pass < 4) dsa_hist_tiles<1>(hist, ikc, iqrow, wq, w, r, h, lane, ntile, tq, mhi, mlo, 32 - 8 * pass, 24 - 8 * pass, false);
    else dsa_hist_tiles<2>(hist, ikc, iqrow, wq, w, r, h, lane, ntile, tq, mhi, mlo, 0, 0, pass == 5);
    __syncthreads();
    {
      int row = tid >> 3, part = tid & 7;
      unsigned sum = 0;
      for (int i = 0; i < 32; ++i) sum += hist[row * 257 + part * 32 + i];
      segs[row * 8 + part] = sum;
    }
    __syncthreads();
    if ((tid & 7) == 0) {
      int row = tid >> 3;
      unsigned nd = need[row], cum = 0;
      int pt = 7;
      for (; pt > 0; --pt) { unsigned c = segs[row * 8 + pt]; if (cum + c >= nd) break; cum += c; }
      int bin = pt * 32 + 31;
      for (; bin > pt * 32; --bin) { unsigned c = hist[row * 257 + bin]; if (cum + c >= nd) break; cum += c; }
      unsigned cnt = hist[row * 257 + bin];
      if (pass < 4) prehi[row] = (prehi[row] << 8) | (unsigned)bin;
      else if (pass == 4) prelo[row] = (unsigned)bin;
      else prelo[row] = (prelo[row] << 4) | (unsigned)bin;
      need[row] = nd - cum;
      if (cnt != nd - cum) atomicOr(&flags[pass], 1);
      if (pass == 1 && cnt > (unsigned)DSA_CAP) atomicOr(&flags[8], 1);
    }
    __syncthreads();
    lastpass = pass;
    if (flags[pass] == 0) { done = true; break; }
    if (pass == 1 && flags[8] == 0) { fast = true; break; }
  }
  if (mode < 2) {
    if (tid < 32) { gst[tid] = prehi[tid]; gst[32 + tid] = prelo[tid]; gst[64 + tid] = need[tid]; }
    if (tid == 0) { gst[96] = (unsigned)lastpass; gst[97] = done ? 1u : 0u; gst[98] = fast ? 1u : 0u; }
    return;
  }
  if (fast) {
    if (tid < 32) candn[tid] = 0;
    __syncthreads();
    const unsigned t16 = prehi[r];
    int kt = w;
    bf16x8 n0, n1;
    if (kt < ntile) { const u16* kp = ikc + (size_t)(kt * 32 + r) * 32 + h * 8; n0 = *(const bf16x8*)kp; n1 = *(const bf16x8*)(kp + 16); }
    for (; kt < ntile; kt += 4) {
      bf16x8 kf0 = n0, kf1 = n1;
      if (kt + 4 < ntile) { const u16* kp = ikc + (size_t)((kt + 4) * 32 + r) * 32 + h * 8; n0 = *(const bf16x8*)kp; n1 = *(const bf16x8*)(kp + 16); }
      f32x16 sc;
      dsa_scores(sc, kf0, kf1, h, iqrow, wq);
      unsigned word = 0;
#pragma unroll
      for (int reg = 0; reg < 16; ++reg) {
        const int sidx = kt * 32 + crow(reg, h);
        const unsigned ok = okey_of(sc[reg]);
        const unsigned hi16 = ok >> 16;
        const bool valid = sidx <= tq;
        word |= (valid && hi16 > t16) ? (1u << crow(reg, h)) : 0u;
        if (valid && hi16 == t16) {
          unsigned slot = atomicAdd(&candn[r], 1u);
          if (slot < (unsigned)DSA_CAP) { candk[r * 64 + slot] = ok; candi[r * 64 + slot] = (unsigned)sidx; }
        }
      }
      word |= __shfl_xor(word, 32);
      if (h == 0) maskw[kt * 32 + r] = word;
    }
    __syncthreads();
    {
      int row = tid >> 3, j8 = tid & 7;
      unsigned nc = candn[row]; nc = nc < (unsigned)DSA_CAP ? nc : (unsigned)DSA_CAP;
      const unsigned nd = need[row];
      for (unsigned i = j8; i < nc; i += 8) {
        unsigned ki = candk[row * 64 + i], ii = candi[row * 64 + i];
        unsigned rank = 0;
        for (unsigned k = 0; k < nc; ++k) { unsigned kk = candk[row * 64 + k], ik2 = candi[row * 64 + k]; rank += (kk > ki || (kk == ki && ik2 < ii)) ? 1u : 0u; }
        if (rank < nd) atomicOr(&maskw[(ii >> 5) * 32 + row], 1u << (ii & 31u));
      }
    }
  } else {
    unsigned thi = prehi[r], tlo = prelo[r];
    if (lastpass < 3) thi <<= (24 - 8 * lastpass);
    if (lastpass < 4) tlo = 0; else if (lastpass == 4) tlo <<= 4;
    int kt = w;
    bf16x8 n0, n1;
    if (kt < ntile) { const u16* kp = ikc + (size_t)(kt * 32 + r) * 32 + h * 8; n0 = *(const bf16x8*)kp; n1 = *(const bf16x8*)(kp + 16); }
    for (; kt < ntile; kt += 4) {
      bf16x8 kf0 = n0, kf1 = n1;
      if (kt + 4 < ntile) { const u16* kp = ikc + (size_t)((kt + 4) * 32 + r) * 32 + h * 8; n0 = *(const bf16x8*)kp; n1 = *(const bf16x8*)(kp + 16); }
      f32x16 sc;
      dsa_scores(sc, kf0, kf1, h, iqrow, wq);
      unsigned word = 0;
#pragma unroll
      for (int reg = 0; reg < 16; ++reg) {
        const int sidx = kt * 32 + crow(reg, h);
        const unsigned ok = okey_of(sc[reg]);
        const unsigned ri = 4095u - (unsigned)sidx;
        bool sel = (sidx <= tq) && (ok > thi || (ok == thi && ri >= tlo));
        word |= sel ? (1u << crow(reg, h)) : 0u;
      }
      word |= __shfl_xor(word, 32);
      if (h == 0) maskw[kt * 32 + r] = word;
    }
  }
  __syncthreads();
  {
    const int tokbase = b * SEQL + t0;
    auto src = [&](int slot, int rr) { return cols + (size_t)(tokbase + rr) * NC + C_DQ + slot * 64; };
    auto posf = [&](int slot, int rr) { return t0 + rr; };
    stage_q(Qs, src, posf, p.dsa_q_gain + layer * 64, true, true, rope64, 0.125f * 1.44269504f);
  }
  __syncthreads();
  bf16x8 qf[4];
  load_qfrags(qf, Qs, w, r, h);
  AttnAcc acc; attn_init(acc);
  const u16* Kb = (const u16*)(PWS + OFF_DK) + (size_t)b * SEQL * 64;
  const u16* Vtb = (const u16*)(PWS + OFF_DVT) + (size_t)b * 64 * SEQL;
  for (int rep = 0; rep < DBG_ATT_REP; ++rep) { attn_init(acc);
  attn_run(acc, qf, Kb, 64, SEQL - 1, Vtb, SEQL, ntile, [&](int i) { return i; }, [&](int kt) { return maskw[kt * 32 + r]; }, kvs); }
  float lt = acc.l + __shfl_xor(acc.l, 32);
  float inv = lt > 0.f ? 1.f / lt : 0.f;
  u16* mixed = (u16*)(PWS + OFF_H);
  u16* orow = mixed + (size_t)(b * SEQL + t0 + r) * 1024 + 256 + w * 64;
#pragma unroll
  for (int g = 0; g < 4; ++g) {
    float x0[4], x1[4];
#pragma unroll
    for (int i = 0; i < 4; ++i) { x0[i] = acc.o0[4 * g + i] * inv; x1[i] = acc.o1[4 * g + i] * inv; }
    store4bf(orow + 8 * g + 4 * h, x0);
    store4bf(orow + 32 + 8 * g + 4 * h, x1);
  }
}

DI void job_nsa(const Params& p, int layer, int b, int tt, char* smem) {
  const int tid = otid(), lane = tid & 63, w = tid >> 6, r = lane & 31, h = lane >> 5;
  const int t0 = tt * 32;
  const int t = t0 + r;
  u16* cols = (u16*)(PWS + OFF_COLS);
  const u16* cb = cols + (size_t)b * SEQL * NC;
  u16* Qs = (u16*)smem;
  u16* kvs = (u16*)(smem + 18432);
  float* stage = (float*)(smem + 37888);
  float* imp = (float*)(smem + 54272);
  unsigned* selm = (unsigned*)(smem + 62464);
  int* tlist = (int*)(smem + 62720);
  int* nlist = (int*)(smem + 63744);
  const float2* rope64 = (const float2*)(PWS + OFF_ROPE64);
  const float qscale = 0.125f * 1.44269504f;
  const int tokbase = b * SEQL + t0;
  auto src = [&](int slot, int rr) { return cols + (size_t)(tokbase + rr) * NC + C_NQ + slot * 64; };
  auto posf = [&](int slot, int rr) { return t0 + rr; };

  stage_q(Qs, src, posf, p.nsa_q_gain + layer * 64, true, false, rope64, qscale);
  __syncthreads();
  bf16x8 qf[4];
  load_qfrags(qf, Qs, w, r, h);
  const u16* Kc_g = (const u16*)(PWS + OFF_KCMP) + (size_t)b * 256 * 64;
  const u16* Vc_g = (const u16*)(PWS + OFF_VCMPT) + (size_t)b * 64 * 256;
  const int jmax = t >= 31 ? ((t - 31) >> 4) : -1;
  const int ntc = ((2 * tt) >> 5) + 1;
  AttnAcc ac; attn_init(ac);
  attn_run(ac, qf, Kc_g, 64, 255, Vc_g, 256, ntc, [&](int i) { return i; }, [&](int kt) { return lowmask(jmax + 1 - kt * 32); }, kvs);
  float lt = ac.l + __shfl_xor(ac.l, 32);
  float inv_c = lt > 0.f ? 1.f / lt : 0.f;
  float mb_c = (ac.m == -INFINITY) ? 0.f : ac.m;
  for (int i = tid; i < 64 * 32; i += 256) imp[i] = 0.f;
  if (tid < 64) selm[tid] = 0;
  {
    const int krow = tid >> 3, kseg = tid & 7;
    u32x4 rk = *(const u32x4*)(Kc_g + (size_t)krow * 64 + kseg * 8);
    __syncthreads();
    *(u32x4*)(kvs + krow * 72 + kseg * 8) = rk;
    __syncthreads();
    for (int kt = 0; kt < ntc; ++kt) {
      const u16* Kc = kvs + (kt & 1) * KV_BUF;
      if (kt + 1 < ntc) rk = *(const u32x4*)(Kc_g + (size_t)((kt + 1) * 32 + krow) * 64 + kseg * 8);
      f32x16 s = zero16();
#pragma unroll
      for (int ks = 0; ks < 4; ++ks) { bf16x8 kf = *(const bf16x8*)(Kc + r * 72 + ks * 16 + h * 8); s = MFMA_BF(kf, qf[ks], s); }
      unsigned mw = lowmask(jmax + 1 - kt * 32);
#pragma unroll
      for (int reg = 0; reg < 16; ++reg) {
        bool bit = (mw >> crow(reg, h)) & 1u;
        float pv = bit ? __builtin_amdgcn_exp2f(s[reg] - mb_c) * inv_c : 0.f;
        stage[w * 1024 + crow(reg, h) * 32 + r] = pv;
      }
      if (kt + 1 < ntc) *(u32x4*)(kvs + ((kt + 1) & 1) * KV_BUF + krow * 72 + kseg * 8) = rk;
      __syncthreads();
      int tq = tid & 31, ng = tid >> 5, n = kt * 8 + ng;
      float ps[4];
#pragma unroll
      for (int i = 0; i < 4; ++i) { int j = 4 * ng + i; ps[i] = ((stage[j * 32 + tq] + stage[1024 + j * 32 + tq]) + stage[2048 + j * 32 + tq]) + stage[3072 + j * 32 + tq]; }
      imp[n * 32 + tq] += ((ps[0] + ps[1]) + ps[2]) + ps[3];
      __syncthreads();
      if (n + 1 < 64) imp[(n + 1) * 32 + tq] += ps[3];
    }
  }
  __syncthreads();
  {
    int tq = tid & 31, sub = tid >> 5;
    int cur = (t0 + tq) >> 6;
    float v[8];
#pragma unroll
    for (int k = 0; k < 8; ++k) {
      int n = sub * 8 + k;
      bool forced = (n == 0) || (n == cur) || (n == cur - 1);
      float val = forced ? INFINITY : (n > cur ? -INFINITY : imp[n * 32 + tq]);
      v[k] = val;
    }
    __syncthreads();
#pragma unroll
    for (int k = 0; k < 8; ++k) imp[(sub * 8 + k) * 32 + tq] = v[k];
    __syncthreads();
    int rank[8];
#pragma unroll
    for (int k = 0; k < 8; ++k) rank[k] = 0;
    for (int n2 = 0; n2 < 64; ++n2) {
      float v2 = imp[n2 * 32 + tq];
#pragma unroll
      for (int k = 0; k < 8; ++k) { int n = sub * 8 + k; rank[k] += (v2 > v[k] || (v2 == v[k] && n2 < n)) ? 1 : 0; }
    }
    unsigned bits = 0;
#pragma unroll
    for (int k = 0; k < 8; ++k) if (rank[k] < 16) bits |= 1u << ((sub * 8 + k) & 31);
    if (bits) atomicOr(&selm[tq * 2 + (sub >> 2)], bits);
  }
  __syncthreads();
  if (tid == 0) {
    unsigned lo = 0, hi = 0;
    for (int i = 0; i < 32; ++i) { lo |= selm[2 * i]; hi |= selm[2 * i + 1]; }
    int cnt = 0;
    for (int n = 0; n < 64; ++n) {
      bool on = n < 32 ? ((lo >> n) & 1u) : ((hi >> (n - 32)) & 1u);
      if (on) { if (2 * n <= tt) tlist[cnt++] = 2 * n; if (2 * n + 1 <= tt) tlist[cnt++] = 2 * n + 1; }
    }
    nlist[0] = cnt;
  }
  const u16* grow = cb + (size_t)t * NC + C_GATES;
  float g0 = sigmoidf_(bf2f(grow[w])), g1 = sigmoidf_(bf2f(grow[4 + w])), g2 = sigmoidf_(bf2f(grow[8 + w]));
  f32x16 out0, out1;
#pragma unroll
  for (int reg = 0; reg < 16; ++reg) { out0[reg] = g0 * inv_c * ac.o0[reg]; out1[reg] = g0 * inv_c * ac.o1[reg]; }
  __syncthreads();
  stage_q(Qs, src, posf, p.nsa_q_gain + layer * 64, true, true, rope64, qscale);
  __syncthreads();
  load_qfrags(qf, Qs, w, r, h);
  const unsigned mylo = selm[2 * r], myhi = selm[2 * r + 1];
  const int nsl = nlist[0];
  {
    AttnAcc as; attn_init(as);
    const u16* Kb = (const u16*)(PWS + OFF_KSC) + (size_t)b * SEQL * 64;
    const u16* Vtb = (const u16*)(PWS + OFF_VST) + (size_t)b * 64 * SEQL;
    for (int rep = 0; rep < DBG_SLC_REP; ++rep) { attn_init(as);
    attn_run(as, qf, Kb, 64, SEQL - 1, Vtb, SEQL, nsl, [&](int i) { return tlist[i]; },
             [&](int kt) { int n = kt >> 1; bool sel = n < 32 ? ((mylo >> n) & 1u) : ((myhi >> (n - 32)) & 1u); return sel ? lowmask(t - kt * 32 + 1) : 0u; }, kvs); }
    float l2 = as.l + __shfl_xor(as.l, 32);
    float inv = l2 > 0.f ? 1.f / l2 : 0.f;
#pragma unroll
    for (int reg = 0; reg < 16; ++reg) { out0[reg] += g1 * inv * as.o0[reg]; out1[reg] += g1 * inv * as.o1[reg]; }
  }
  {
    AttnAcc aw; attn_init(aw);
    const u16* Kb = (const u16*)(PWS + OFF_KWC) + (size_t)b * SEQL * 64;
    const u16* Vtb = (const u16*)(PWS + OFF_VWT) + (size_t)b * 64 * SEQL;
    const int klo = tt - 16 > 0 ? tt - 16 : 0;
    for (int rep = 0; rep < DBG_SWA_REP; ++rep) { attn_init(aw);
    attn_run(aw, qf, Kb, 64, SEQL - 1, Vtb, SEQL, tt - klo + 1, [&](int i) { return klo + i; },
             [&](int kt) { int lo = t - 511 - kt * 32; unsigned lm = lo <= 0 ? 0xffffffffu : (lo >= 32 ? 0u : (0xffffffffu << lo)); return lowmask(t - kt * 32 + 1) & lm; }, kvs); }
    float l2 = aw.l + __shfl_xor(aw.l, 32);
    float inv = l2 > 0.f ? 1.f / l2 : 0.f;
#pragma unroll
    for (int reg = 0; reg < 16; ++reg) { out0[reg] += g2 * inv * aw.o0[reg]; out1[reg] += g2 * inv * aw.o1[reg]; }
  }
  u16* mixed = (u16*)(PWS + OFF_H);
  u16* orow = mixed + (size_t)(b * SEQL + t) * 1024 + 512 + w * 64;
#pragma unroll
  for (int g = 0; g < 4; ++g) {
    float x0[4], x1[4];
#pragma unroll
    for (int i = 0; i < 4; ++i) { x0[i] = out0[4 * g + i]; x1[i] = out1[4 * g + i]; }
    store4bf(orow + 8 * g + 4 * h, x0);
    store4bf(orow + 32 + 8 * g + 4 * h, x1);
  }
}

DI void job_xattn(const Params& p, int layer, int b, int hd, int tq, char* smem) {
  const int tid = otid(), lane = tid & 63, w = tid >> 6, r = lane & 31, h = lane >> 5;
  u16* Qs = (u16*)smem;
  u16* kvs = (u16*)(smem + 18432);
  const u16* xq = (const u16*)(PWS + OFF_XQ);
  const int tokbase = b * SEQL + tq * 128;
  auto src = [&](int slot, int rr) { return xq + (size_t)(tokbase + slot * 32 + rr) * 256 + hd * 64; };
  auto posf = [&](int slot, int rr) { return 0; };
  stage_q(Qs, src, posf, p.xa_q_gain + layer * 64, true, false, (const float2*)nullptr, 0.125f * 1.44269504f);
  __syncthreads();
  bf16x8 qf[4];
  load_qfrags(qf, Qs, w, r, h);
  const u16* Kb = (const u16*)(PWS + OFF_MEMKV) + ((size_t)(layer * 4 + b) * 256) * 512 + hd * 64;
  const u16* Vtb = (const u16*)(PWS + OFF_MEMVT) + ((size_t)(layer * 4 + b) * 256 + hd * 64) * 256;
  AttnAcc a; attn_init(a);
  attn_run(a, qf, Kb, 512, 255, Vtb, 256, 8, [&](int i) { return i; }, [&](int kt) { return 0xffffffffu; }, kvs);
  float lt = a.l + __shfl_xor(a.l, 32);
  float inv = 1.f / lt;
  u16* xo = (u16*)(PWS + OFF_XO);
  u16* orow = xo + (size_t)(tokbase + w * 32 + r) * 256 + hd * 64;
#pragma unroll
  for (int g = 0; g < 4; ++g) {
    float x0[4], x1[4];
#pragma unroll
    for (int i = 0; i < 4; ++i) { x0[i] = a.o0[4 * g + i] * inv; x1[i] = a.o1[4 * g + i] * inv; }
    store4bf(orow + 8 * g + 4 * h, x0);
    store4bf(orow + 32 + 8 * g + 4 * h, x1);
  }
}

DI void job_prep(const Params& p, int layer, int job, char* smem) {
  const int tid = otid();
  const int tok0 = job * 32;
  const int b = tok0 >> 12, pos0 = tok0 & 4095;
  u16* cols = (u16*)(PWS + OFF_COLS);
  const float2* rope64 = (const float2*)(PWS + OFF_ROPE64);
  const float2* rope32 = (const float2*)(PWS + OFF_ROPE32);
  float* ckvn = (float*)smem;
  float* kpre = ckvn + 32 * 128;
  float* vbuf = kpre + 32 * 64;
  for (int it = 0; it < 4; ++it) {
    int row = it * 16 + (tid >> 4), lg = tid & 15;
    int tk = row >> 1, which = row & 1;
    u16* ptr = cols + (size_t)(tok0 + tk) * NC + (which ? C_KW : C_KS) + lg * 4;
    float x[4]; load4bf(ptr, x);
    rowop<64>(x, lg, p.nsa_k_gains + layer * 192 + (which ? 128 : 64), true, true, pos0 + tk, rope64);
    store4bf((u16*)(PWS + (which ? OFF_KWC : OFF_KSC)) + (size_t)(tok0 + tk) * 64 + lg * 4, x);
  }
  for (int it = 0; it < 8; ++it) {
    int row = it * 32 + (tid >> 3), lg = tid & 7;
    int tk = row >> 3, hh = row & 7;
    u16* ptr = cols + (size_t)(tok0 + tk) * NC + C_IQ + hh * 32 + lg * 4;
    float x[4]; load4bf(ptr, x);
    rowop<32>(x, lg, nullptr, false, true, pos0 + tk, rope32);
    store4bf(ptr, x);
  }
  {
    int tk = tid >> 3, lg = tid & 7;
    u16* ptr = cols + (size_t)(tok0 + tk) * NC + C_IK + lg * 4;
    float x[4]; load4bf(ptr, x);
    rowop<32>(x, lg, p.dsa_idxk_gain + layer * 32, true, true, pos0 + tk, rope32);
    store4bf((u16*)(PWS + OFF_IKC) + (size_t)(tok0 + tk) * 32 + lg * 4, x);
  }
  u16* ckvb = (u16*)smem;
  for (int it = 0; it < 4; ++it) {
    int tk = it * 8 + (tid >> 5), lg = tid & 31;
    float x[4]; load4bf(cols + (size_t)(tok0 + tk) * NC + C_CKV + lg * 4, x);
    rowop<128>(x, lg, p.dsa_kv_gain + layer * 128, true, false, 0, rope64);
    store4bf(ckvb + tk * 136 + lg * 4, x);
  }
  __syncthreads();
  {
    const int lane = tid & 63, w = tid >> 6, r = lane & 31, h = lane >> 5;
    const u16* wt = (const u16*)(PWS + OFF_WUKV) + (size_t)layer * 128 * 128 + (size_t)(w * 32 + r) * 128;
    f32x16 acc = zero16();
#pragma unroll
    for (int s2 = 0; s2 < 8; ++s2) {
      bf16x8 af = *(const bf16x8*)(ckvb + r * 136 + s2 * 16 + h * 8);
      bf16x8 bfr = *(const bf16x8*)(wt + s2 * 16 + h * 8);
      acc = MFMA_BF(af, bfr, acc);
    }
#pragma unroll
    for (int reg = 0; reg < 16; ++reg) {
      int tk = crow(reg, h), n = w * 32 + r;
      if (n < 64) kpre[tk * 64 + n] = acc[reg]; else vbuf[tk * 65 + (n - 64)] = acc[reg];
    }
  }
  __syncthreads();
  u16* DK = (u16*)(PWS + OFF_DK);
  for (int it = 0; it < 2; ++it) {
    int tk = it * 16 + (tid >> 4), lg = tid & 15;
    float x[4];
#pragma unroll
    for (int i = 0; i < 4; ++i) x[i] = kpre[tk * 64 + lg * 4 + i];
    rowop<64>(x, lg, p.dsa_k_gain + layer * 64, true, true, pos0 + tk, rope64);
    store4bf(DK + (size_t)(tok0 + tk) * 64 + lg * 4, x);
  }
  for (int which = 0; which < 3; ++which) {
    if (which > 0) {
      __syncthreads();
      for (int i = 0; i < 8; ++i) { int e = tid + 256 * i; int tk = e >> 6, d = e & 63; vbuf[tk * 65 + d] = bf2f(cols[(size_t)(tok0 + tk) * NC + (which == 1 ? C_VS : C_VW) + d]); }
      __syncthreads();
    }
    u16* dst = (u16*)(PWS + (which == 0 ? OFF_DVT : (which == 1 ? OFF_VST : OFF_VWT)));
    int d = tid & 63, q = tid >> 6;
    uint4 o;
    o.x = pack2(vbuf[(q * 8 + 0) * 65 + d], vbuf[(q * 8 + 1) * 65 + d]);
    o.y = pack2(vbuf[(q * 8 + 2) * 65 + d], vbuf[(q * 8 + 3) * 65 + d]);
    o.z = pack2(vbuf[(q * 8 + 4) * 65 + d], vbuf[(q * 8 + 5) * 65 + d]);
    o.w = pack2(vbuf[(q * 8 + 6) * 65 + d], vbuf[(q * 8 + 7) * 65 + d]);
    *(uint4*)(dst + ((size_t)(b * 64 + d)) * SEQL + pos0 + q * 8) = o;
  }
}

DI void job_memkv_post(const Params& p, int job, char* smem) {
  const int tid = otid();
  const int l = job >> 5, row0 = (job & 31) * 32;
  u16* kv = (u16*)(PWS + OFF_MEMKV) + (size_t)l * 1024 * 512;
  u16* vt = (u16*)(PWS + OFF_MEMVT) + (size_t)l * 4 * 256 * 256;
  float* vbuf = (float*)smem;
  for (int it = 0; it < 8; ++it) {
    int row = it * 16 + (tid >> 4), lg = tid & 15;
    int rr = row >> 2, hd = row & 3;
    u16* ptr = kv + (size_t)(row0 + rr) * 512 + hd * 64 + lg * 4;
    float x[4]; load4bf(ptr, x);
    rowop<64>(x, lg, p.xa_k_gain + l * 64, true, false, 0, (const float2*)nullptr);
    store4bf(ptr, x);
  }
  for (int i = 0; i < 32; ++i) { int e = tid + 256 * i; int rr = e >> 8, c = e & 255; vbuf[rr * 257 + c] = bf2f(kv[(size_t)(row0 + rr) * 512 + 256 + c]); }
  __syncthreads();
  {
    int b = row0 >> 8, m0 = row0 & 255;
    int c = tid;
    for (int q = 0; q < 4; ++q) {
      uint4 o;
      o.x = pack2(vbuf[(q * 8 + 0) * 257 + c], vbuf[(q * 8 + 1) * 257 + c]);
      o.y = pack2(vbuf[(q * 8 + 2) * 257 + c], vbuf[(q * 8 + 3) * 257 + c]);
      o.z = pack2(vbuf[(q * 8 + 4) * 257 + c], vbuf[(q * 8 + 5) * 257 + c]);
      o.w = pack2(vbuf[(q * 8 + 6) * 257 + c], vbuf[(q * 8 + 7) * 257 + c]);
      *(uint4*)(vt + ((size_t)(b * 256 + c)) * 256 + m0 + q * 8) = o;
    }
  }
}

DI void job_cmp2(const Params& p, int layer, int job, char* smem) {
  const int tid = otid();
  const int rl = tid >> 5, nq = (tid >> 4) & 1, lg = tid & 15;
  const int gr0 = job * 8;
  const int gr = gr0 + rl;
  const int b = gr >> 8, j = gr & 255;
  const u16* hid = (const u16*)(PWS + OFF_HID);
  float* hs = (float*)smem;
  float* part = hs + 8 * 512;
  float* vb = part + 8 * 16 * 8;
  for (int i = 0; i < 2; ++i) {
    int c = tid + 256 * i; int row = c >> 6, seg = c & 63;
    int g2 = gr0 + row; int b2 = g2 >> 8, j2 = g2 & 255;
    float x[8];
    if (j2 < 255) ld8bf(hid + (size_t)(b2 * 255 + j2) * 512 + seg * 8, x);
    else { for (int k = 0; k < 8; ++k) x[k] = 0.f; }
#pragma unroll
    for (int k = 0; k < 8; ++k) hs[row * 512 + seg * 8 + k] = x[k];
  }
  __syncthreads();
  float ak[4] = {0.f, 0.f, 0.f, 0.f}, av[4] = {0.f, 0.f, 0.f, 0.f};
  {
    const float* w2k = p.nsa_k_w2 + (size_t)layer * 256 * 64 + lg * 4;
    const float* w2v = p.nsa_v_w2 + (size_t)layer * 256 * 64 + lg * 4;
    const float* hr = hs + rl * 512;
#pragma unroll 8
    for (int n = nq * 128; n < nq * 128 + 128; ++n) {
      float hk = hr[n], hv = hr[256 + n];
      float4 wk = *(const float4*)(w2k + n * 64), wv = *(const float4*)(w2v + n * 64);
      ak[0] = fmaf(hk, wk.x, ak[0]); ak[1] = fmaf(hk, wk.y, ak[1]); ak[2] = fmaf(hk, wk.z, ak[2]); ak[3] = fmaf(hk, wk.w, ak[3]);
      av[0] = fmaf(hv, wv.x, av[0]); av[1] = fmaf(hv, wv.y, av[1]); av[2] = fmaf(hv, wv.z, av[2]); av[3] = fmaf(hv, wv.w, av[3]);
    }
  }
  if (nq == 1) {
#pragma unroll
    for (int i = 0; i < 4; ++i) { part[(rl * 16 + lg) * 8 + i] = ak[i]; part[(rl * 16 + lg) * 8 + 4 + i] = av[i]; }
  }
  __syncthreads();
  if (nq == 0) {
#pragma unroll
    for (int i = 0; i < 4; ++i) { ak[i] += part[(rl * 16 + lg) * 8 + i]; av[i] += part[(rl * 16 + lg) * 8 + 4 + i]; }
  }
  rowop<64>(ak, lg, p.nsa_k_gains + layer * 192, true, false, 0, (const float2*)nullptr);
  if (nq == 0) {
    store4bf((u16*)(PWS + OFF_KCMP) + (size_t)gr * 64 + lg * 4, ak);
#pragma unroll
    for (int i = 0; i < 4; ++i) vb[rl * 65 + lg * 4 + i] = av[i];
  }
  __syncthreads();
  if (tid < 64) {
    int d = tid;
    uint4 o;
    o.x = pack2(vb[0 * 65 + d], vb[1 * 65 + d]);
    o.y = pack2(vb[2 * 65 + d], vb[3 * 65 + d]);
    o.z = pack2(vb[4 * 65 + d], vb[5 * 65 + d]);
    o.w = pack2(vb[6 * 65 + d], vb[7 * 65 + d]);
    int bb = gr0 >> 8, jb = gr0 & 255;
    *(uint4*)((u16*)(PWS + OFF_VCMPT) + ((size_t)(bb * 64 + d)) * 256 + jb) = o;
  }
}

DI float lb_of(const Params& p, int layer, int c) {
  if (layer == 0) return 0.f;
  float p0 = p.lb_param[c], p1 = p.lb_param[256 + c];
  return 1.f / (1.f + expf(p0 - p1));
}
DI void mm32(f32x16& acc, const float* Ap, int asi, int ask, const float* Bp, int bsk, int bsj, int r, int h) {
#pragma unroll 8
  for (int k = 0; k < 64; k += 2) {
    float a = Ap[r * asi + (k + h) * ask];
    float b = Bp[(k + h) * bsk + r * bsj];
    acc = MFMA_F32(a, b, acc);
  }
}
template <bool SILU_GATE>
DI void finish_rows(const float* ob, const float* gain, const u16* cols, int gate_col, u16* mixed, int mix_col, int tb, int hd) {
  const int tid = otid(), lg = tid & 15;
  for (int it = 0; it < 4; ++it) {
    int t = it * 16 + (tid >> 4);
    float x[4];
#pragma unroll
    for (int i = 0; i < 4; ++i) x[i] = ob[t * 65 + lg * 4 + i];
    rowop<64>(x, lg, gain, true, false, 0, (const float2*)nullptr);
    float g[4]; load4bf(cols + (size_t)(tb + t) * NC + gate_col + hd * 64 + lg * 4, g);
#pragma unroll
    for (int i = 0; i < 4; ++i) x[i] *= SILU_GATE ? siluf_(g[i]) : sigmoidf_(g[i]);
    store4bf(mixed + (size_t)(tb + t) * 1024 + mix_col + hd * 64 + lg * 4, x);
  }
}

DI void conv8(const u16* cols, const float (&cw)[4][8], const float (&cbias)[8], int tok, int pos, int coloff, float (&out)[8]) {
#pragma unroll
  for (int k = 0; k < 8; ++k) out[k] = cbias[k];
#pragma unroll
  for (int j = 0; j < 4; ++j) {
    int dp = j - 3;
    if (pos + dp >= 0) {
      float x[8]; ld8bf(cols + (size_t)(tok + dp) * NC + coloff, x);
#pragma unroll
      for (int k = 0; k < 8; ++k) out[k] = fmaf(cw[j][k], x[k], out[k]);
    }
  }
#pragma unroll
  for (int k = 0; k < 8; ++k) out[k] = siluf_(out[k]);
}
DI void load_convw(const Params& p, int layer, int ch0, float (&cw)[4][8], float (&cbias)[8]) {
  const float* w = p.ml_conv_w + (size_t)layer * 4 * 512 + ch0;
#pragma unroll
  for (int j = 0; j < 4; ++j) {
    float4 a = *(const float4*)(w + j * 512), b2 = *(const float4*)(w + j * 512 + 4);
    cw[j][0] = a.x; cw[j][1] = a.y; cw[j][2] = a.z; cw[j][3] = a.w; cw[j][4] = b2.x; cw[j][5] = b2.y; cw[j][6] = b2.z; cw[j][7] = b2.w;
  }
  const float* bb = p.ml_conv_b + layer * 512 + ch0;
  float4 a = *(const float4*)bb, b2 = *(const float4*)(bb + 4);
  cbias[0] = a.x; cbias[1] = a.y; cbias[2] = a.z; cbias[3] = a.w; cbias[4] = b2.x; cbias[5] = b2.y; cbias[6] = b2.z; cbias[7] = b2.w;
}
DI void load_state(float* dst, const float* src, int tid) {
#pragma unroll
  for (int i = 0; i < 4; ++i) { int e4 = tid + 256 * i; int row = e4 >> 4, c4 = (e4 & 15) * 4; float4 v = *(const float4*)(src + row * 64 + c4);
    dst[row * 65 + c4] = v.x; dst[row * 65 + c4 + 1] = v.y; dst[row * 65 + c4 + 2] = v.z; dst[row * 65 + c4 + 3] = v.w; }
}

DI void job_hg_A(const Params& p, int layer, int cid, char* smem) {
  const int tid = otid(), lane = tid & 63, w = tid >> 6, r = lane & 31, h = lane >> 5;
  const int bh = cid >> 6, c = cid & 63, b = bh >> 2, hd = bh & 3;
  const int tb = b * SEQL + c * 64;
  const u16* cols = (const u16*)(PWS + OFF_COLS);
  float* B0 = (float*)smem; float* B1 = B0 + 64 * 65; float* B2 = B1 + 64 * 65;
  {
    const int seg = tid & 7;
    float lbv[8];
#pragma unroll
    for (int k = 0; k < 8; ++k) lbv[k] = lb_of(p, layer, hd * 64 + seg * 8 + k);
#pragma unroll
    for (int i = 0; i < 2; ++i) {
      int s = (tid >> 3) + 32 * i;
      const u16* row = cols + (size_t)(tb + s) * NC + hd * 64 + seg * 8;
      float f[8], iv[8]; ld8bf(row + C_HGF, f); ld8bf(row + C_HGI, iv);
#pragma unroll
      for (int k = 0; k < 8; ++k) {
        float fg = lbv[k] + (1.f - lbv[k]) * sigmoidf_(f[k]);
        B0[s * 65 + seg * 8 + k] = logf(fg); B1[s * 65 + seg * 8 + k] = 1.f - fg; B2[s * 65 + seg * 8 + k] = iv[k];
      }
    }
  }
  __syncthreads();
  if (tid < 64) { float run = 0.f; for (int s = 0; s < 64; ++s) { run += B0[s * 65 + tid]; B0[s * 65 + tid] = run; } }
  __syncthreads();
  for (int e = tid; e < 4096; e += 256) { int s = e >> 6, kd = e & 63; B1[s * 65 + kd] *= expf(B0[63 * 65 + kd] - B0[s * 65 + kd]); }
  __syncthreads();
  const int ih = w >> 1, jh = w & 1;
  f32x16 acc = zero16();
  mm32(acc, B1 + ih * 32, 1, 65, B2 + jh * 32, 65, 1, r, h);
  float* st = (float*)(PWS + OFF_HGST) + (size_t)cid * 4096;
#pragma unroll
  for (int reg = 0; reg < 16; ++reg) st[(ih * 32 + crow(reg, h)) * 64 + jh * 32 + r] = acc[reg];
  if (tid < 64) ((float*)(PWS + OFF_HGD))[cid * 64 + tid] = expf(B0[63 * 65 + tid]);
}

DI void job_hg_scan(const Params& p, int job) {
  const int bh = job >> 4, e = (job & 15) * 256 + otid();
  float* st = (float*)(PWS + OFF_HGST);
  const float* dv = (const float*)(PWS + OFF_HGD);
  float S = 0.f;
  for (int c0 = 0; c0 < 64; c0 += 16) {
    float U[16], D[16];
#pragma unroll
    for (int i = 0; i < 16; ++i) { U[i] = st[(size_t)(bh * 64 + c0 + i) * 4096 + e]; D[i] = dv[(bh * 64 + c0 + i) * 64 + (e >> 6)]; }
#pragma unroll
    for (int i = 0; i < 16; ++i) { st[(size_t)(bh * 64 + c0 + i) * 4096 + e] = S; S = D[i] * S + U[i]; }
  }
}

DI void job_hg_C(const Params& p, int layer, int cid, char* smem) {
  const int tid = otid(), lane = tid & 63, w = tid >> 6, r = lane & 31, h = lane >> 5;
  const int bh = cid >> 6, c = cid & 63, b = bh >> 2, hd = bh & 3;
  const int tb = b * SEQL + c * 64;
  const u16* cols = (const u16*)(PWS + OFF_COLS);
  float* B0 = (float*)smem; float* B1 = B0 + 64 * 65; float* B2 = B1 + 64 * 65; float* B3 = B2 + 64 * 65;
  {
    const int seg = tid & 7;
    float lbv[8];
#pragma unroll
    for (int k = 0; k < 8; ++k) lbv[k] = lb_of(p, layer, hd * 64 + seg * 8 + k);
#pragma unroll
    for (int i = 0; i < 2; ++i) {
      int s = (tid >> 3) + 32 * i;
      const u16* row = cols + (size_t)(tb + s) * NC + hd * 64 + seg * 8;
      float f[8], iv[8], qr[8]; ld8bf(row + C_HGF, f); ld8bf(row + C_HGI, iv); ld8bf(row + C_HGQ, qr);
#pragma unroll
      for (int k = 0; k < 8; ++k) {
        float fg = lbv[k] + (1.f - lbv[k]) * sigmoidf_(f[k]);
        B0[s * 65 + seg * 8 + k] = logf(fg); B2[s * 65 + seg * 8 + k] = 1.f - fg;
        B1[s * 65 + seg * 8 + k] = siluf_(qr[k]) * 0.125f; B3[s * 65 + seg * 8 + k] = iv[k];
      }
    }
  }
  __syncthreads();
  if (tid < 64) { float run = 0.f; for (int s = 0; s < 64; ++s) { run += B0[s * 65 + tid]; B0[s * 65 + tid] = run; } }
  __syncthreads();
  for (int e = tid; e < 4096; e += 256) {
    int s = e >> 6, kd = e & 63;
    float bref = B0[31 * 65 + kd], bc = B0[s * 65 + kd];
    B1[s * 65 + kd] *= expf(bc - bref);
    B2[s * 65 + kd] *= expf(bref - bc);
  }
  __syncthreads();
  const int th = w >> 1, sh = w & 1;
  f32x16 at = zero16();
  if (!(th == 0 && sh == 1)) mm32(at, B1 + th * 32 * 65, 65, 1, B2 + sh * 32 * 65, 1, 65, r, h);
  __syncthreads();
  for (int e = tid; e < 4096; e += 256) { int s = e >> 6, kd = e & 63; B2[s * 65 + kd] = B1[s * 65 + kd] * expf(B0[31 * 65 + kd]); }
  __syncthreads();
#pragma unroll
  for (int reg = 0; reg < 16; ++reg) {
    int t = th * 32 + crow(reg, h), s = sh * 32 + r;
    B1[t * 65 + s] = (s <= t) ? at[reg] : 0.f;
  }
  load_state(B0, (const float*)(PWS + OFF_HGST) + (size_t)cid * 4096, tid);
  __syncthreads();
  const int vh = w & 1;
  f32x16 o = zero16();
  mm32(o, B2 + th * 32 * 65, 65, 1, B0 + vh * 32, 65, 1, r, h);
  mm32(o, B1 + th * 32 * 65, 65, 1, B3 + vh * 32, 65, 1, r, h);
  __syncthreads();
#pragma unroll
  for (int reg = 0; reg < 16; ++reg) B2[(th * 32 + crow(reg, h)) * 65 + vh * 32 + r] = o[reg];
  __syncthreads();
  finish_rows<true>(B2, p.hg_o_gain + layer * 64, cols, C_HGG, (u16*)(PWS + OFF_H), 0, tb, hd);
}

DI float conv_silu(const Params& p, int layer, const u16* cols, int tok, int pos, int ch) {
  const float* cw = p.ml_conv_w + (size_t)layer * 4 * 512;
  float a = p.ml_conv_b[layer * 512 + ch];
#pragma unroll
  for (int j = 0; j < 4; ++j) {
    int dp = j - 3;
    float xv = (pos + dp >= 0) ? bf2f(cols[(size_t)(tok + dp) * NC + C_MQ + ch]) : 0.f;
    a = fmaf(cw[j * 512 + ch], xv, a);
  }
  return siluf_(a);
}
DI float logsigmoidf_(float x) { return fminf(x, 0.f) - log1pf(expf(-fabsf(x))); }
DI float scan_add(float v, int lane) { for (int o = 1; o < 64; o <<= 1) { float u = __shfl_up(v, o); if (lane >= o) v += u; } return v; }
DI float scan_max(float v, int lane) { for (int o = 1; o < 64; o <<= 1) { float u = __shfl_up(v, o); if (lane >= o) v = fmaxf(v, u); } return v; }

DI void job_ml_A(const Params& p, int layer, int cid, char* smem) {
  const int tid = otid(), lane = tid & 63, w = tid >> 6, r = lane & 31, h = lane >> 5;
  const int bh = cid >> 6, c = cid & 63, b = bh >> 2, hd = bh & 3;
  const int tb = b * SEQL + c * 64;
  const u16* cols = (const u16*)(PWS + OFF_COLS);
  float* B1 = (float*)smem; float* B2 = B1 + 64 * 65; float* wsv = B2 + 64 * 65;
  float* mlsc = (float*)(PWS + OFF_MLSC);
  if (w == 0) {
    const u16* row = cols + (size_t)(tb + lane) * NC;
    float fgv = bf2f(row[C_FG + hd]) + p.ml_f_bias[layer * 4 + hd];
    float igv = bf2f(row[C_IG + hd]) + p.ml_i_bias[layer * 4 + hd];
    float lf = logsigmoidf_(fgv);
    float bc = scan_add(lf, lane);
    float blast = __shfl(bc, 63);
    float lw = blast - bc + igv;
    float Mc = wave_max(lw);
    wsv[lane] = expf(lw - Mc);
    if (lane == 0) { mlsc[cid] = Mc; mlsc[1024 + cid] = blast; }
  }
  {
    const int seg = tid & 7;
    float cw[4][8], cbias[8];
    load_convw(p, layer, 256 + hd * 64 + seg * 8, cw, cbias);
#pragma unroll
    for (int i = 0; i < 2; ++i) {
      int s = (tid >> 3) + 32 * i;
      float kv[8], vv[8];
      conv8(cols, cw, cbias, tb + s, c * 64 + s, C_MK + hd * 64 + seg * 8, kv);
      ld8bf(cols + (size_t)(tb + s) * NC + C_MV + hd * 64 + seg * 8, vv);
#pragma unroll
      for (int k = 0; k < 8; ++k) { B1[s * 65 + seg * 8 + k] = kv[k] * 0.125f; B2[s * 65 + seg * 8 + k] = vv[k]; }
    }
  }
  __syncthreads();
  for (int e = tid; e < 4096; e += 256) { int s = e >> 6, d = e & 63; B1[s * 65 + d] *= wsv[s]; }
  __syncthreads();
  const int ih = w >> 1, jh = w & 1;
  f32x16 acc = zero16();
  mm32(acc, B1 + ih * 32, 1, 65, B2 + jh * 32, 65, 1, r, h);
  float* st = (float*)(PWS + OFF_MLST) + (size_t)cid * 4096;
#pragma unroll
  for (int reg = 0; reg < 16; ++reg) st[(ih * 32 + crow(reg, h)) * 64 + jh * 32 + r] = acc[reg];
  if (tid < 64) { float sacc = 0.f; for (int s = 0; s < 64; ++s) sacc += B1[s * 65 + tid]; ((float*)(PWS + OFF_MLN))[cid * 64 + tid] = sacc; }
}

DI void job_ml_scan(const Params& p, int job) {
  const int bh = job >> 4, sl = job & 15, tid = otid(), e = sl * 256 + tid;
  float* st = (float*)(PWS + OFF_MLST);
  float* nv = (float*)(PWS + OFF_MLN);
  float* mlsc = (float*)(PWS + OFF_MLSC);
  float S = 0.f, nS = 0.f, m = -1e30f;
  const bool don = (sl == 0 && tid < 64);
  for (int c0 = 0; c0 < 64; c0 += 16) {
    float U[16], Mc[16], Bl[16], Nu[16];
#pragma unroll
    for (int i = 0; i < 16; ++i) {
      int cid = bh * 64 + c0 + i;
      U[i] = st[(size_t)cid * 4096 + e]; Mc[i] = mlsc[cid]; Bl[i] = mlsc[1024 + cid];
      Nu[i] = don ? nv[cid * 64 + tid] : 0.f;
    }
#pragma unroll
    for (int i = 0; i < 16; ++i) {
      int cid = bh * 64 + c0 + i;
      float mnew = fmaxf(Bl[i] + m, Mc[i]);
      float dec = expf(Bl[i] + m - mnew), us = expf(Mc[i] - mnew);
      st[(size_t)cid * 4096 + e] = S;
      S = dec * S + us * U[i];
      if (don) { nv[cid * 64 + tid] = nS; nS = dec * nS + us * Nu[i]; }
      if (sl == 0 && tid == 0) mlsc[2048 + cid] = m;
      m = mnew;
    }
  }
}

DI void job_ml_C(const Params& p, int layer, int cid, char* smem) {
  const int tid = otid(), lane = tid & 63, w = tid >> 6, r = lane & 31, h = lane >> 5;
  const int bh = cid >> 6, c = cid & 63, b = bh >> 2, hd = bh & 3;
  const int tb = b * SEQL + c * 64;
  const u16* cols = (const u16*)(PWS + OFF_COLS);
  float* B0 = (float*)smem; float* B1 = B0 + 64 * 65; float* B2 = B1 + 64 * 65; float* B3 = B2 + 64 * 65;
  float* s_bc = B3 + 64 * 65; float* s_as = s_bc + 64; float* s_mt = s_as + 64; float* s_wi = s_mt + 64; float* s_nv = s_wi + 64; float* s_den = s_nv + 64;
  const float* mlsc = (const float*)(PWS + OFF_MLSC);
  if (w == 0) {
    const u16* row = cols + (size_t)(tb + lane) * NC;
    float fgv = bf2f(row[C_FG + hd]) + p.ml_f_bias[layer * 4 + hd];
    float igv = bf2f(row[C_IG + hd]) + p.ml_i_bias[layer * 4 + hd];
    float lf = logsigmoidf_(fgv);
    float bc = scan_add(lf, lane);
    float as = igv - bc;
    float pm = scan_max(as, lane);
    float m = mlsc[2048 + cid];
    float inter = bc + m;
    float mt = fmaxf(inter, bc + pm);
    s_bc[lane] = bc; s_as[lane] = as; s_mt[lane] = mt; s_wi[lane] = expf(inter - mt);
    s_nv[lane] = ((const float*)(PWS + OFF_MLN))[cid * 64 + lane];
  }
  {
    const int seg = tid & 7;
    {
      float cw[4][8], cbias[8];
      load_convw(p, layer, hd * 64 + seg * 8, cw, cbias);
#pragma unroll
      for (int i = 0; i < 2; ++i) {
        int s = (tid >> 3) + 32 * i;
        float qv[8];
        conv8(cols, cw, cbias, tb + s, c * 64 + s, C_MQ + hd * 64 + seg * 8, qv);
#pragma unroll
        for (int k = 0; k < 8; ++k) B0[s * 65 + seg * 8 + k] = qv[k];
      }
    }
    {
      float cw[4][8], cbias[8];
      load_convw(p, layer, 256 + hd * 64 + seg * 8, cw, cbias);
#pragma unroll
      for (int i = 0; i < 2; ++i) {
        int s = (tid >> 3) + 32 * i;
        float kv[8], vv[8];
        conv8(cols, cw, cbias, tb + s, c * 64 + s, C_MK + hd * 64 + seg * 8, kv);
        ld8bf(cols + (size_t)(tb + s) * NC + C_MV + hd * 64 + seg * 8, vv);
#pragma unroll
        for (int k = 0; k < 8; ++k) { B1[s * 65 + seg * 8 + k] = kv[k] * 0.125f; B2[s * 65 + seg * 8 + k] = vv[k]; }
      }
    }
    load_state(B3, (const float*)(PWS + OFF_MLST) + (size_t)cid * 4096, tid);
  }
  __syncthreads();
  const int th = w >> 1, sh = w & 1;
  f32x16 qk = zero16();
  if (!(th == 0 && sh == 1)) mm32(qk, B0 + th * 32 * 65, 65, 1, B1 + sh * 32 * 65, 1, 65, r, h);
  __syncthreads();
#pragma unroll
  for (int reg = 0; reg < 16; ++reg) {
    int t = th * 32 + crow(reg, h), s = sh * 32 + r;
    float dm = (s <= t) ? expf(s_bc[t] + s_as[s] - s_mt[t]) : 0.f;
    B1[t * 65 + s] = qk[reg] * dm;
  }
  for (int e = tid; e < 4096; e += 256) { int t = e >> 6, d = e & 63; B0[t * 65 + d] *= s_wi[t]; }
  __syncthreads();
  const int vh = w & 1;
  f32x16 o = zero16();
  mm32(o, B0 + th * 32 * 65, 65, 1, B3 + vh * 32, 65, 1, r, h);
  mm32(o, B1 + th * 32 * 65, 65, 1, B2 + vh * 32, 65, 1, r, h);
  if (tid < 64) {
    float dsum = 0.f;
    for (int d = 0; d < 64; ++d) dsum = fmaf(B0[tid * 65 + d], s_nv[d], dsum);
    float ssum = 0.f;
    for (int s = 0; s < 64; ++s) ssum += B1[tid * 65 + s];
    s_den[tid] = dsum + ssum;
  }
  __syncthreads();
#pragma unroll
  for (int reg = 0; reg < 16; ++reg) {
    int t = th * 32 + crow(reg, h);
    float dn = fmaxf(fabsf(s_den[t]), expf(-s_mt[t]));
    B3[t * 65 + vh * 32 + r] = o[reg] / dn;
  }
  __syncthreads();
  finish_rows<false>(B3, p.ml_o_gain + layer * 64, cols, C_MOG, (u16*)(PWS + OFF_H), 768, tb, hd);
}


#define XB_TMO      128
#define XB_XCNT(j)  (256  + 64 * (j))
#define XB_XSUB(j)  (1280 + 64 * (j))
#define XB_XGEN(j)  (2304 + 64 * (j))
#define XB_TOP      3328
#define XB_TOPGEN   3392
#define XCD_BAR_WORDS 3456
#define XB_SPIN_CAP (1u << 20)
#define LAS __attribute__((address_space(3)))
DI unsigned xb_ld(unsigned* p) { return __hip_atomic_load(p, __ATOMIC_RELAXED, __HIP_MEMORY_SCOPE_AGENT); }
DI unsigned xb_add(unsigned* p, unsigned v) { return __hip_atomic_fetch_add(p, v, __ATOMIC_RELAXED, __HIP_MEMORY_SCOPE_AGENT); }
DI unsigned xb_xcc_id() { return (unsigned)__builtin_amdgcn_s_getreg((3 << 11) | 20) & 0xFu; }
#define XB_SPIN(cond, bar) do { unsigned _sp = 0; while (cond) { __builtin_amdgcn_s_sleep(1); \
    if ((++_sp & 255u) == 0u) { if (xb_ld(&(bar)[XB_TMO])) break; if (_sp > XB_SPIN_CAP) { atomicAdd(&(bar)[XB_TMO], 1u); break; } } } } while (0)
struct XcdBarrier { unsigned* bar; unsigned x; volatile LAS unsigned* st; };
DI XcdBarrier xcd_barrier_post(unsigned* bar, volatile LAS unsigned* st) {
  XcdBarrier b; b.bar = bar; b.x = xb_xcc_id(); b.st = st;
  if (__builtin_amdgcn_workitem_id_x() == 0) (void)xb_add(&bar[XB_XCNT(b.x)], 1u);
  return b;
}
DI void xcd_barrier_complete(unsigned* bar, unsigned x, unsigned& nloc, unsigned& nx) {
  const unsigned G = gridDim.x * gridDim.y * gridDim.z;
  unsigned sum, cnt, mine, sp = 0u;
  for (;;) {
    sum = 0u; cnt = 0u; mine = 0u;
#pragma unroll
    for (unsigned j = 0; j < 16; ++j) { const unsigned c = xb_ld(&bar[XB_XCNT(j)]); sum += c; cnt += (c > 0u) ? 1u : 0u; mine = (j == x) ? c : mine; }
    if (sum == G) break;
    __builtin_amdgcn_s_sleep(1);
    if ((++sp & 255u) == 0u) { if (xb_ld(&bar[XB_TMO])) break; if (sp > XB_SPIN_CAP) { atomicAdd(&bar[XB_TMO], 1u); break; } }
  }
  nloc = mine > 0u ? mine : 1u; nx = cnt > 0u ? cnt : 1u;
}
DI void xcd_barrier(const XcdBarrier& b) {
  asm volatile("s_waitcnt vmcnt(0)" ::: "memory");
  __syncthreads();
  if (__builtin_amdgcn_workitem_id_x() == 0) {
    unsigned* bar = b.bar;
    __builtin_amdgcn_s_waitcnt(0);
    unsigned nloc = b.st[0], nx = b.st[1];
    if (nloc == 0u) { xcd_barrier_complete(bar, b.x, nloc, nx); b.st[0] = nloc; b.st[1] = nx; }
    const unsigned old = xb_add(&bar[XB_XSUB(b.x)], 1u);
    const unsigned gen = old / nloc;
    if (old + 1u == (gen + 1u) * nloc) {
      __builtin_amdgcn_fence(__ATOMIC_RELEASE, "agent");
      asm volatile("s_waitcnt vmcnt(0)" ::: "memory");
      const unsigned og = xb_add(&bar[XB_TOP], 1u);
      const unsigned tg = og / nx;
      if (og + 1u == (tg + 1u) * nx) xb_add(&bar[XB_TOPGEN], 1u);
      else XB_SPIN(xb_ld(&bar[XB_TOPGEN]) == tg, bar);
      __builtin_amdgcn_fence(__ATOMIC_ACQUIRE, "agent");
      xb_add(&bar[XB_XGEN(b.x)], 1u);
      asm volatile("s_waitcnt vmcnt(0)" ::: "memory");
    } else {
      XB_SPIN(xb_ld(&bar[XB_XGEN(b.x)]) == gen, bar);
      __builtin_amdgcn_fence(__ATOMIC_ACQUIRE, "agent");
      asm volatile("s_waitcnt vmcnt(0)" ::: "memory");
    }
  }
  __syncthreads();
}

DI int next_job(int* ctr, int* s_job) {
  __syncthreads();
  if (otid() == 0) *s_job = atomicAdd(ctr, 1);
  __syncthreads();
  return *s_job;
}

struct ConvDesc { const float* src; int K, Nsrc, Ndst, mode; size_t dst; };

__global__ void __launch_bounds__(256, 2) fwd_megakernel(Params p) {
  p.x = asg(p.x);
  p.mem = asg(p.mem);
  p.lb_param = asg(p.lb_param);
  p.norm_mix = asg(p.norm_mix);
  p.w_in = asg(p.w_in);
  p.w_out = asg(p.w_out);
  p.hg_o_gain = asg(p.hg_o_gain);
  p.dsa_kv_gain = asg(p.dsa_kv_gain);
  p.dsa_w_uk = asg(p.dsa_w_uk);
  p.dsa_w_uv = asg(p.dsa_w_uv);
  p.dsa_q_gain = asg(p.dsa_q_gain);
  p.dsa_k_gain = asg(p.dsa_k_gain);
  p.dsa_idxk_gain = asg(p.dsa_idxk_gain);
  p.nsa_pos_k = asg(p.nsa_pos_k);
  p.nsa_pos_v = asg(p.nsa_pos_v);
  p.nsa_k_w1 = asg(p.nsa_k_w1);
  p.nsa_k_w2 = asg(p.nsa_k_w2);
  p.nsa_v_w1 = asg(p.nsa_v_w1);
  p.nsa_v_w2 = asg(p.nsa_v_w2);
  p.nsa_q_gain = asg(p.nsa_q_gain);
  p.nsa_k_gains = asg(p.nsa_k_gains);
  p.ml_conv_w = asg(p.ml_conv_w);
  p.ml_conv_b = asg(p.ml_conv_b);
  p.ml_i_bias = asg(p.ml_i_bias);
  p.ml_f_bias = asg(p.ml_f_bias);
  p.ml_o_gain = asg(p.ml_o_gain);
  p.norm_xa = asg(p.norm_xa);
  p.norm_mem = asg(p.norm_mem);
  p.xa_wq = asg(p.xa_wq);
  p.xa_wkv = asg(p.xa_wkv);
  p.xa_wo = asg(p.xa_wo);
  p.xa_q_gain = asg(p.xa_q_gain);
  p.xa_k_gain = asg(p.xa_k_gain);
  p.norm_ffn = asg(p.norm_ffn);
  p.ffn_w13 = asg(p.ffn_w13);
  p.ffn_w2 = asg(p.ffn_w2);
  p.out = asg(p.out);
  cg::grid_group grid = cg::this_grid();
  __shared__ __attribute__((aligned(16))) char smem[SMEM_BYTES];
  int* s_job = (int*)(smem + SMEM_BYTES - 16);
  volatile LAS unsigned* xst = (volatile LAS unsigned*)(smem + SMEM_BYTES - 32);
  if (otid() == 0) { xst[0] = 0u; xst[1] = 0u; }
  __syncthreads();
  XcdBarrier xb = xcd_barrier_post((unsigned*)(p.ws + OFF_BAR), xst);
  int* ctr0 = (int*)(PWS + OFF_CTR);
  u16* WB = (u16*)(PWS + OFF_WB);
  u16* cols = (u16*)(PWS + OFF_COLS);
  u16* Hb = (u16*)(PWS + OFF_H);
  const int tid = otid();

  for (int ph2 = 0; ph2 < 2 * NPHASE; ++ph2) {
    const int ph = ph2 >> 1;
    const int layer = ph == 0 ? 0 : (ph - 1) / 14;
    const int kind = ph == 0 ? -1 : (ph - 1) % 14;
    if ((ph2 & 1) && DBG_REP == 99) { xcd_barrier(xb); continue; }
    if ((ph2 & 1) && kind != DBG_REP) continue;
    int* ctr = ctr0 + ((ph2 & 1) ? 32 : 0);
    const int sub = (ph2 & 1) ? DBG_SUB : 15;
    const u16* WL = WB + (size_t)layer * W_LAYER;
    int j;
    if (ph == 0) {
      const int NBIAS = 64, NUKV = 2, NROPE = 192, NMEM = 128, NCONV = 936 * 2, NX = 1024;
      const int total = NBIAS + NUKV + NROPE + NMEM + NCONV + NX;
      while ((j = next_job(&ctr[ph], s_job)) < total) {
        if (j < NBIAS) {
          int l = j >> 5, kv = (j >> 4) & 1, ng = j & 15;
          const float* pe = (kv ? p.nsa_pos_v : p.nsa_pos_k) + (size_t)l * 2048;
          const float* w1 = (kv ? p.nsa_v_w1 : p.nsa_k_w1) + (size_t)l * 2048 * 256;
          int nl = tid & 15, kp = tid >> 4;
          float a = 0.f;
#pragma unroll 8
          for (int k = kp * 128; k < kp * 128 + 128; ++k) a = fmaf(pe[k], w1[(size_t)k * 256 + ng * 16 + nl], a);
          float* red = (float*)smem;
          red[kp * 16 + nl] = a;
          __syncthreads();
          if (tid < 16) {
            float t = 0.f;
            for (int q = 0; q < 16; ++q) t += red[q * 16 + tid];
            ((float*)(PWS + OFF_BIAS1))[(l * 2 + kv) * 256 + ng * 16 + tid] = t;
          }
        } else if ((j -= NBIAS) < NUKV) {
          u16* wt = (u16*)(PWS + OFF_WUKV) + (size_t)j * 128 * 128;
          const float* uk = p.dsa_w_uk + (size_t)j * 128 * 64;
          const float* uv = p.dsa_w_uv + (size_t)j * 128 * 64;
          for (int e = tid; e < 128 * 128; e += 256) { int n = e >> 7, k = e & 127; wt[e] = f2bf(n < 64 ? uk[k * 64 + n] : uv[k * 64 + (n - 64)]); }
        } else if ((j -= NUKV) < NROPE) {
          int e = j * 256 + tid;
          int pos = e / 12, f = e % 12;
          float inv = f < 8 ? exp2f(-(float)f * (18.931568569324174f / 8.f)) : exp2f(-(float)(f - 8) * (18.931568569324174f / 4.f));
          float angf = (float)pos * inv;
          double ang = (double)angf;
          double k = rint(ang * 0.15915494309189535);
          float rr = (float)(ang - k * 6.283185307179586);
          float2 cs = make_float2(cosf(rr), sinf(rr));
          if (f < 8) ((float2*)(PWS + OFF_ROPE64))[pos * 8 + f] = cs; else ((float2*)(PWS + OFF_ROPE32))[pos * 4 + (f - 8)] = cs;
        } else if ((j -= NROPE) < NMEM) {
          int l = j >> 6, row0 = (j & 63) * 16;
          job_rmsnorm(p.mem, p.norm_mem + l * 1024, (u16*)(PWS + OFF_MEMH) + (size_t)l * 1024 * 1024, nullptr, row0);
        } else if ((j -= NMEM) < NCONV) {
          int l = j / 936, q = j % 936;
          const float* src; int K, Nsrc, mode, ntn; size_t dst;
          if (q < 216) { src = p.w_in + (size_t)l * 1024 * IN_COLS; K = 1024; Nsrc = IN_COLS; mode = 1; dst = WO_IN; ntn = 54; }
          else if ((q -= 216) < 64) { src = p.w_out + (size_t)l * 1024 * 1024; K = 1024; Nsrc = 1024; mode = 0; dst = WO_OUT; ntn = 16; }
          else if ((q -= 64) < 16) { src = p.xa_wq + (size_t)l * 1024 * 256; K = 1024; Nsrc = 256; mode = 0; dst = WO_Q; ntn = 4; }
          else if ((q -= 16) < 32) { src = p.xa_wkv + (size_t)l * 1024 * 512; K = 1024; Nsrc = 512; mode = 0; dst = WO_KV; ntn = 8; }
          else if ((q -= 32) < 16) { src = p.xa_wo + (size_t)l * 256 * 1024; K = 256; Nsrc = 1024; mode = 0; dst = WO_O; ntn = 16; }
          else if ((q -= 16) < 352) { src = p.ffn_w13 + (size_t)l * 1024 * 5632; K = 1024; Nsrc = 5632; mode = 2; dst = WO_13; ntn = 88; }
          else if ((q -= 352) < 176) { src = p.ffn_w2 + (size_t)l * 2816 * 1024; K = 2816; Nsrc = 1024; mode = 0; dst = WO_2; ntn = 16; }
          else if ((q -= 176) < 32) { src = p.nsa_k_w1 + (size_t)l * 2048 * 256; K = 2048; Nsrc = 256; mode = 0; dst = WO_KW1; ntn = 4; }
          else { q -= 32; src = p.nsa_v_w1 + (size_t)l * 2048 * 256; K = 2048; Nsrc = 256; mode = 0; dst = WO_VW1; ntn = 4; }
          job_convert(src, K, Nsrc, WB + (size_t)l * W_LAYER + dst, mode, q % ntn, q / ntn, (float*)smem);
        } else {
          j -= NCONV;
          job_rmsnorm(p.x, p.norm_mix, Hb, p.out, j * 16);
        }
      }
    } else if (kind == 0) {
      const int NG = 128 * 27, NM = layer == 0 ? 2 * 8 * 4 : 0;
      while ((j = next_job(&ctr[ph], s_job)) < NG + NM) {
        if (j < NG) gemm_tile<0, 0>(Hb, 1024, WL + WO_IN, 1024, j / 27, j % 27, smem, cols, NC, nullptr, 0);
        else { int q = j - NG; int l = q >> 5, tm = (q >> 2) & 7, tn = q & 3;
          gemm_tile<0, 0>((const u16*)(PWS + OFF_MEMH) + (size_t)l * 1024 * 1024, 1024, WB + (size_t)l * W_LAYER + WO_KV, 1024, tm, tn, smem,
                          (u16*)(PWS + OFF_MEMKV) + (size_t)l * 1024 * 512, 512, nullptr, 0); }
      }
    } else if (kind == 1) {
      const int NP = 512, NM = layer == 0 ? 64 : 0;
      while ((j = next_job(&ctr[ph], s_job)) < NP + NM) {
        if (j < NP) job_prep(p, layer, j, smem); else job_memkv_post(p, j - NP, smem);
      }
    } else if (kind == 2) {
      const int ND = 512, NCG = 32, NML = 1024, NHG = 1024;
      while ((j = next_job(&ctr[ph], s_job)) < ND + NCG + NML + NHG) {
        if (j < ND) { if (sub & 1) job_dsa(p, layer, j & 3, 127 - (j >> 2), smem, 0); }
        else if ((j -= ND) < NCG) { if (sub & 2) {
          int kv = j >> 4, tm = (j >> 1) & 7, tn = j & 1;
          gemm_tile<3, 1>(cols, 0, WL + (kv ? WO_VW1 : WO_KW1), 2048, tm, tn, smem, (u16*)(PWS + OFF_HID) + kv * 256, 512,
                          (const float*)(PWS + OFF_BIAS1) + (layer * 2 + kv) * 256, kv ? C_VC : C_KC); }
        } else if ((j -= NCG) < NML) { if (sub & 4) job_ml_A(p, layer, j, smem); }
        else { if (sub & 8) job_hg_A(p, layer, j - NML, smem); }
      }
    } else if (kind == 3) {
      const int NS = 256, NC2 = 128;
      while ((j = next_job(&ctr[ph], s_job)) < 512 + 2 * NS + NC2) {
        if (j < 512) job_dsa(p, layer, j & 3, 127 - (j >> 2), smem, 1);
        else if ((j -= 512) < NS) job_ml_scan(p, j); else if (j < 2 * NS) job_hg_scan(p, j - NS); else job_cmp2(p, layer, j - 2 * NS, smem);
      }
    } else if (kind == 4) {
      const int NN = 512, NML = 1024, NHG = 1024;
      while ((j = next_job(&ctr[ph], s_job)) < 512 + NN + NML + NHG) {
        if (j < 512) { job_dsa(p, layer, j & 3, 127 - (j >> 2), smem, 2); continue; }
        j -= 512;
        if (j < NN) { if (sub & 1) job_nsa(p, layer, j & 3, 127 - (j >> 2), smem); }
        else if ((j -= NN) < NML) { if (sub & 2) job_ml_C(p, layer, j, smem); }
        else { if (sub & 4) job_hg_C(p, layer, j - NML, smem); }
      }
    } else if (kind == 5) {
      if (!(DBG_SKIP & 1)) while ((j = next_job(&ctr[ph], s_job)) < 128 * 8) gemm_tile<1, 0>(Hb, 1024, WL + WO_OUT, 1024, j >> 3, j & 7, smem, p.out, 1024, nullptr, 0, DBG_MK0, DBG_MK1);
    } else if (kind == 6 || kind == 10 || kind == 13) {
      if (kind == 13 && layer == 1) {   }
      else {
        const float* g = kind == 6 ? p.norm_xa + layer * 1024 : (kind == 10 ? p.norm_ffn + layer * 1024 : p.norm_mix + (layer + 1) * 1024);
        while ((j = next_job(&ctr[ph], s_job)) < 1024) job_rmsnorm(p.out, g, Hb, nullptr, j * 16);
      }
    } else if (kind == 7) {
      while ((j = next_job(&ctr[ph], s_job)) < 128 * 2) gemm_tile<0, 0>(Hb, 1024, WL + WO_Q, 1024, j >> 1, j & 1, smem, (u16*)(PWS + OFF_XQ), 256, nullptr, 0);
    } else if (kind == 8) {
      while ((j = next_job(&ctr[ph], s_job)) < 512) job_xattn(p, layer, j >> 7, (j >> 5) & 3, j & 31, smem);
    } else if (kind == 9) {
      if (!(DBG_SKIP & 2)) while ((j = next_job(&ctr[ph], s_job)) < 128 * 8) gemm_tile<1, 0>((const u16*)(PWS + OFF_XO), 256, WL + WO_O, 256, j >> 3, j & 7, smem, p.out, 1024, nullptr, 0);
    } else if (kind == 11) {
      while ((j = next_job(&ctr[ph], s_job)) < 128 * 44) gemm_tile<2, 0>(Hb, 1024, WL + WO_13, 1024, j / 44, j % 44, smem, (u16*)(PWS + OFF_G), DFF, nullptr, 0);
    } else if (kind == 12) {
      if (!(DBG_SKIP & 4)) while ((j = next_job(&ctr[ph], s_job)) < 128 * 8) gemm_tile<1, 0>((const u16*)(PWS + OFF_G), DFF, WL + WO_2, DFF, j >> 3, j & 7, smem, p.out, 1024, nullptr, 0);
    }
    if (ph2 + 1 < 2 * NPHASE) { if (p.use_cg) grid.sync(); else xcd_barrier(xb); }
  }
}

extern "C" void kernel_launch(void* const* d_in, const int* in_sizes, int n_in, void* d_out, int out_size, void* d_ws, size_t ws_size,
                              hipStream_t stream) {
  static int grid_blocks = 0;
  if (!grid_blocks) {
    int dev = 0, cus = 0, per_cu = 0;
    hipGetDevice(&dev);
    hipDeviceGetAttribute(&cus, hipDeviceAttributeMultiprocessorCount, dev);
    hipOccupancyMaxActiveBlocksPerMultiprocessor(&per_cu, fwd_megakernel, 256, 0);
    if (per_cu > 2) per_cu = 2;
    if (per_cu < 1) per_cu = 1;
    grid_blocks = cus * per_cu;
  }
  Params p{};
  const float** pp = (const float**)&p;
  for (int i = 0; i < 36; ++i) pp[i] = (const float*)d_in[i];
  p.out = (float*)d_out;
  p.ws = (char*)d_ws;
  p.use_cg = 0; p.pad_ = 0;
  hipMemsetAsync(d_ws, 0, 4096 + 16384, stream);
  void* args[] = {&p};
  hipError_t e = hipLaunchCooperativeKernel((void*)fwd_megakernel, dim3(grid_blocks), dim3(256), args, 0, stream);
  if (e != hipSuccess) fprintf(stderr, "cooperative launch failed: %s (grid %d)\n", hipGetErrorString(e), grid_blocks);
}
```

```cpp
#include <hip/hip_runtime.h>
#include <hip/hip_bf16.h>
#include <hip/hip_cooperative_groups.h>
#include <cstdio>
namespace cg = cooperative_groups;

#define DI __device__ __forceinline__
typedef unsigned short u16;
typedef unsigned long long u64;
typedef __attribute__((ext_vector_type(8))) short bf16x8;
typedef __attribute__((ext_vector_type(4))) short s16x4;
typedef __attribute__((ext_vector_type(16))) float f32x16;
typedef __attribute__((ext_vector_type(2))) float f32x2;
typedef __attribute__((ext_vector_type(4))) unsigned u32x4;
typedef __attribute__((ext_vector_type(4))) float f32x4v;
typedef __attribute__((ext_vector_type(2))) __bf16 bf16x2v;

constexpr int T_TOK = 16384, SEQL = 4096, NBATCH = 4, DM = 1024;
constexpr int NC = 3456;
constexpr int C_HGQ = 0, C_HGF = 256, C_HGI = 512, C_HGG = 768;
constexpr int C_DQ = 1024, C_CKV = 1280, C_IQ = 1408;
constexpr int C_NQ = 1664, C_KC = 1920, C_VC = 1984, C_KS = 2048, C_VS = 2112, C_KW = 2176, C_VW = 2240;
constexpr int C_MQ = 2304, C_MK = 2560, C_MV = 2816, C_MOG = 3072;
constexpr int C_IK = 3328, C_IW = 3360, C_GATES = 3368, C_IG = 3380, C_FG = 3384;
constexpr int IN_COLS = 3388, DFF = 2816;

constexpr size_t WO_IN = 0;
constexpr size_t WO_OUT = WO_IN + (size_t)NC * 1024;
constexpr size_t WO_Q = WO_OUT + 1024 * 1024;
constexpr size_t WO_KV = WO_Q + 256 * 1024;
constexpr size_t WO_O = WO_KV + 512 * 1024;
constexpr size_t WO_13 = WO_O + 1024 * 256;
constexpr size_t WO_2 = WO_13 + (size_t)5632 * 1024;
constexpr size_t WO_KW1 = WO_2 + (size_t)1024 * 2816;
constexpr size_t WO_VW1 = WO_KW1 + 256 * 2048;
constexpr size_t W_LAYER = WO_VW1 + 256 * 2048;

constexpr size_t al256(size_t x) { return (x + 255) & ~(size_t)255; }
constexpr size_t OFF_CTR = 0;
constexpr size_t OFF_BAR = 4096;
constexpr size_t OFF_ROPE64 = 4096 + 16384;
constexpr size_t OFF_ROPE32 = OFF_ROPE64 + 4096 * 8 * 8;
constexpr size_t OFF_BIAS1 = OFF_ROPE32 + 4096 * 4 * 8;
constexpr size_t OFF_WB = al256(OFF_BIAS1 + 4096);
constexpr size_t OFF_COLS = al256(OFF_WB + 2 * W_LAYER * 2);
constexpr size_t OFF_H = al256(OFF_COLS + (size_t)T_TOK * NC * 2);
constexpr size_t OFF_HGST = al256(OFF_H + (size_t)T_TOK * 1024 * 2);
constexpr size_t OFF_MLST = al256(OFF_HGST + (size_t)1024 * 4096 * 4);
constexpr size_t OFF_HGD = al256(OFF_MLST + (size_t)1024 * 4096 * 4);
constexpr size_t OFF_MLN = al256(OFF_HGD + 1024 * 64 * 4);
constexpr size_t OFF_MLSC = al256(OFF_MLN + 1024 * 64 * 4);
constexpr size_t OFF_DK = al256(OFF_MLSC + 3 * 1024 * 4);
constexpr size_t OFF_DVT = al256(OFF_DK + (size_t)T_TOK * 64 * 2);
constexpr size_t OFF_VST = al256(OFF_DVT + (size_t)T_TOK * 64 * 2);
constexpr size_t OFF_VWT = al256(OFF_VST + (size_t)T_TOK * 64 * 2);
constexpr size_t OFF_KCMP = al256(OFF_VWT + (size_t)T_TOK * 64 * 2);
constexpr size_t OFF_VCMPT = al256(OFF_KCMP + 4 * 256 * 64 * 2);
constexpr size_t OFF_HID = al256(OFF_VCMPT + 4 * 256 * 64 * 2);
constexpr size_t OFF_MEMH = al256(OFF_HID + 1024 * 512 * 2);
constexpr size_t OFF_MEMKV = al256(OFF_MEMH + 2 * 1024 * 1024 * 2);
constexpr size_t OFF_MEMVT = al256(OFF_MEMKV + 2 * 1024 * 512 * 2);
constexpr size_t OFF_IKC = al256(OFF_MEMVT + 2 * 4 * 256 * 256 * 2);
constexpr size_t OFF_WUKV = al256(OFF_IKC + (size_t)T_TOK * 32 * 2);
constexpr size_t OFF_KSC = al256(OFF_WUKV + 2 * 128 * 128 * 2);
constexpr size_t OFF_KWC = al256(OFF_KSC + (size_t)T_TOK * 64 * 2);
constexpr size_t OFF_DSAST = al256(OFF_KWC + (size_t)T_TOK * 64 * 2);
constexpr size_t OFF_END = al256(OFF_DSAST + 512 * 128 * 4);
static_assert(OFF_END <= (size_t)256 * 1024 * 1024, "workspace overflow");
constexpr size_t OFF_XQ = OFF_HGST;
constexpr size_t OFF_XO = OFF_MLST;
constexpr size_t OFF_G = OFF_COLS;

constexpr int SMEM_BYTES = 75776;
constexpr int NPHASE = 28;
#define DBG_SKIP 0
#define DBG_REP -2
#define DBG_SUB 15
#define DBG_ATT_REP 1
#define DBG_EPI_REP 1
#define DBG_SELREP 1
#define DBG_SLC_REP 1
#define DBG_SWA_REP 1
#define DBG_MK0 0
#define DBG_MK1 16

struct Params {
  const float* x; const float* mem; const float* lb_param; const float* norm_mix; const float* w_in; const float* w_out;
  const float* hg_o_gain; const float* dsa_kv_gain; const float* dsa_w_uk; const float* dsa_w_uv; const float* dsa_q_gain;
  const float* dsa_k_gain; const float* dsa_idxk_gain; const float* nsa_pos_k; const float* nsa_pos_v; const float* nsa_k_w1;
  const float* nsa_k_w2; const float* nsa_v_w1; const float* nsa_v_w2; const float* nsa_q_gain; const float* nsa_k_gains;
  const float* ml_conv_w; const float* ml_conv_b; const float* ml_i_bias; const float* ml_f_bias; const float* ml_o_gain;
  const float* norm_xa; const float* norm_mem; const float* xa_wq; const float* xa_wkv; const float* xa_wo; const float* xa_q_gain;
  const float* xa_k_gain; const float* norm_ffn; const float* ffn_w13; const float* ffn_w2;
  float* out; char* ws;
  int use_cg; int pad_;
};

DI int otid() { int t = __builtin_amdgcn_workitem_id_x(); asm volatile("" : "+v"(t)); return t; }
typedef __attribute__((address_space(1))) char gchar_t;
DI char* oq(char* x) { gchar_t* g = (gchar_t*)x; asm volatile("" : "+s"(g)); return (char*)g; }
template <class T> DI T* asg(T* q) { return (T*)(__attribute__((address_space(1))) T*)q; }
#define PWS (oq(p.ws))
DI float bf2f(u16 v) { return __uint_as_float(((unsigned)v) << 16); }
DI unsigned pack2(float a, float b) { f32x2 v = {a, b}; return __builtin_bit_cast(unsigned, __builtin_convertvector(v, bf16x2v)); }
DI u16 f2bf(float a) { return (u16)(pack2(a, 0.f) & 0xffffu); }
DI float sigmoidf_(float x) { return __frcp_rn(1.f + __expf(-x)); }
DI float siluf_(float x) { return x * __frcp_rn(1.f + __expf(-x)); }
DI int crow(int reg, int h) { return (reg & 3) + 8 * (reg >> 2) + 4 * h; }
DI f32x16 zero16() { f32x16 z; for (int i = 0; i < 16; ++i) z[i] = 0.f; return z; }
#define MFMA_BF(a, b, c) __builtin_amdgcn_mfma_f32_32x32x16_bf16((a), (b), (c), 0, 0, 0)
#define MFMA_F32(a, b, c) __builtin_amdgcn_mfma_f32_32x32x2f32((a), (b), (c), 0, 0, 0)
DI float wave_sum(float v) { for (int o = 32; o; o >>= 1) v += __shfl_xor(v, o); return v; }
DI float wave_max(float v) { for (int o = 32; o; o >>= 1) v = fmaxf(v, __shfl_xor(v, o)); return v; }
DI void load4bf(const u16* p, float (&x)[4]) { uint2 v = *(const uint2*)p; x[0] = __uint_as_float(v.x << 16); x[1] = __uint_as_float(v.x & 0xffff0000u); x[2] = __uint_as_float(v.y << 16); x[3] = __uint_as_float(v.y & 0xffff0000u); }
DI void ld8bf(const u16* p, float (&x)[8]) {
  u32x4 v = *(const u32x4*)p;
  x[0] = __uint_as_float(v.x << 16); x[1] = __uint_as_float(v.x & 0xffff0000u);
  x[2] = __uint_as_float(v.y << 16); x[3] = __uint_as_float(v.y & 0xffff0000u);
  x[4] = __uint_as_float(v.z << 16); x[5] = __uint_as_float(v.z & 0xffff0000u);
  x[6] = __uint_as_float(v.w << 16); x[7] = __uint_as_float(v.w & 0xffff0000u);
}
DI void store4bf(u16* p, const float (&x)[4]) { uint2 v; v.x = pack2(x[0], x[1]); v.y = pack2(x[2], x[3]); *(uint2*)p = v; }

template <int W>
DI void rowop(float (&x)[4], int lg, const float* gain, bool do_norm, bool do_rope, int pos, const float2* ropetab) {
  if (do_norm) {
    float ss = x[0] * x[0] + x[1] * x[1] + x[2] * x[2] + x[3] * x[3];
#pragma unroll
    for (int o = W / 8; o >= 1; o >>= 1) ss += __shfl_xor(ss, o);
    float rstd = rsqrtf(ss * (1.f / W) + 1e-6f);
#pragma unroll
    for (int i = 0; i < 4; ++i) x[i] = x[i] * rstd * gain[lg * 4 + i];
  }
  if (do_rope) {
    constexpr int HALF = W / 8, LPH = HALF / 4;
    float xp[4];
#pragma unroll
    for (int i = 0; i < 4; ++i) xp[i] = __shfl_xor(x[i], LPH);
    const float4* tp = (const float4*)(ropetab + pos * HALF + (lg % LPH) * 4);
    const float4 c01 = tp[0], c23 = tp[1];
    const float cs[4] = {c01.x, c01.z, c23.x, c23.z};
    const float sn[4] = {c01.y, c01.w, c23.y, c23.w};
    const bool rot = lg < 2 * LPH;
    const bool isx2 = lg >= LPH;
#pragma unroll
    for (int i = 0; i < 4; ++i) {
      float rv = isx2 ? (x[i] * cs[i] + xp[i] * sn[i]) : (x[i] * cs[i] - xp[i] * sn[i]);
      x[i] = rot ? rv : x[i];
    }
  }
}

DI int map_in(int n) {
  if (n < 1664) return n;
  if (n < 2304) return n + 40;
  if (n < 3328) return n + 52;
  if (n < 3360) return 1664 + (n - 3328);
  if (n < 3368) return 1696 + (n - 3360);
  if (n < 3380) return 2344 + (n - 3368);
  if (n < 3388) return n;
  return -1;
}
DI int map_w13(int n) { int blk = n >> 6, w = n & 63; return w < 32 ? blk * 32 + w : 2816 + blk * 32 + (w - 32); }

DI void job_convert(const float* src, int K, int Nsrc, u16* dst, int mode, int tile_n, int tile_k4, float* sm) {
  const int tid = otid(), tx = tid & 15, ty = tid >> 4;
  int n = tile_n * 64 + tx * 4;
  int sn = mode == 0 ? n : (mode == 1 ? map_in(n) : map_w13(n));
  float4 v[16];
#pragma unroll
  for (int i = 0; i < 16; ++i) {
    int kl = ty + 16 * i;
    v[i] = sn >= 0 ? *(const float4*)(src + (size_t)(tile_k4 * 256 + kl) * Nsrc + sn) : make_float4(0.f, 0.f, 0.f, 0.f);
  }
#pragma unroll
  for (int i = 0; i < 16; ++i) {
    int kl = ty + 16 * i;
    float* t = sm + (kl >> 6) * (64 * 65) + (kl & 63) * 65 + tx * 4;
    t[0] = v[i].x; t[1] = v[i].y; t[2] = v[i].z; t[3] = v[i].w;
  }
  __syncthreads();
  int row = tid >> 2, seg = tid & 3;
#pragma unroll
  for (int q = 0; q < 4; ++q) {
    const float* t = sm + q * (64 * 65);
    unsigned pk[8];
#pragma unroll
    for (int i = 0; i < 8; ++i) pk[i] = pack2(t[(seg * 16 + 2 * i) * 65 + row], t[(seg * 16 + 2 * i + 1) * 65 + row]);
    uint4* d = (uint4*)(dst + (size_t)(tile_n * 64 + row) * K + tile_k4 * 256 + q * 64 + seg * 16);
    d[0] = make_uint4(pk[0], pk[1], pk[2], pk[3]);
    d[1] = make_uint4(pk[4], pk[5], pk[6], pk[7]);
  }
}

DI void job_rmsnorm(const float* X, const float* gain, u16* H, float* copy_out, int row0) {
  const int tid = otid(), lane = tid & 63, w = tid >> 6;
  for (int i = 0; i < 4; ++i) {
    int row = row0 + w * 4 + i;
    const float4* xr = (const float4*)(X + (size_t)row * 1024);
    float4 v[4];
    float ss = 0.f;
#pragma unroll
    for (int j = 0; j < 4; ++j) { v[j] = xr[lane + 64 * j]; ss += v[j].x * v[j].x + v[j].y * v[j].y + v[j].z * v[j].z + v[j].w * v[j].w; }
    ss = wave_sum(ss);
    float rstd = rsqrtf(ss * (1.f / 1024.f) + 1e-6f);
#pragma unroll
    for (int j = 0; j < 4; ++j) {
      float4 g = ((const float4*)gain)[lane + 64 * j];
      uint2 o; o.x = pack2(v[j].x * rstd * g.x, v[j].y * rstd * g.y); o.y = pack2(v[j].z * rstd * g.z, v[j].w * rstd * g.w);
      *(uint2*)(H + (size_t)row * 1024 + (lane + 64 * j) * 4) = o;
      if (copy_out) ((float4*)(copy_out + (size_t)row * 1024))[lane + 64 * j] = v[j];
    }
  }
}

template <int EPI, int AMODE>
DI void gemm_tile(const u16* __restrict__ A, int lda, const u16* __restrict__ Bt, int K, int tm, int tn, char* smem,
                  void* Cp, int ldc, const float* bias, int coff, int kt0 = 0, int kt1 = -1) {
  char* As = smem;
  char* Bs = smem + 32768;
  const int tid = otid(), lane = tid & 63, w = tid >> 6;
  const int r = lane & 31, h = lane >> 5, wm = w >> 1, wn = w & 1;
  const int lr8 = lane >> 3, lc = (lane & 7) ^ lr8;
  const u16* ap[4];
  const u16* bp[4];
#pragma unroll
  for (int q = 0; q < 4; ++q) {
    int rowl = (w * 4 + q) * 8 + lr8;
    int row = tm * 128 + rowl;
    if (AMODE == 0) ap[q] = A + (size_t)row * lda + lc * 8;
    else { int m = row < 1019 ? row : 1019; int b = m / 255, j = m % 255; ap[q] = A + ((size_t)(b * 4096 + 16 * j)) * NC + coff + lc * 8; }
    bp[q] = Bt + (size_t)(tn * 128 + rowl) * K + lc * 8;
  }
  const size_t akstep = AMODE == 0 ? 64 : NC;
  f32x4v acc[4][4];
#pragma unroll
  for (int a = 0; a < 4; ++a)
#pragma unroll
    for (int b = 0; b < 4; ++b) acc[a][b] = f32x4v{0.f, 0.f, 0.f, 0.f};
  const int nk = kt1 < 0 ? K / 64 : kt1;
#define G_ISSUE(BUF, KT) _Pragma("unroll") for (int q = 0; q < 4; ++q) { \
    __builtin_amdgcn_global_load_lds((const unsigned*)(ap[q] + (size_t)(KT) * akstep), (unsigned*)(As + (BUF) * 16384 + (w * 4 + q) * 1024), 16, 0, 0); \
    __builtin_amdgcn_global_load_lds((const unsigned*)(bp[q] + (size_t)(KT) * 64), (unsigned*)(Bs + (BUF) * 16384 + (w * 4 + q) * 1024), 16, 0, 0); }
  const int l15 = lane & 15, lq = lane >> 4, l7 = lane & 7;
  G_ISSUE(0, kt0)
  __syncthreads();
  for (int kt = kt0; kt < nk; ++kt) {
    const int cur = (kt - kt0) & 1;
    if (kt + 1 < nk) { G_ISSUE(cur ^ 1, kt + 1) }
    const char* Ac = As + cur * 16384;
    const char* Bc = Bs + cur * 16384;
#pragma unroll
    for (int s = 0; s < 2; ++s) {
      const int co = ((4 * s + lq) ^ l7) * 16;
      bf16x8 af[4], bfr[4];
#pragma unroll
      for (int mt = 0; mt < 4; ++mt) af[mt] = *(const bf16x8*)(Ac + (wm * 64 + mt * 16 + l15) * 128 + co);
#pragma unroll
      for (int nt = 0; nt < 4; ++nt) bfr[nt] = *(const bf16x8*)(Bc + (wn * 64 + nt * 16 + l15) * 128 + co);
#pragma unroll
      for (int mt = 0; mt < 4; ++mt)
#pragma unroll
        for (int nt = 0; nt < 4; ++nt) acc[mt][nt] = __builtin_amdgcn_mfma_f32_16x16x32_bf16(af[mt], bfr[nt], acc[mt][nt], 0, 0, 0);
    }
    __syncthreads();
  }
#undef G_ISSUE
#pragma unroll
  for (int mt = 0; mt < 4; ++mt) {
#pragma unroll
    for (int reg = 0; reg < 4; ++reg) {
      const int row = tm * 128 + wm * 64 + mt * 16 + lq * 4 + reg;
      if (EPI == 0) {
        u16* C = (u16*)Cp;
#pragma unroll
        for (int nt = 0; nt < 4; ++nt) C[(size_t)row * ldc + tn * 128 + wn * 64 + nt * 16 + l15] = f2bf(acc[mt][nt][reg]);
      } else if (EPI == 1) {
        float* C = (float*)Cp;
#pragma unroll
        for (int nt = 0; nt < 4; ++nt) { float* q = C + (size_t)row * ldc + tn * 128 + wn * 64 + nt * 16 + l15; *q = *q + acc[mt][nt][reg]; }
      } else if (EPI == 2) {
        u16* C = (u16*)Cp;
#pragma unroll
        for (int nt = 0; nt < 2; ++nt) {
          float av = acc[mt][nt][reg], bv = acc[mt][nt + 2][reg];
          C[(size_t)row * ldc + (tn * 2 + wn) * 32 + nt * 16 + l15] = f2bf(siluf_(av) * bv);
        }
      } else {
        u16* C = (u16*)Cp;
        if (row < 1020) {
#pragma unroll
          for (int nt = 0; nt < 4; ++nt) {
            int col = tn * 128 + wn * 64 + nt * 16 + l15;
            C[(size_t)row * ldc + col] = f2bf(fmaxf(acc[mt][nt][reg] + bias[col], 0.f));
          }
        }
      }
    }
  }
}

struct AttnAcc { f32x16 o0, o1; float m, l; };
DI void attn_init(AttnAcc& a) { a.o0 = zero16(); a.o1 = zero16(); a.m = -INFINITY; a.l = 0.f; }

template <class SrcF, class PosF>
DI void stage_q(u16* Qs, SrcF src, PosF posf, const float* gain, bool do_norm, bool do_rope, const float2* rope64, float scale) {
  const int tid = otid(), lg = tid & 15;
#pragma unroll
  for (int it = 0; it < 8; ++it) {
    int row = it * 16 + (tid >> 4);
    int slot = row >> 5, r = row & 31;
    float x[4];
    load4bf(src(slot, r) + lg * 4, x);
    rowop<64>(x, lg, gain, do_norm, do_rope, posf(slot, r), rope64);
#pragma unroll
    for (int i = 0; i < 4; ++i) x[i] *= scale;
    store4bf(Qs + (slot * 32 + r) * 72 + lg * 4, x);
  }
}
DI void load_qfrags(bf16x8 (&qf)[4], const u16* Qs, int slot, int r, int h) {
#pragma unroll
  for (int s = 0; s < 4; ++s) qf[s] = *(const bf16x8*)(Qs + (slot * 32 + r) * 72 + s * 16 + h * 8);
}

constexpr int KV_BUF = 32 * 72 + 64 * 40;

template <class TileF, class MaskF>
DI void attn_run(AttnAcc& a, const bf16x8 (&qf)[4], const u16* Kb, size_t kstride, int kmaxrow, const u16* Vtb, size_t vstride,
                 int ntiles, TileF tile_at, MaskF mask_at, u16* kvs) {
  const int tid = otid(), lane = tid & 63;
  const int r = lane & 31, h = lane >> 5;
  const int krow = tid >> 3, kseg = tid & 7, vrow = tid >> 2, vseg = tid & 3;
  if (ntiles <= 0) return;
  u32x4 rk, rv;
  {
    int kt = tile_at(0);
    int kr = kt * 32 + krow; kr = kr < kmaxrow ? kr : kmaxrow;
    rk = *(const u32x4*)(Kb + (size_t)kr * kstride + kseg * 8);
    rv = *(const u32x4*)(Vtb + (size_t)vrow * vstride + kt * 32 + vseg * 8);
  }
  __syncthreads();
  *(u32x4*)(kvs + krow * 72 + kseg * 8) = rk;
  *(u32x4*)(kvs + 32 * 72 + vrow * 40 + vseg * 8) = rv;
  __syncthreads();
  for (int i = 0; i < ntiles; ++i) {
    const int kt = tile_at(i);
    const int cur = i & 1;
    if (i + 1 < ntiles) {
      int kn = tile_at(i + 1);
      int kr = kn * 32 + krow; kr = kr < kmaxrow ? kr : kmaxrow;
      rk = *(const u32x4*)(Kb + (size_t)kr * kstride + kseg * 8);
      rv = *(const u32x4*)(Vtb + (size_t)vrow * vstride + kn * 32 + vseg * 8);
    }
    const u16* Kc = kvs + cur * KV_BUF;
    const u16* Vc = Kc + 32 * 72;
    f32x16 s = zero16();
#pragma unroll
    for (int ks = 0; ks < 4; ++ks) {
      bf16x8 kf = *(const bf16x8*)(Kc + r * 72 + ks * 16 + h * 8);
      s = MFMA_BF(kf, qf[ks], s);
    }
    unsigned mw = mask_at(kt);
    float mx = -INFINITY;
#pragma unroll
    for (int reg = 0; reg < 16; ++reg) {
      bool bit = (mw >> crow(reg, h)) & 1u;
      s[reg] = bit ? s[reg] : -INFINITY;
      mx = fmaxf(mx, s[reg]);
    }
    mx = fmaxf(mx, __shfl_xor(mx, 32));
    float mnew = fmaxf(a.m, mx);
    float mb = (mnew == -INFINITY) ? 0.f : mnew;
    float alpha = __builtin_amdgcn_exp2f(a.m - mb);
    float psum = 0.f;
#pragma unroll
    for (int reg = 0; reg < 16; ++reg) { float pv = __builtin_amdgcn_exp2f(s[reg] - mb); psum += pv; s[reg] = pv; }
    a.l = a.l * alpha + psum;
    a.m = mnew;
#pragma unroll
    for (int reg = 0; reg < 16; ++reg) { a.o0[reg] *= alpha; a.o1[reg] *= alpha; }
#pragma unroll
    for (int s2 = 0; s2 < 2; ++s2) {
      uint4 pu;
      pu.x = pack2(s[8 * s2 + 0], s[8 * s2 + 1]); pu.y = pack2(s[8 * s2 + 2], s[8 * s2 + 3]);
      pu.z = pack2(s[8 * s2 + 4], s[8 * s2 + 5]); pu.w = pack2(s[8 * s2 + 6], s[8 * s2 + 7]);
      bf16x8 pf = __builtin_bit_cast(bf16x8, pu);
#pragma unroll
      for (int dt = 0; dt < 2; ++dt) {
        uint2 lo = *(const uint2*)(Vc + (dt * 32 + r) * 40 + 16 * s2 + 4 * h);
        uint2 hi = *(const uint2*)(Vc + (dt * 32 + r) * 40 + 16 * s2 + 8 + 4 * h);
        uint4 vu = make_uint4(lo.x, lo.y, hi.x, hi.y);
        bf16x8 vf = __builtin_bit_cast(bf16x8, vu);
        if (dt == 0) a.o0 = MFMA_BF(vf, pf, a.o0); else a.o1 = MFMA_BF(vf, pf, a.o1);
      }
    }
    if (i + 1 < ntiles) {
      u16* Kn = kvs + (cur ^ 1) * KV_BUF;
      *(u32x4*)(Kn + krow * 72 + kseg * 8) = rk;
      *(u32x4*)(Kn + 32 * 72 + vrow * 40 + vseg * 8) = rv;
    }
    __syncthreads();
  }
}

DI unsigned lowmask(int n) { return n <= 0 ? 0u : (n >= 32 ? 0xffffffffu : ((1u << n) - 1u)); }

DI void dsa_scores(f32x16& sc, const bf16x8& kf0, const bf16x8& kf1, int h, const u16* iqrow, const float (&wq)[8]) {
  {
    bf16x8 q0 = *(const bf16x8*)(iqrow + 256 + h * 8);
    bf16x8 q1 = *(const bf16x8*)(iqrow + 256 + 16 + h * 8);
    sc = zero16();
    sc = MFMA_BF(kf0, q0, sc);
    sc = MFMA_BF(kf1, q1, sc);
  }
#pragma unroll
  for (int hh = 0; hh < 8; ++hh) {
    bf16x8 q0 = *(const bf16x8*)(iqrow + hh * 32 + h * 8);
    bf16x8 q1 = *(const bf16x8*)(iqrow + hh * 32 + 16 + h * 8);
    f32x16 a = zero16();
    a = MFMA_BF(kf0, q0, a);
    a = MFMA_BF(kf1, q1, a);
#pragma unroll
    for (int reg = 0; reg < 16; ++reg) sc[reg] = fmaf(wq[hh], __builtin_fabsf(a[reg]), sc[reg]);
    if (hh & 1) __builtin_amdgcn_sched_barrier(0);
  }
}
DI unsigned okey_of(float s) {
  unsigned u = __float_as_uint(s + 0.f);
  return u ^ ((unsigned)((int)u >> 31) | 0x80000000u);
}

template <int MODE>
DI void dsa_hist_tiles(unsigned* hist, const u16* ikc, const u16* iqrow, const float (&wq)[8], int w, int r, int h, int lane, int ntile, int tq,
                       unsigned mhi, unsigned mlo, int shm, int shd, bool last_idx) {
  int kt = w;
  bf16x8 n0, n1;
  if (kt < ntile) { const u16* kp = ikc + (size_t)(kt * 32 + r) * 32 + h * 8; n0 = *(const bf16x8*)kp; n1 = *(const bf16x8*)(kp + 16); }
  for (; kt < ntile; kt += 4) {
    bf16x8 kf0 = n0, kf1 = n1;
    if (kt + 4 < ntile) { const u16* kp = ikc + (size_t)((kt + 4) * 32 + r) * 32 + h * 8; n0 = *(const bf16x8*)kp; n1 = *(const bf16x8*)(kp + 16); }
    f32x16 sc;
    dsa_scores(sc, kf0, kf1, h, iqrow, wq);
#pragma unroll
    for (int reg = 0; reg < 16; ++reg) {
      const int sidx = kt * 32 + crow(reg, h);
      const unsigned ok = okey_of(sc[reg]);
      bool sel = sidx <= tq;
      unsigned digit;
      if (MODE == 0) { digit = ok >> 24; }
      else if (MODE == 1) { sel = sel && ((ok >> shm) == mhi); digit = (ok >> shd) & 255u; }
      else { const unsigned ri = 4095u - (unsigned)sidx; sel = sel && (ok == mhi) && (last_idx ? ((ri >> 4) == mlo) : true); digit = last_idx ? (ri & 15u) : (ri >> 4); }
      const int addr = sel ? (r * 257 + (int)digit) : (32 * 257 + lane);
      atomicAdd(&hist[addr], 1u);
    }
  }
}

constexpr int DSA_CAP = 64;

DI void job_dsa(const Params& p, int layer, int b, int tt, char* smem, int mode) {
  const int tid = otid(), lane = tid & 63, w = tid >> 6, r = lane & 31, h = lane >> 5;
  const int t0 = tt * 32, ntile = tt + 1;
  u16* cols = (u16*)(PWS + OFF_COLS);
  const u16* cb = cols + (size_t)b * SEQL * NC;
  const u16* ikc = (const u16*)(PWS + OFF_IKC) + (size_t)b * SEQL * 32;
  unsigned* hist = (unsigned*)smem;
  unsigned* candk = (unsigned*)smem;
  unsigned* candi = (unsigned*)(smem + 8192);
  unsigned* candn = (unsigned*)(smem + 16384);
  u16* Qs = (u16*)smem;
  u16* kvs = (u16*)(smem + 18432);
  unsigned* maskw = (unsigned*)(smem + 37888);
  unsigned* segs = (unsigned*)(smem + 54272);
  unsigned* prehi = (unsigned*)(smem + 55296);
  unsigned* prelo = (unsigned*)(smem + 55424);
  unsigned* need = (unsigned*)(smem + 55552);
  int* flags = (int*)(smem + 55680);
  const float2* rope64 = (const float2*)(PWS + OFF_ROPE64);

  unsigned* gst = (unsigned*)(PWS + OFF_DSAST) + (size_t)(b * 128 + tt) * 128;
  const u16* qrow = cb + (size_t)(t0 + r) * NC;
  u16* iqs = (u16*)(smem + 55808);
  for (int i = 0; i < 4; ++i) {
    int c = tid + 256 * i; int row = c >> 5, seg = c & 31;
    *(u32x4*)(iqs + row * 296 + seg * 8) = *(const u32x4*)(cb + (size_t)(t0 + row) * NC + C_IQ + seg * 8);
  }
  const u16* iqrow = iqs + r * 296;
  float wq[8];
  { float a[4], c[4]; load4bf(qrow + C_IW, a); load4bf(qrow + C_IW + 4, c);
#pragma unroll
    for (int i = 0; i < 4; ++i) { wq[i] = 0.5f * a[i]; wq[4 + i] = 0.5f * c[i]; } }

  int lastpass = 0;
  bool fast = false, done = false;
  if (mode == 0) {
    if (tid < 32) { prehi[tid] = 0; prelo[tid] = 0; int nd = t0 + tid + 1; need[tid] = nd < 256 ? nd : 256; }
  } else {
    if (tid < 32) { prehi[tid] = gst[tid]; prelo[tid] = gst[32 + tid]; need[tid] = gst[64 + tid]; }
    lastpass = (int)gst[96]; done = gst[97] != 0u; fast = gst[98] != 0u;
    if (mode == 1 && done) return;
  }
  if (tid < 16) flags[tid] = 0;
  __syncthreads();
  {
    int row = tid >> 3, lg = tid & 7;
    const u16* wr = cb + (size_t)(t0 + row) * NC + C_IW;
    float acc4[4] = {0.f, 0.f, 0.f, 0.f};
#pragma unroll
    for (int hh = 0; hh < 8; ++hh) {
      float wv = 0.5f * bf2f(wr[hh]);
      float x[4]; load4bf(iqs + row * 296 + hh * 32 + lg * 4, x);
#pragma unroll
      for (int i = 0; i < 4; ++i) acc4[i] = fmaf(wv, x[i], acc4[i]);
    }
    store4bf(iqs + row * 296 + 256 + lg * 4, acc4);
  }
  const int tq = t0 + r;
  const int pbeg = mode == 0 ? 0 : (mode == 1 ? 1 : ((done || fast) ? 6 : 2));
  const int pend = mode == 0 ? 1 : (mode == 1 ? 2 : 6);
  for (int pass = pbeg; pass < pend; ++pass) {
    for (int i = tid; i < 32 * 257 + 64; i += 256) hist[i] = 0;
    __syncthreads();
    const unsigned mhi = prehi[r], mlo = prelo[r];
    if (pass == 0) dsa_hist_tiles<0>(hist, ikc, iqrow, wq, w, r, h, lane, ntile, tq, mhi, mlo, 0, 0, false);
    else if (pass < 4) dsa_hist_tiles<1>(hist, ikc, iqrow, wq, w, r, h, lane, ntile, tq, mhi, mlo, 32 - 8 * pass, 24 - 8 * pass, false);
    else dsa_hist_tiles<2>(hist, ikc, iqrow, wq, w, r, h, lane, ntile, tq, mhi, mlo, 0, 0, pass == 5);
    __syncthreads();
    {
      int row = tid >> 3, part = tid & 7;
      unsigned sum = 0;
      for (int i = 0; i < 32; ++i) sum += hist[row * 257 + part * 32 + i];
      segs[row * 8 + part] = sum;
    }
    __syncthreads();
    if ((tid & 7) == 0) {
      int row = tid >> 3;
      unsigned nd = need[row], cum = 0;
      int pt = 7;
      for (; pt > 0; --pt) { unsigned c = segs[row * 8 + pt]; if (cum + c >= nd) break; cum += c; }
      int bin = pt * 32 + 31;
      for (; bin > pt * 32; --bin) { unsigned c = hist[row * 257 + bin]; if (cum + c >= nd) break; cum += c; }
      unsigned cnt = hist[row * 257 + bin];
      if (pass < 4) prehi[row] = (prehi[row] << 8) | (unsigned)bin;
      else if (pass == 4) prelo[row] = (unsigned)bin;
      else prelo[row] = (prelo[row] << 4) | (unsigned)bin;
      need[row] = nd - cum;
      if (cnt != nd - cum) atomicOr(&flags[pass], 1);
      if (pass == 1 && cnt > (unsigned)DSA_CAP) atomicOr(&flags[8], 1);
    }
    __syncthreads();
    lastpass = pass;
    if (flags[pass] == 0) { done = true; break; }
    if (pass == 1 && flags[8] == 0) { fast = true; break; }
  }
  if (mode < 2) {
    if (tid < 32) { gst[tid] = prehi[tid]; gst[32 + tid] = prelo[tid]; gst[64 + tid] = need[tid]; }
    if (tid == 0) { gst[96] = (unsigned)lastpass; gst[97] = done ? 1u : 0u; gst[98] = fast ? 1u : 0u; }
    return;
  }
  if (fast) {
    if (tid < 32) candn[tid] = 0;
    __syncthreads();
    const unsigned t16 = prehi[r];
    int kt = w;
    bf16x8 n0, n1;
    if (kt < ntile) { const u16* kp = ikc + (size_t)(kt * 32 + r) * 32 + h * 8; n0 = *(const bf16x8*)kp; n1 = *(const bf16x8*)(kp + 16); }
    for (; kt < ntile; kt += 4) {
      bf16x8 kf0 = n0, kf1 = n1;
      if (kt + 4 < ntile) { const u16* kp = ikc + (size_t)((kt + 4) * 32 + r) * 32 + h * 8; n0 = *(const bf16x8*)kp; n1 = *(const bf16x8*)(kp + 16); }
      f32x16 sc;
      dsa_scores(sc, kf0, kf1, h, iqrow, wq);
      unsigned word = 0;
#pragma unroll
      for (int reg = 0; reg < 16; ++reg) {
        const int sidx = kt * 32 + crow(reg, h);
        const unsigned ok = okey_of(sc[reg]);
        const unsigned hi16 = ok >> 16;
        const bool valid = sidx <= tq;
        word |= (valid && hi16 > t16) ? (1u << crow(reg, h)) : 0u;
        if (valid && hi16 == t16) {
          unsigned slot = atomicAdd(&candn[r], 1u);
          if (slot < (unsigned)DSA_CAP) { candk[r * 64 + slot] = ok; candi[r * 64 + slot] = (unsigned)sidx; }
        }
      }
      word |= __shfl_xor(word, 32);
      if (h == 0) maskw[kt * 32 + r] = word;
    }
    __syncthreads();
    {
      int row = tid >> 3, j8 = tid & 7;
      unsigned nc = candn[row]; nc = nc < (unsigned)DSA_CAP ? nc : (unsigned)DSA_CAP;
      const unsigned nd = need[row];
      for (unsigned i = j8; i < nc; i += 8) {
        unsigned ki = candk[row * 64 + i], ii = candi[row * 64 + i];
        unsigned rank = 0;
        for (unsigned k = 0; k < nc; ++k) { unsigned kk = candk[row * 64 + k], ik2 = candi[row * 64 + k]; rank += (kk > ki || (kk == ki && ik2 < ii)) ? 1u : 0u; }
        if (rank < nd) atomicOr(&maskw[(ii >> 5) * 32 + row], 1u << (ii & 31u));
      }
    }
  } else {
    unsigned thi = prehi[r], tlo = prelo[r];
    if (lastpass < 3) thi <<= (24 - 8 * lastpass);
    if (lastpass < 4) tlo = 0; else if (lastpass == 4) tlo <<= 4;
    int kt = w;
    bf16x8 n0, n1;
    if (kt < ntile) { const u16* kp = ikc + (size_t)(kt * 32 + r) * 32 + h * 8; n0 = *(const bf16x8*)kp; n1 = *(const bf16x8*)(kp + 16); }
    for (; kt < ntile; kt += 4) {
      bf16x8 kf0 = n0, kf1 = n1;
      if (kt + 4 < ntile) { const u16* kp = ikc + (size_t)((kt + 4) * 32 + r) * 32 + h * 8; n0 = *(const bf16x8*)kp; n1 = *(const bf16x8*)(kp + 16); }
      f32x16 sc;
      dsa_scores(sc, kf0, kf1, h, iqrow, wq);
      unsigned word = 0;
#pragma unroll
      for (int reg = 0; reg < 16; ++reg) {
        const int sidx = kt * 32 + crow(reg, h);
        const unsigned ok = okey_of(sc[reg]);
        const unsigned ri = 4095u - (unsigned)sidx;
        bool sel = (sidx <= tq) && (ok > thi || (ok == thi && ri >= tlo));
        word |= sel ? (1u << crow(reg, h)) : 0u;
      }
      word |= __shfl_xor(word, 32);
      if (h == 0) maskw[kt * 32 + r] = word;
    }
  }
  __syncthreads();
  {
    const int tokbase = b * SEQL + t0;
    auto src = [&](int slot, int rr) { return cols + (size_t)(tokbase + rr) * NC + C_DQ + slot * 64; };
    auto posf = [&](int slot, int rr) { return t0 + rr; };
    stage_q(Qs, src, posf, p.dsa_q_gain + layer * 64, true, true, rope64, 0.125f * 1.44269504f);
  }
  __syncthreads();
  bf16x8 qf[4];
  load_qfrags(qf, Qs, w, r, h);
  AttnAcc acc; attn_init(acc);
  const u16* Kb = (const u16*)(PWS + OFF_DK) + (size_t)b * SEQL * 64;
  const u16* Vtb = (const u16*)(PWS + OFF_DVT) + (size_t)b * 64 * SEQL;
  for (int rep = 0; rep < DBG_ATT_REP; ++rep) { attn_init(acc);
  attn_run(acc, qf, Kb, 64, SEQL - 1, Vtb, SEQL, ntile, [&](int i) { return i; }, [&](int kt) { return maskw[kt * 32 + r]; }, kvs); }
  float lt = acc.l + __shfl_xor(acc.l, 32);
  float inv = lt > 0.f ? 1.f / lt : 0.f;
  u16* mixed = (u16*)(PWS + OFF_H);
  u16* orow = mixed + (size_t)(b * SEQL + t0 + r) * 1024 + 256 + w * 64;
#pragma unroll
  for (int g = 0; g < 4; ++g) {
    float x0[4], x1[4];
#pragma unroll
    for (int i = 0; i < 4; ++i) { x0[i] = acc.o0[4 * g + i] * inv; x1[i] = acc.o1[4 * g + i] * inv; }
    store4bf(orow + 8 * g + 4 * h, x0);
    store4bf(orow + 32 + 8 * g + 4 * h, x1);
  }
}

DI void job_nsa(const Params& p, int layer, int b, int tt, char* smem) {
  const int tid = otid(), lane = tid & 63, w = tid >> 6, r = lane & 31, h = lane >> 5;
  const int t0 = tt * 32;
  const int t = t0 + r;
  u16* cols = (u16*)(PWS + OFF_COLS);
  const u16* cb = cols + (size_t)b * SEQL * NC;
  u16* Qs = (u16*)smem;
  u16* kvs = (u16*)(smem + 18432);
  float* stage = (float*)(smem + 37888);
  float* imp = (float*)(smem + 54272);
  unsigned* selm = (unsigned*)(smem + 62464);
  int* tlist = (int*)(smem + 62720);
  int* nlist = (int*)(smem + 63744);
  const float2* rope64 = (const float2*)(PWS + OFF_ROPE64);
  const float qscale = 0.125f * 1.44269504f;
  const int tokbase = b * SEQL + t0;
  auto src = [&](int slot, int rr) { return cols + (size_t)(tokbase + rr) * NC + C_NQ + slot * 64; };
  auto posf = [&](int slot, int rr) { return t0 + rr; };

  stage_q(Qs, src, posf, p.nsa_q_gain + layer * 64, true, false, rope64, qscale);
  __syncthreads();
  bf16x8 qf[4];
  load_qfrags(qf, Qs, w, r, h);
  const u16* Kc_g = (const u16*)(PWS + OFF_KCMP) + (size_t)b * 256 * 64;
  const u16* Vc_g = (const u16*)(PWS + OFF_VCMPT) + (size_t)b * 64 * 256;
  const int jmax = t >= 31 ? ((t - 31) >> 4) : -1;
  const int ntc = ((2 * tt) >> 5) + 1;
  AttnAcc ac; attn_init(ac);
  attn_run(ac, qf, Kc_g, 64, 255, Vc_g, 256, ntc, [&](int i) { return i; }, [&](int kt) { return lowmask(jmax + 1 - kt * 32); }, kvs);
  float lt = ac.l + __shfl_xor(ac.l, 32);
  float inv_c = lt > 0.f ? 1.f / lt : 0.f;
  float mb_c = (ac.m == -INFINITY) ? 0.f : ac.m;
  for (int i = tid; i < 64 * 32; i += 256) imp[i] = 0.f;
  if (tid < 64) selm[tid] = 0;
  {
    const int krow = tid >> 3, kseg = tid & 7;
    u32x4 rk = *(const u32x4*)(Kc_g + (size_t)krow * 64 + kseg * 8);
    __syncthreads();
    *(u32x4*)(kvs + krow * 72 + kseg * 8) = rk;
    __syncthreads();
    for (int kt = 0; kt < ntc; ++kt) {
      const u16* Kc = kvs + (kt & 1) * KV_BUF;
      if (kt + 1 < ntc) rk = *(const u32x4*)(Kc_g + (size_t)((kt + 1) * 32 + krow) * 64 + kseg * 8);
      f32x16 s = zero16();
#pragma unroll
      for (int ks = 0; ks < 4; ++ks) { bf16x8 kf = *(const bf16x8*)(Kc + r * 72 + ks * 16 + h * 8); s = MFMA_BF(kf, qf[ks], s); }
      unsigned mw = lowmask(jmax + 1 - kt * 32);
#pragma unroll
      for (int reg = 0; reg < 16; ++reg) {
        bool bit = (mw >> crow(reg, h)) & 1u;
        float pv = bit ? __builtin_amdgcn_exp2f(s[reg] - mb_c) * inv_c : 0.f;
        stage[w * 1024 + crow(reg, h) * 32 + r] = pv;
      }
      if (kt + 1 < ntc) *(u32x4*)(kvs + ((kt + 1) & 1) * KV_BUF + krow * 72 + kseg * 8) = rk;
      __syncthreads();
      int tq = tid & 31, ng = tid >> 5, n = kt * 8 + ng;
      float ps[4];
#pragma unroll
      for (int i = 0; i < 4; ++i) { int j = 4 * ng + i; ps[i] = ((stage[j * 32 + tq] + stage[1024 + j * 32 + tq]) + stage[2048 + j * 32 + tq]) + stage[3072 + j * 32 + tq]; }
      imp[n * 32 + tq] += ((ps[0] + ps[1]) + ps[2]) + ps[3];
      __syncthreads();
      if (n + 1 < 64) imp[(n + 1) * 32 + tq] += ps[3];
    }
  }
  __syncthreads();
  {
    int tq = tid & 31, sub = tid >> 5;
    int cur = (t0 + tq) >> 6;
    float v[8];
#pragma unroll
    for (int k = 0; k < 8; ++k) {
      int n = sub * 8 + k;
      bool forced = (n == 0) || (n == cur) || (n == cur - 1);
      float val = forced ? INFINITY : (n > cur ? -INFINITY : imp[n * 32 + tq]);
      v[k] = val;
    }
    __syncthreads();
#pragma unroll
    for (int k = 0; k < 8; ++k) imp[(sub * 8 + k) * 32 + tq] = v[k];
    __syncthreads();
    int rank[8];
#pragma unroll
    for (int k = 0; k < 8; ++k) rank[k] = 0;
    for (int n2 = 0; n2 < 64; ++n2) {
      float v2 = imp[n2 * 32 + tq];
#pragma unroll
      for (int k = 0; k < 8; ++k) { int n = sub * 8 + k; rank[k] += (v2 > v[k] || (v2 == v[k] && n2 < n)) ? 1 : 0; }
    }
    unsigned bits = 0;
#pragma unroll
    for (int k = 0; k < 8; ++k) if (rank[k] < 16) bits |= 1u << ((sub * 8 + k) & 31);
    if (bits) atomicOr(&selm[tq * 2 + (sub >> 2)], bits);
  }
  __syncthreads();
  if (tid == 0) {
    unsigned lo = 0, hi = 0;
    for (int i = 0; i < 32; ++i) { lo |= selm[2 * i]; hi |= selm[2 * i + 1]; }
    int cnt = 0;
    for (int n = 0; n < 64; ++n) {
      bool on = n < 32 ? ((lo >> n) & 1u) : ((hi >> (n - 32)) & 1u);
      if (on) { if (2 * n <= tt) tlist[cnt++] = 2 * n; if (2 * n + 1 <= tt) tlist[cnt++] = 2 * n + 1; }
    }
    nlist[0] = cnt;
  }
  const u16* grow = cb + (size_t)t * NC + C_GATES;
  float g0 = sigmoidf_(bf2f(grow[w])), g1 = sigmoidf_(bf2f(grow[4 + w])), g2 = sigmoidf_(bf2f(grow[8 + w]));
  f32x16 out0, out1;
#pragma unroll
  for (int reg = 0; reg < 16; ++reg) { out0[reg] = g0 * inv_c * ac.o0[reg]; out1[reg] = g0 * inv_c * ac.o1[reg]; }
  __syncthreads();
  stage_q(Qs, src, posf, p.nsa_q_gain + layer * 64, true, true, rope64, qscale);
  __syncthreads();
  load_qfrags(qf, Qs, w, r, h);
  const unsigned mylo = selm[2 * r], myhi = selm[2 * r + 1];
  const int nsl = nlist[0];
  {
    AttnAcc as; attn_init(as);
    const u16* Kb = (const u16*)(PWS + OFF_KSC) + (size_t)b * SEQL * 64;
    const u16* Vtb = (const u16*)(PWS + OFF_VST) + (size_t)b * 64 * SEQL;
    for (int rep = 0; rep < DBG_SLC_REP; ++rep) { attn_init(as);
    attn_run(as, qf, Kb, 64, SEQL - 1, Vtb, SEQL, nsl, [&](int i) { return tlist[i]; },
             [&](int kt) { int n = kt >> 1; bool sel = n < 32 ? ((mylo >> n) & 1u) : ((myhi >> (n - 32)) & 1u); return sel ? lowmask(t - kt * 32 + 1) : 0u; }, kvs); }
    float l2 = as.l + __shfl_xor(as.l, 32);
    float inv = l2 > 0.f ? 1.f / l2 : 0.f;
#pragma unroll
    for (int reg = 0; reg < 16; ++reg) { out0[reg] += g1 * inv * as.o0[reg]; out1[reg] += g1 * inv * as.o1[reg]; }
  }
  {
    AttnAcc aw; attn_init(aw);
    const u16* Kb = (const u16*)(PWS + OFF_KWC) + (size_t)b * SEQL * 64;
    const u16* Vtb = (const u16*)(PWS + OFF_VWT) + (size_t)b * 64 * SEQL;
    const int klo = tt - 16 > 0 ? tt - 16 : 0;
    for (int rep = 0; rep < DBG_SWA_REP; ++rep) { attn_init(aw);
    attn_run(aw, qf, Kb, 64, SEQL - 1, Vtb, SEQL, tt - klo + 1, [&](int i) { return klo + i; },
             [&](int kt) { int lo = t - 511 - kt * 32; unsigned lm = lo <= 0 ? 0xffffffffu : (lo >= 32 ? 0u : (0xffffffffu << lo)); return lowmask(t - kt * 32 + 1) & lm; }, kvs); }
    float l2 = aw.l + __shfl_xor(aw.l, 32);
    float inv = l2 > 0.f ? 1.f / l2 : 0.f;
#pragma unroll
    for (int reg = 0; reg < 16; ++reg) { out0[reg] += g2 * inv * aw.o0[reg]; out1[reg] += g2 * inv * aw.o1[reg]; }
  }
  u16* mixed = (u16*)(PWS + OFF_H);
  u16* orow = mixed + (size_t)(b * SEQL + t) * 1024 + 512 + w * 64;
#pragma unroll
  for (int g = 0; g < 4; ++g) {
    float x0[4], x1[4];
#pragma unroll
    for (int i = 0; i < 4; ++i) { x0[i] = out0[4 * g + i]; x1[i] = out1[4 * g + i]; }
    store4bf(orow + 8 * g + 4 * h, x0);
    store4bf(orow + 32 + 8 * g + 4 * h, x1);
  }
}

DI void job_xattn(const Params& p, int layer, int b, int hd, int tq, char* smem) {
  const int tid = otid(), lane = tid & 63, w = tid >> 6, r = lane & 31, h = lane >> 5;
  u16* Qs = (u16*)smem;
  u16* kvs = (u16*)(smem + 18432);
  const u16* xq = (const u16*)(PWS + OFF_XQ);
  const int tokbase = b * SEQL + tq * 128;
  auto src = [&](int slot, int rr) { return xq + (size_t)(tokbase + slot * 32 + rr) * 256 + hd * 64; };
  auto posf = [&](int slot, int rr) { return 0; };
  stage_q(Qs, src, posf, p.xa_q_gain + layer * 64, true, false, (const float2*)nullptr, 0.125f * 1.44269504f);
  __syncthreads();
  bf16x8 qf[4];
  load_qfrags(qf, Qs, w, r, h);
  const u16* Kb = (const u16*)(PWS + OFF_MEMKV) + ((size_t)(layer * 4 + b) * 256) * 512 + hd * 64;
  const u16* Vtb = (const u16*)(PWS + OFF_MEMVT) + ((size_t)(layer * 4 + b) * 256 + hd * 64) * 256;
  AttnAcc a; attn_init(a);
  attn_run(a, qf, Kb, 512, 255, Vtb, 256, 8, [&](int i) { return i; }, [&](int kt) { return 0xffffffffu; }, kvs);
  float lt = a.l + __shfl_xor(a.l, 32);
  float inv = 1.f / lt;
  u16* xo = (u16*)(PWS + OFF_XO);
  u16* orow = xo + (size_t)(tokbase + w * 32 + r) * 256 + hd * 64;
#pragma unroll
  for (int g = 0; g < 4; ++g) {
    float x0[4], x1[4];
#pragma unroll
    for (int i = 0; i < 4; ++i) { x0[i] = a.o0[4 * g + i] * inv; x1[i] = a.o1[4 * g + i] * inv; }
    store4bf(orow + 8 * g + 4 * h, x0);
    store4bf(orow + 32 + 8 * g + 4 * h, x1);
  }
}

DI void job_prep(const Params& p, int layer, int job, char* smem) {
  const int tid = otid();
  const int tok0 = job * 32;
  const int b = tok0 >> 12, pos0 = tok0 & 4095;
  u16* cols = (u16*)(PWS + OFF_COLS);
  const float2* rope64 = (const float2*)(PWS + OFF_ROPE64);
  const float2* rope32 = (const float2*)(PWS + OFF_ROPE32);
  float* ckvn = (float*)smem;
  float* kpre = ckvn + 32 * 128;
  float* vbuf = kpre + 32 * 64;
  for (int it = 0; it < 4; ++it) {
    int row = it * 16 + (tid >> 4), lg = tid & 15;
    int tk = row >> 1, which = row & 1;
    u16* ptr = cols + (size_t)(tok0 + tk) * NC + (which ? C_KW : C_KS) + lg * 4;
    float x[4]; load4bf(ptr, x);
    rowop<64>(x, lg, p.nsa_k_gains + layer * 192 + (which ? 128 : 64), true, true, pos0 + tk, rope64);
    store4bf((u16*)(PWS + (which ? OFF_KWC : OFF_KSC)) + (size_t)(tok0 + tk) * 64 + lg * 4, x);
  }
  for (int it = 0; it < 8; ++it) {
    int row = it * 32 + (tid >> 3), lg = tid & 7;
    int tk = row >> 3, hh = row & 7;
    u16* ptr = cols + (size_t)(tok0 + tk) * NC + C_IQ + hh * 32 + lg * 4;
    float x[4]; load4bf(ptr, x);
    rowop<32>(x, lg, nullptr, false, true, pos0 + tk, rope32);
    store4bf(ptr, x);
  }
  {
    int tk = tid >> 3, lg = tid & 7;
    u16* ptr = cols + (size_t)(tok0 + tk) * NC + C_IK + lg * 4;
    float x[4]; load4bf(ptr, x);
    rowop<32>(x, lg, p.dsa_idxk_gain + layer * 32, true, true, pos0 + tk, rope32);
    store4bf((u16*)(PWS + OFF_IKC) + (size_t)(tok0 + tk) * 32 + lg * 4, x);
  }
  u16* ckvb = (u16*)smem;
  for (int it = 0; it < 4; ++it) {
    int tk = it * 8 + (tid >> 5), lg = tid & 31;
    float x[4]; load4bf(cols + (size_t)(tok0 + tk) * NC + C_CKV + lg * 4, x);
    rowop<128>(x, lg, p.dsa_kv_gain + layer * 128, true, false, 0, rope64);
    store4bf(ckvb + tk * 136 + lg * 4, x);
  }
  __syncthreads();
  {
    const int lane = tid & 63, w = tid >> 6, r = lane & 31, h = lane >> 5;
    const u16* wt = (const u16*)(PWS + OFF_WUKV) + (size_t)layer * 128 * 128 + (size_t)(w * 32 + r) * 128;
    f32x16 acc = zero16();
#pragma unroll
    for (int s2 = 0; s2 < 8; ++s2) {
      bf16x8 af = *(const bf16x8*)(ckvb + r * 136 + s2 * 16 + h * 8);
      bf16x8 bfr = *(const bf16x8*)(wt + s2 * 16 + h * 8);
      acc = MFMA_BF(af, bfr, acc);
    }
#pragma unroll
    for (int reg = 0; reg < 16; ++reg) {
      int tk = crow(reg, h), n = w * 32 + r;
      if (n < 64) kpre[tk * 64 + n] = acc[reg]; else vbuf[tk * 65 + (n - 64)] = acc[reg];
    }
  }
  __syncthreads();
  u16* DK = (u16*)(PWS + OFF_DK);
  for (int it = 0; it < 2; ++it) {
    int tk = it * 16 + (tid >> 4), lg = tid & 15;
    float x[4];
#pragma unroll
    for (int i = 0; i < 4; ++i) x[i] = kpre[tk * 64 + lg * 4 + i];
    rowop<64>(x, lg, p.dsa_k_gain + layer * 64, true, true, pos0 + tk, rope64);
    store4bf(DK + (size_t)(tok0 + tk) * 64 + lg * 4, x);
  }
  for (int which = 0; which < 3; ++which) {
    if (which > 0) {
      __syncthreads();
      for (int i = 0; i < 8; ++i) { int e = tid + 256 * i; int tk = e >> 6, d = e & 63; vbuf[tk * 65 + d] = bf2f(cols[(size_t)(tok0 + tk) * NC + (which == 1 ? C_VS : C_VW) + d]); }
      __syncthreads();
    }
    u16* dst = (u16*)(PWS + (which == 0 ? OFF_DVT : (which == 1 ? OFF_VST : OFF_VWT)));
    int d = tid & 63, q = tid >> 6;
    uint4 o;
    o.x = pack2(vbuf[(q * 8 + 0) * 65 + d], vbuf[(q * 8 + 1) * 65 + d]);
    o.y = pack2(vbuf[(q * 8 + 2) * 65 + d], vbuf[(q * 8 + 3) * 65 + d]);
    o.z = pack2(vbuf[(q * 8 + 4) * 65 + d], vbuf[(q * 8 + 5) * 65 + d]);
    o.w = pack2(vbuf[(q * 8 + 6) * 65 + d], vbuf[(q * 8 + 7) * 65 + d]);
    *(uint4*)(dst + ((size_t)(b * 64 + d)) * SEQL + pos0 + q * 8) = o;
  }
}

DI void job_memkv_post(const Params& p, int job, char* smem) {
  const int tid = otid();
  const int l = job >> 5, row0 = (job & 31) * 32;
  u16* kv = (u16*)(PWS + OFF_MEMKV) + (size_t)l * 1024 * 512;
  u16* vt = (u16*)(PWS + OFF_MEMVT) + (size_t)l * 4 * 256 * 256;
  float* vbuf = (float*)smem;
  for (int it = 0; it < 8; ++it) {
    int row = it * 16 + (tid >> 4), lg = tid & 15;
    int rr = row >> 2, hd = row & 3;
    u16* ptr = kv + (size_t)(row0 + rr) * 512 + hd * 64 + lg * 4;
    float x[4]; load4bf(ptr, x);
    rowop<64>(x, lg, p.xa_k_gain + l * 64, true, false, 0, (const float2*)nullptr);
    store4bf(ptr, x);
  }
  for (int i = 0; i < 32; ++i) { int e = tid + 256 * i; int rr = e >> 8, c = e & 255; vbuf[rr * 257 + c] = bf2f(kv[(size_t)(row0 + rr) * 512 + 256 + c]); }
  __syncthreads();
  {
    int b = row0 >> 8, m0 = row0 & 255;
    int c = tid;
    for (int q = 0; q < 4; ++q) {
      uint4 o;
      o.x = pack2(vbuf[(q * 8 + 0) * 257 + c], vbuf[(q * 8 + 1) * 257 + c]);
      o.y = pack2(vbuf[(q * 8 + 2) * 257 + c], vbuf[(q * 8 + 3) * 257 + c]);
      o.z = pack2(vbuf[(q * 8 + 4) * 257 + c], vbuf[(q * 8 + 5) * 257 + c]);
      o.w = pack2(vbuf[(q * 8 + 6) * 257 + c], vbuf[(q * 8 + 7) * 257 + c]);
      *(uint4*)(vt + ((size_t)(b * 256 + c)) * 256 + m0 + q * 8) = o;
    }
  }
}

DI void job_cmp2(const Params& p, int layer, int job, char* smem) {
  const int tid = otid();
  const int rl = tid >> 5, nq = (tid >> 4) & 1, lg = tid & 15;
  const int gr0 = job * 8;
  const int gr = gr0 + rl;
  const int b = gr >> 8, j = gr & 255;
  const u16* hid = (const u16*)(PWS + OFF_HID);
  float* hs = (float*)smem;
  float* part = hs + 8 * 512;
  float* vb = part + 8 * 16 * 8;
  for (int i = 0; i < 2; ++i) {
    int c = tid + 256 * i; int row = c >> 6, seg = c & 63;
    int g2 = gr0 + row; int b2 = g2 >> 8, j2 = g2 & 255;
    float x[8];
    if (j2 < 255) ld8bf(hid + (size_t)(b2 * 255 + j2) * 512 + seg * 8, x);
    else { for (int k = 0; k < 8; ++k) x[k] = 0.f; }
#pragma unroll
    for (int k = 0; k < 8; ++k) hs[row * 512 + seg * 8 + k] = x[k];
  }
  __syncthreads();
  float ak[4] = {0.f, 0.f, 0.f, 0.f}, av[4] = {0.f, 0.f, 0.f, 0.f};
  {
    const float* w2k = p.nsa_k_w2 + (size_t)layer * 256 * 64 + lg * 4;
    const float* w2v = p.nsa_v_w2 + (size_t)layer * 256 * 64 + lg * 4;
    const float* hr = hs + rl * 512;
#pragma unroll 8
    for (int n = nq * 128; n < nq * 128 + 128; ++n) {
      float hk = hr[n], hv = hr[256 + n];
      float4 wk = *(const float4*)(w2k + n * 64), wv = *(const float4*)(w2v + n * 64);
      ak[0] = fmaf(hk, wk.x, ak[0]); ak[1] = fmaf(hk, wk.y, ak[1]); ak[2] = fmaf(hk, wk.z, ak[2]); ak[3] = fmaf(hk, wk.w, ak[3]);
      av[0] = fmaf(hv, wv.x, av[0]); av[1] = fmaf(hv, wv.y, av[1]); av[2] = fmaf(hv, wv.z, av[2]); av[3] = fmaf(hv, wv.w, av[3]);
    }
  }
  if (nq == 1) {
#pragma unroll
    for (int i = 0; i < 4; ++i) { part[(rl * 16 + lg) * 8 + i] = ak[i]; part[(rl * 16 + lg) * 8 + 4 + i] = av[i]; }
  }
  __syncthreads();
  if (nq == 0) {
#pragma unroll
    for (int i = 0; i < 4; ++i) { ak[i] += part[(rl * 16 + lg) * 8 + i]; av[i] += part[(rl * 16 + lg) * 8 + 4 + i]; }
  }
  rowop<64>(ak, lg, p.nsa_k_gains + layer * 192, true, false, 0, (const float2*)nullptr);
  if (nq == 0) {
    store4bf((u16*)(PWS + OFF_KCMP) + (size_t)gr * 64 + lg * 4, ak);
#pragma unroll
    for (int i = 0; i < 4; ++i) vb[rl * 65 + lg * 4 + i] = av[i];
  }
  __syncthreads();
  if (tid < 64) {
    int d = tid;
    uint4 o;
    o.x = pack2(vb[0 * 65 + d], vb[1 * 65 + d]);
    o.y = pack2(vb[2 * 65 + d], vb[3 * 65 + d]);
    o.z = pack2(vb[4 * 65 + d], vb[5 * 65 + d]);
    o.w = pack2(vb[6 * 65 + d], vb[7 * 65 + d]);
    int bb = gr0 >> 8, jb = gr0 & 255;
    *(uint4*)((u16*)(PWS + OFF_VCMPT) + ((size_t)(bb * 64 + d)) * 256 + jb) = o;
  }
}

DI float lb_of(const Params& p, int layer, int c) {
  if (layer == 0) return 0.f;
  float p0 = p.lb_param[c], p1 = p.lb_param[256 + c];
  return 1.f / (1.f + __expf(p0 - p1));
}
DI void mm32(f32x16& acc, const float* Ap, int asi, int ask, const float* Bp, int bsk, int bsj, int r, int h) {
#pragma unroll 8
  for (int k = 0; k < 64; k += 2) {
    float a = Ap[r * asi + (k + h) * ask];
    float b = Bp[(k + h) * bsk + r * bsj];
    acc = MFMA_F32(a, b, acc);
  }
}
template <bool SILU_GATE>
DI void finish_rows(const float* ob, const float* gain, const u16* cols, int gate_col, u16* mixed, int mix_col, int tb, int hd) {
  const int tid = otid(), lg = tid & 15;
  for (int it = 0; it < 4; ++it) {
    int t = it * 16 + (tid >> 4);
    float x[4];
#pragma unroll
    for (int i = 0; i < 4; ++i) x[i] = ob[t * 65 + lg * 4 + i];
    rowop<64>(x, lg, gain, true, false, 0, (const float2*)nullptr);
    float g[4]; load4bf(cols + (size_t)(tb + t) * NC + gate_col + hd * 64 + lg * 4, g);
#pragma unroll
    for (int i = 0; i < 4; ++i) x[i] *= SILU_GATE ? siluf_(g[i]) : sigmoidf_(g[i]);
    store4bf(mixed + (size_t)(tb + t) * 1024 + mix_col + hd * 64 + lg * 4, x);
  }
}

DI void conv8(const u16* cols, const float (&cw)[4][8], const float (&cbias)[8], int tok, int pos, int coloff, float (&out)[8]) {
#pragma unroll
  for (int k = 0; k < 8; ++k) out[k] = cbias[k];
#pragma unroll
  for (int j = 0; j < 4; ++j) {
    int dp = j - 3;
    if (pos + dp >= 0) {
      float x[8]; ld8bf(cols + (size_t)(tok + dp) * NC + coloff, x);
#pragma unroll
      for (int k = 0; k < 8; ++k) out[k] = fmaf(cw[j][k], x[k], out[k]);
    }
  }
#pragma unroll
  for (int k = 0; k < 8; ++k) out[k] = siluf_(out[k]);
}
DI void load_convw(const Params& p, int layer, int ch0, float (&cw)[4][8], float (&cbias)[8]) {
  const float* w = p.ml_conv_w + (size_t)layer * 4 * 512 + ch0;
#pragma unroll
  for (int j = 0; j < 4; ++j) {
    float4 a = *(const float4*)(w + j * 512), b2 = *(const float4*)(w + j * 512 + 4);
    cw[j][0] = a.x; cw[j][1] = a.y; cw[j][2] = a.z; cw[j][3] = a.w; cw[j][4] = b2.x; cw[j][5] = b2.y; cw[j][6] = b2.z; cw[j][7] = b2.w;
  }
  const float* bb = p.ml_conv_b + layer * 512 + ch0;
  float4 a = *(const float4*)bb, b2 = *(const float4*)(bb + 4);
  cbias[0] = a.x; cbias[1] = a.y; cbias[2] = a.z; cbias[3] = a.w; cbias[4] = b2.x; cbias[5] = b2.y; cbias[6] = b2.z; cbias[7] = b2.w;
}
DI void load_state(float* dst, const float* src, int tid) {
#pragma unroll
  for (int i = 0; i < 4; ++i) { int e4 = tid + 256 * i; int row = e4 >> 4, c4 = (e4 & 15) * 4; float4 v = *(const float4*)(src + row * 64 + c4);
    dst[row * 65 + c4] = v.x; dst[row * 65 + c4 + 1] = v.y; dst[row * 65 + c4 + 2] = v.z; dst[row * 65 + c4 + 3] = v.w; }
}

DI void job_hg_A(const Params& p, int layer, int cid, char* smem) {
  const int tid = otid(), lane = tid & 63, w = tid >> 6, r = lane & 31, h = lane >> 5;
  const int bh = cid >> 6, c = cid & 63, b = bh >> 2, hd = bh & 3;
  const int tb = b * SEQL + c * 64;
  const u16* cols = (const u16*)(PWS + OFF_COLS);
  float* B0 = (float*)smem; float* B1 = B0 + 64 * 65; float* B2 = B1 + 64 * 65;
  {
    const int seg = tid & 7;
    float lbv[8];
#pragma unroll
    for (int k = 0; k < 8; ++k) lbv[k] = lb_of(p, layer, hd * 64 + seg * 8 + k);
#pragma unroll
    for (int i = 0; i < 2; ++i) {
      int s = (tid >> 3) + 32 * i;
      const u16* row = cols + (size_t)(tb + s) * NC + hd * 64 + seg * 8;
      float f[8], iv[8]; ld8bf(row + C_HGF, f); ld8bf(row + C_HGI, iv);
#pragma unroll
      for (int k = 0; k < 8; ++k) {
        float fg = lbv[k] + (1.f - lbv[k]) * sigmoidf_(f[k]);
        B0[s * 65 + seg * 8 + k] = logf(fg); B1[s * 65 + seg * 8 + k] = 1.f - fg; B2[s * 65 + seg * 8 + k] = iv[k];
      }
    }
  }
  __syncthreads();
  if (tid < 64) { float run = 0.f; for (int s = 0; s < 64; ++s) { run += B0[s * 65 + tid]; B0[s * 65 + tid] = run; } }
  __syncthreads();
  for (int e = tid; e < 4096; e += 256) { int s = e >> 6, kd = e & 63; B1[s * 65 + kd] *= __expf(B0[63 * 65 + kd] - B0[s * 65 + kd]); }
  __syncthreads();
  const int ih = w >> 1, jh = w & 1;
  f32x16 acc = zero16();
  mm32(acc, B1 + ih * 32, 1, 65, B2 + jh * 32, 65, 1, r, h);
  float* st = (float*)(PWS + OFF_HGST) + (size_t)cid * 4096;
#pragma unroll
  for (int reg = 0; reg < 16; ++reg) st[(ih * 32 + crow(reg, h)) * 64 + jh * 32 + r] = acc[reg];
  if (tid < 64) ((float*)(PWS + OFF_HGD))[cid * 64 + tid] = __expf(B0[63 * 65 + tid]);
}

DI void job_hg_scan(const Params& p, int job) {
  const int bh = job >> 4, e = (job & 15) * 256 + otid();
  float* st = (float*)(PWS + OFF_HGST);
  const float* dv = (const float*)(PWS + OFF_HGD);
  float S = 0.f;
  for (int c0 = 0; c0 < 64; c0 += 16) {
    float U[16], D[16];
#pragma unroll
    for (int i = 0; i < 16; ++i) { U[i] = st[(size_t)(bh * 64 + c0 + i) * 4096 + e]; D[i] = dv[(bh * 64 + c0 + i) * 64 + (e >> 6)]; }
#pragma unroll
    for (int i = 0; i < 16; ++i) { st[(size_t)(bh * 64 + c0 + i) * 4096 + e] = S; S = D[i] * S + U[i]; }
  }
}

DI void job_hg_C(const Params& p, int layer, int cid, char* smem) {
  const int tid = otid(), lane = tid & 63, w = tid >> 6, r = lane & 31, h = lane >> 5;
  const int bh = cid >> 6, c = cid & 63, b = bh >> 2, hd = bh & 3;
  const int tb = b * SEQL + c * 64;
  const u16* cols = (const u16*)(PWS + OFF_COLS);
  float* B0 = (float*)smem; float* B1 = B0 + 64 * 65; float* B2 = B1 + 64 * 65; float* B3 = B2 + 64 * 65;
  {
    const int seg = tid & 7;
    float lbv[8];
#pragma unroll
    for (int k = 0; k < 8; ++k) lbv[k] = lb_of(p, layer, hd * 64 + seg * 8 + k);
#pragma unroll
    for (int i = 0; i < 2; ++i) {
      int s = (tid >> 3) + 32 * i;
      const u16* row = cols + (size_t)(tb + s) * NC + hd * 64 + seg * 8;
      float f[8], iv[8], qr[8]; ld8bf(row + C_HGF, f); ld8bf(row + C_HGI, iv); ld8bf(row + C_HGQ, qr);
#pragma unroll
      for (int k = 0; k < 8; ++k) {
        float fg = lbv[k] + (1.f - lbv[k]) * sigmoidf_(f[k]);
        B0[s * 65 + seg * 8 + k] = logf(fg); B2[s * 65 + seg * 8 + k] = 1.f - fg;
        B1[s * 65 + seg * 8 + k] = siluf_(qr[k]) * 0.125f; B3[s * 65 + seg * 8 + k] = iv[k];
      }
    }
  }
  __syncthreads();
  if (tid < 64) { float run = 0.f; for (int s = 0; s < 64; ++s) { run += B0[s * 65 + tid]; B0[s * 65 + tid] = run; } }
  __syncthreads();
  for (int e = tid; e < 4096; e += 256) {
    int s = e >> 6, kd = e & 63;
    float bref = B0[31 * 65 + kd], bc = B0[s * 65 + kd];
    B1[s * 65 + kd] *= __expf(bc - bref);
    B2[s * 65 + kd] *= __expf(bref - bc);
  }
  __syncthreads();
  const int th = w >> 1, sh = w & 1;
  f32x16 at = zero16();
  if (!(th == 0 && sh == 1)) mm32(at, B1 + th * 32 * 65, 65, 1, B2 + sh * 32 * 65, 1, 65, r, h);
  __syncthreads();
  for (int e = tid; e < 4096; e += 256) { int s = e >> 6, kd = e & 63; B2[s * 65 + kd] = B1[s * 65 + kd] * __expf(B0[31 * 65 + kd]); }
  __syncthreads();
#pragma unroll
  for (int reg = 0; reg < 16; ++reg) {
    int t = th * 32 + crow(reg, h), s = sh * 32 + r;
    B1[t * 65 + s] = (s <= t) ? at[reg] : 0.f;
  }
  load_state(B0, (const float*)(PWS + OFF_HGST) + (size_t)cid * 4096, tid);
  __syncthreads();
  const int vh = w & 1;
  f32x16 o = zero16();
  mm32(o, B2 + th * 32 * 65, 65, 1, B0 + vh * 32, 65, 1, r, h);
  mm32(o, B1 + th * 32 * 65, 65, 1, B3 + vh * 32, 65, 1, r, h);
  __syncthreads();
#pragma unroll
  for (int reg = 0; reg < 16; ++reg) B2[(th * 32 + crow(reg, h)) * 65 + vh * 32 + r] = o[reg];
  __syncthreads();
  finish_rows<true>(B2, p.hg_o_gain + layer * 64, cols, C_HGG, (u16*)(PWS + OFF_H), 0, tb, hd);
}

DI float conv_silu(const Params& p, int layer, const u16* cols, int tok, int pos, int ch) {
  const float* cw = p.ml_conv_w + (size_t)layer * 4 * 512;
  float a = p.ml_conv_b[layer * 512 + ch];
#pragma unroll
  for (int j = 0; j < 4; ++j) {
    int dp = j - 3;
    float xv = (pos + dp >= 0) ? bf2f(cols[(size_t)(tok + dp) * NC + C_MQ + ch]) : 0.f;
    a = fmaf(cw[j * 512 + ch], xv, a);
  }
  return siluf_(a);
}
DI float logsigmoidf_(float x) { return fminf(x, 0.f) - log1pf(__expf(-fabsf(x))); }
DI float scan_add(float v, int lane) { for (int o = 1; o < 64; o <<= 1) { float u = __shfl_up(v, o); if (lane >= o) v += u; } return v; }
DI float scan_max(float v, int lane) { for (int o = 1; o < 64; o <<= 1) { float u = __shfl_up(v, o); if (lane >= o) v = fmaxf(v, u); } return v; }

DI void job_ml_A(const Params& p, int layer, int cid, char* smem) {
  const int tid = otid(), lane = tid & 63, w = tid >> 6, r = lane & 31, h = lane >> 5;
  const int bh = cid >> 6, c = cid & 63, b = bh >> 2, hd = bh & 3;
  const int tb = b * SEQL + c * 64;
  const u16* cols = (const u16*)(PWS + OFF_COLS);
  float* B1 = (float*)smem; float* B2 = B1 + 64 * 65; float* wsv = B2 + 64 * 65;
  float* mlsc = (float*)(PWS + OFF_MLSC);
  if (w == 0) {
    const u16* row = cols + (size_t)(tb + lane) * NC;
    float fgv = bf2f(row[C_FG + hd]) + p.ml_f_bias[layer * 4 + hd];
    float igv = bf2f(row[C_IG + hd]) + p.ml_i_bias[layer * 4 + hd];
    float lf = logsigmoidf_(fgv);
    float bc = scan_add(lf, lane);
    float blast = __shfl(bc, 63);
    float lw = blast - bc + igv;
    float Mc = wave_max(lw);
    wsv[lane] = __expf(lw - Mc);
    if (lane == 0) { mlsc[cid] = Mc; mlsc[1024 + cid] = blast; }
  }
  {
    const int seg = tid & 7;
    float cw[4][8], cbias[8];
    load_convw(p, layer, 256 + hd * 64 + seg * 8, cw, cbias);
#pragma unroll
    for (int i = 0; i < 2; ++i) {
      int s = (tid >> 3) + 32 * i;
      float kv[8], vv[8];
      conv8(cols, cw, cbias, tb + s, c * 64 + s, C_MK + hd * 64 + seg * 8, kv);
      ld8bf(cols + (size_t)(tb + s) * NC + C_MV + hd * 64 + seg * 8, vv);
#pragma unroll
      for (int k = 0; k < 8; ++k) { B1[s * 65 + seg * 8 + k] = kv[k] * 0.125f; B2[s * 65 + seg * 8 + k] = vv[k]; }
    }
  }
  __syncthreads();
  for (int e = tid; e < 4096; e += 256) { int s = e >> 6, d = e & 63; B1[s * 65 + d] *= wsv[s]; }
  __syncthreads();
  const int ih = w >> 1, jh = w & 1;
  f32x16 acc = zero16();
  mm32(acc, B1 + ih * 32, 1, 65, B2 + jh * 32, 65, 1, r, h);
  float* st = (float*)(PWS + OFF_MLST) + (size_t)cid * 4096;
#pragma unroll
  for (int reg = 0; reg < 16; ++reg) st[(ih * 32 + crow(reg, h)) * 64 + jh * 32 + r] = acc[reg];
  if (tid < 64) { float sacc = 0.f; for (int s = 0; s < 64; ++s) sacc += B1[s * 65 + tid]; ((float*)(PWS + OFF_MLN))[cid * 64 + tid] = sacc; }
}

DI void job_ml_scan(const Params& p, int job) {
  const int bh = job >> 4, sl = job & 15, tid = otid(), e = sl * 256 + tid;
  float* st = (float*)(PWS + OFF_MLST);
  float* nv = (float*)(PWS + OFF_MLN);
  float* mlsc = (float*)(PWS + OFF_MLSC);
  float S = 0.f, nS = 0.f, m = -1e30f;
  const bool don = (sl == 0 && tid < 64);
  for (int c0 = 0; c0 < 64; c0 += 16) {
    float U[16], Mc[16], Bl[16], Nu[16];
#pragma unroll
    for (int i = 0; i < 16; ++i) {
      int cid = bh * 64 + c0 + i;
      U[i] = st[(size_t)cid * 4096 + e]; Mc[i] = mlsc[cid]; Bl[i] = mlsc[1024 + cid];
      Nu[i] = don ? nv[cid * 64 + tid] : 0.f;
    }
#pragma unroll
    for (int i = 0; i < 16; ++i) {
      int cid = bh * 64 + c0 + i;
      float mnew = fmaxf(Bl[i] + m, Mc[i]);
      float dec = __expf(Bl[i] + m - mnew), us = __expf(Mc[i] - mnew);
      st[(size_t)cid * 4096 + e] = S;
      S = dec * S + us * U[i];
      if (don) { nv[cid * 64 + tid] = nS; nS = dec * nS + us * Nu[i]; }
      if (sl == 0 && tid == 0) mlsc[2048 + cid] = m;
      m = mnew;
    }
  }
}

DI void job_ml_C(const Params& p, int layer, int cid, char* smem) {
  const int tid = otid(), lane = tid & 63, w = tid >> 6, r = lane & 31, h = lane >> 5;
  const int bh = cid >> 6, c = cid & 63, b = bh >> 2, hd = bh & 3;
  const int tb = b * SEQL + c * 64;
  const u16* cols = (const u16*)(PWS + OFF_COLS);
  float* B0 = (float*)smem; float* B1 = B0 + 64 * 65; float* B2 = B1 + 64 * 65; float* B3 = B2 + 64 * 65;
  float* s_bc = B3 + 64 * 65; float* s_as = s_bc + 64; float* s_mt = s_as + 64; float* s_wi = s_mt + 64; float* s_nv = s_wi + 64; float* s_den = s_nv + 64;
  const float* mlsc = (const float*)(PWS + OFF_MLSC);
  if (w == 0) {
    const u16* row = cols + (size_t)(tb + lane) * NC;
    float fgv = bf2f(row[C_FG + hd]) + p.ml_f_bias[layer * 4 + hd];
    float igv = bf2f(row[C_IG + hd]) + p.ml_i_bias[layer * 4 + hd];
    float lf = logsigmoidf_(fgv);
    float bc = scan_add(lf, lane);
    float as = igv - bc;
    float pm = scan_max(as, lane);
    float m = mlsc[2048 + cid];
    float inter = bc + m;
    float mt = fmaxf(inter, bc + pm);
    s_bc[lane] = bc; s_as[lane] = as; s_mt[lane] = mt; s_wi[lane] = __expf(inter - mt);
    s_nv[lane] = ((const float*)(PWS + OFF_MLN))[cid * 64 + lane];
  }
  {
    const int seg = tid & 7;
    {
      float cw[4][8], cbias[8];
      load_convw(p, layer, hd * 64 + seg * 8, cw, cbias);
#pragma unroll
      for (int i = 0; i < 2; ++i) {
        int s = (tid >> 3) + 32 * i;
        float qv[8];
        conv8(cols, cw, cbias, tb + s, c * 64 + s, C_MQ + hd * 64 + seg * 8, qv);
#pragma unroll
        for (int k = 0; k < 8; ++k) B0[s * 65 + seg * 8 + k] = qv[k];
      }
    }
    {
      float cw[4][8], cbias[8];
      load_convw(p, layer, 256 + hd * 64 + seg * 8, cw, cbias);
#pragma unroll
      for (int i = 0; i < 2; ++i) {
        int s = (tid >> 3) + 32 * i;
        float kv[8], vv[8];
        conv8(cols, cw, cbias, tb + s, c * 64 + s, C_MK + hd * 64 + seg * 8, kv);
        ld8bf(cols + (size_t)(tb + s) * NC + C_MV + hd * 64 + seg * 8, vv);
#pragma unroll
        for (int k = 0; k < 8; ++k) { B1[s * 65 + seg * 8 + k] = kv[k] * 0.125f; B2[s * 65 + seg * 8 + k] = vv[k]; }
      }
    }
    load_state(B3, (const float*)(PWS + OFF_MLST) + (size_t)cid * 4096, tid);
  }
  __syncthreads();
  const int th = w >> 1, sh = w & 1;
  f32x16 qk = zero16();
  if (!(th == 0 && sh == 1)) mm32(qk, B0 + th * 32 * 65, 65, 1, B1 + sh * 32 * 65, 1, 65, r, h);
  __syncthreads();
#pragma unroll
  for (int reg = 0; reg < 16; ++reg) {
    int t = th * 32 + crow(reg, h), s = sh * 32 + r;
    float dm = (s <= t) ? __expf(s_bc[t] + s_as[s] - s_mt[t]) : 0.f;
    B1[t * 65 + s] = qk[reg] * dm;
  }
  for (int e = tid; e < 4096; e += 256) { int t = e >> 6, d = e & 63; B0[t * 65 + d] *= s_wi[t]; }
  __syncthreads();
  const int vh = w & 1;
  f32x16 o = zero16();
  mm32(o, B0 + th * 32 * 65, 65, 1, B3 + vh * 32, 65, 1, r, h);
  mm32(o, B1 + th * 32 * 65, 65, 1, B2 + vh * 32, 65, 1, r, h);
  if (tid < 64) {
    float dsum = 0.f;
    for (int d = 0; d < 64; ++d) dsum = fmaf(B0[tid * 65 + d], s_nv[d], dsum);
    float ssum = 0.f;
    for (int s = 0; s < 64; ++s) ssum += B1[tid * 65 + s];
    s_den[tid] = dsum + ssum;
  }
  __syncthreads();
#pragma unroll
  for (int reg = 0; reg < 16; ++reg) {
    int t = th * 32 + crow(reg, h);
    float dn = fmaxf(fabsf(s_den[t]), __expf(-s_mt[t]));
    B3[t * 65 + vh * 32 + r] = o[reg] / dn;
  }
  __syncthreads();
  finish_rows<false>(B3, p.ml_o_gain + layer * 64, cols, C_MOG, (u16*)(PWS + OFF_H), 768, tb, hd);
}


#define XB_TMO      128
#define XB_XCNT(j)  (256  + 64 * (j))
#define XB_XSUB(j)  (1280 + 64 * (j))
#define XB_XGEN(j)  (2304 + 64 * (j))
#define XB_TOP      3328
#define XB_TOPGEN   3392
#define XCD_BAR_WORDS 3456
#define XB_SPIN_CAP (1u << 20)
#define LAS __attribute__((address_space(3)))
DI unsigned xb_ld(unsigned* p) { return __hip_atomic_load(p, __ATOMIC_RELAXED, __HIP_MEMORY_SCOPE_AGENT); }
DI unsigned xb_add(unsigned* p, unsigned v) { return __hip_atomic_fetch_add(p, v, __ATOMIC_RELAXED, __HIP_MEMORY_SCOPE_AGENT); }
DI unsigned xb_xcc_id() { return (unsigned)__builtin_amdgcn_s_getreg((3 << 11) | 20) & 0xFu; }
#define XB_SPIN(cond, bar) do { unsigned _sp = 0; while (cond) { __builtin_amdgcn_s_sleep(1); \
    if ((++_sp & 255u) == 0u) { if (xb_ld(&(bar)[XB_TMO])) break; if (_sp > XB_SPIN_CAP) { atomicAdd(&(bar)[XB_TMO], 1u); break; } } } } while (0)
struct XcdBarrier { unsigned* bar; unsigned x; volatile LAS unsigned* st; };
DI XcdBarrier xcd_barrier_post(unsigned* bar, volatile LAS unsigned* st) {
  XcdBarrier b; b.bar = bar; b.x = xb_xcc_id(); b.st = st;
  if (__builtin_amdgcn_workitem_id_x() == 0) (void)xb_add(&bar[XB_XCNT(b.x)], 1u);
  return b;
}
DI void xcd_barrier_complete(unsigned* bar, unsigned x, unsigned& nloc, unsigned& nx) {
  const unsigned G = gridDim.x * gridDim.y * gridDim.z;
  unsigned sum, cnt, mine, sp = 0u;
  for (;;) {
    sum = 0u; cnt = 0u; mine = 0u;
#pragma unroll
    for (unsigned j = 0; j < 16; ++j) { const unsigned c = xb_ld(&bar[XB_XCNT(j)]); sum += c; cnt += (c > 0u) ? 1u : 0u; mine = (j == x) ? c : mine; }
    if (sum == G) break;
    __builtin_amdgcn_s_sleep(1);
    if ((++sp & 255u) == 0u) { if (xb_ld(&bar[XB_TMO])) break; if (sp > XB_SPIN_CAP) { atomicAdd(&bar[XB_TMO], 1u); break; } }
  }
  nloc = mine > 0u ? mine : 1u; nx = cnt > 0u ? cnt : 1u;
}
DI void xcd_barrier(const XcdBarrier& b) {
  asm volatile("s_waitcnt vmcnt(0)" ::: "memory");
  __syncthreads();
  if (__builtin_amdgcn_workitem_id_x() == 0) {
    unsigned* bar = b.bar;
    __builtin_amdgcn_s_waitcnt(0);
    unsigned nloc = b.st[0], nx = b.st[1];
    if (nloc == 0u) { xcd_barrier_complete(bar, b.x, nloc, nx); b.st[0] = nloc; b.st[1] = nx; }
    const unsigned old = xb_add(&bar[XB_XSUB(b.x)], 1u);
    const unsigned gen = old / nloc;
    if (old + 1u == (gen + 1u) * nloc) {
      __builtin_amdgcn_fence(__ATOMIC_RELEASE, "agent");
      asm volatile("s_waitcnt vmcnt(0)" ::: "memory");
      const unsigned og = xb_add(&bar[XB_TOP], 1u);
      const unsigned tg = og / nx;
      if (og + 1u == (tg + 1u) * nx) xb_add(&bar[XB_TOPGEN], 1u);
      else XB_SPIN(xb_ld(&bar[XB_TOPGEN]) == tg, bar);
      __builtin_amdgcn_fence(__ATOMIC_ACQUIRE, "agent");
      xb_add(&bar[XB_XGEN(b.x)], 1u);
      asm volatile("s_waitcnt vmcnt(0)" ::: "memory");
    } else {
      XB_SPIN(xb_ld(&bar[XB_XGEN(b.x)]) == gen, bar);
      __builtin_amdgcn_fence(__ATOMIC_ACQUIRE, "agent");
      asm volatile("s_waitcnt vmcnt(0)" ::: "memory");
    }
  }
  __syncthreads();
}

DI int next_job(int* ctr, int* s_job) {
  __syncthreads();
  if (otid() == 0) *s_job = atomicAdd(ctr, 1);
  __syncthreads();
  return *s_job;
}

struct ConvDesc { const float* src; int K, Nsrc, Ndst, mode; size_t dst; };

__global__ void __launch_bounds__(256, 2) fwd_megakernel(Params p) {
  p.x = asg(p.x);
  p.mem = asg(p.mem);
  p.lb_param = asg(p.lb_param);
  p.norm_mix = asg(p.norm_mix);
  p.w_in = asg(p.w_in);
  p.w_out = asg(p.w_out);
  p.hg_o_gain = asg(p.hg_o_gain);
  p.dsa_kv_gain = asg(p.dsa_kv_gain);
  p.dsa_w_uk = asg(p.dsa_w_uk);
  p.dsa_w_uv = asg(p.dsa_w_uv);
  p.dsa_q_gain = asg(p.dsa_q_gain);
  p.dsa_k_gain = asg(p.dsa_k_gain);
  p.dsa_idxk_gain = asg(p.dsa_idxk_gain);
  p.nsa_pos_k = asg(p.nsa_pos_k);
  p.nsa_pos_v = asg(p.nsa_pos_v);
  p.nsa_k_w1 = asg(p.nsa_k_w1);
  p.nsa_k_w2 = asg(p.nsa_k_w2);
  p.nsa_v_w1 = asg(p.nsa_v_w1);
  p.nsa_v_w2 = asg(p.nsa_v_w2);
  p.nsa_q_gain = asg(p.nsa_q_gain);
  p.nsa_k_gains = asg(p.nsa_k_gains);
  p.ml_conv_w = asg(p.ml_conv_w);
  p.ml_conv_b = asg(p.ml_conv_b);
  p.ml_i_bias = asg(p.ml_i_bias);
  p.ml_f_bias = asg(p.ml_f_bias);
  p.ml_o_gain = asg(p.ml_o_gain);
  p.norm_xa = asg(p.norm_xa);
  p.norm_mem = asg(p.norm_mem);
  p.xa_wq = asg(p.xa_wq);
  p.xa_wkv = asg(p.xa_wkv);
  p.xa_wo = asg(p.xa_wo);
  p.xa_q_gain = asg(p.xa_q_gain);
  p.xa_k_gain = asg(p.xa_k_gain);
  p.norm_ffn = asg(p.norm_ffn);
  p.ffn_w13 = asg(p.ffn_w13);
  p.ffn_w2 = asg(p.ffn_w2);
  p.out = asg(p.out);
  cg::grid_group grid = cg::this_grid();
  __shared__ __attribute__((aligned(16))) char smem[SMEM_BYTES];
  int* s_job = (int*)(smem + SMEM_BYTES - 16);
  volatile LAS unsigned* xst = (volatile LAS unsigned*)(smem + SMEM_BYTES - 32);
  if (otid() == 0) { xst[0] = 0u; xst[1] = 0u; }
  __syncthreads();
  XcdBarrier xb = xcd_barrier_post((unsigned*)(p.ws + OFF_BAR), xst);
  int* ctr0 = (int*)(PWS + OFF_CTR);
  u16* WB = (u16*)(PWS + OFF_WB);
  u16* cols = (u16*)(PWS + OFF_COLS);
  u16* Hb = (u16*)(PWS + OFF_H);
  const int tid = otid();

  for (int ph2 = 0; ph2 < 2 * NPHASE; ++ph2) {
    const int ph = ph2 >> 1;
    const int layer = ph == 0 ? 0 : (ph - 1) / 14;
    const int kind = ph == 0 ? -1 : (ph - 1) % 14;
    if ((ph2 & 1) && DBG_REP == 99) { xcd_barrier(xb); continue; }
    if ((ph2 & 1) && kind != DBG_REP) continue;
    int* ctr = ctr0 + ((ph2 & 1) ? 32 : 0);
    const int sub = (ph2 & 1) ? DBG_SUB : 15;
    const u16* WL = WB + (size_t)layer * W_LAYER;
    int j;
    if (ph == 0) {
      const int NBIAS = 64, NUKV = 2, NROPE = 192, NMEM = 128, NCONV = 936 * 2, NX = 1024;
      const int total = NBIAS + NUKV + NROPE + NMEM + NCONV + NX;
      while ((j = next_job(&ctr[ph], s_job)) < total) {
        if (j < NBIAS) {
          int l = j >> 5, kv = (j >> 4) & 1, ng = j & 15;
          const float* pe = (kv ? p.nsa_pos_v : p.nsa_pos_k) + (size_t)l * 2048;
          const float* w1 = (kv ? p.nsa_v_w1 : p.nsa_k_w1) + (size_t)l * 2048 * 256;
          int nl = tid & 15, kp = tid >> 4;
          float a = 0.f;
#pragma unroll 8
          for (int k = kp * 128; k < kp * 128 + 128; ++k) a = fmaf(pe[k], w1[(size_t)k * 256 + ng * 16 + nl], a);
          float* red = (float*)smem;
          red[kp * 16 + nl] = a;
          __syncthreads();
          if (tid < 16) {
            float t = 0.f;
            for (int q = 0; q < 16; ++q) t += red[q * 16 + tid];
            ((float*)(PWS + OFF_BIAS1))[(l * 2 + kv) * 256 + ng * 16 + tid] = t;
          }
        } else if ((j -= NBIAS) < NUKV) {
          u16* wt = (u16*)(PWS + OFF_WUKV) + (size_t)j * 128 * 128;
          const float* uk = p.dsa_w_uk + (size_t)j * 128 * 64;
          const float* uv = p.dsa_w_uv + (size_t)j * 128 * 64;
          for (int e = tid; e < 128 * 128; e += 256) { int n = e >> 7, k = e & 127; wt[e] = f2bf(n < 64 ? uk[k * 64 + n] : uv[k * 64 + (n - 64)]); }
        } else if ((j -= NUKV) < NROPE) {
          int e = j * 256 + tid;
          int pos = e / 12, f = e % 12;
          float inv = f < 8 ? exp2f(-(float)f * (18.931568569324174f / 8.f)) : exp2f(-(float)(f - 8) * (18.931568569324174f / 4.f));
          float angf = (float)pos * inv;
          double ang = (double)angf;
          double k = rint(ang * 0.15915494309189535);
          float rr = (float)(ang - k * 6.283185307179586);
          float2 cs = make_float2(cosf(rr), sinf(rr));
          if (f < 8) ((float2*)(PWS + OFF_ROPE64))[pos * 8 + f] = cs; else ((float2*)(PWS + OFF_ROPE32))[pos * 4 + (f - 8)] = cs;
        } else if ((j -= NROPE) < NMEM) {
          int l = j >> 6, row0 = (j & 63) * 16;
          job_rmsnorm(p.mem, p.norm_mem + l * 1024, (u16*)(PWS + OFF_MEMH) + (size_t)l * 1024 * 1024, nullptr, row0);
        } else if ((j -= NMEM) < NCONV) {
          int l = j / 936, q = j % 936;
          const float* src; int K, Nsrc, mode, ntn; size_t dst;
          if (q < 216) { src = p.w_in + (size_t)l * 1024 * IN_COLS; K = 1024; Nsrc = IN_COLS; mode = 1; dst = WO_IN; ntn = 54; }
          else if ((q -= 216) < 64) { src = p.w_out + (size_t)l * 1024 * 1024; K = 1024; Nsrc = 1024; mode = 0; dst = WO_OUT; ntn = 16; }
          else if ((q -= 64) < 16) { src = p.xa_wq + (size_t)l * 1024 * 256; K = 1024; Nsrc = 256; mode = 0; dst = WO_Q; ntn = 4; }
          else if ((q -= 16) < 32) { src = p.xa_wkv + (size_t)l * 1024 * 512; K = 1024; Nsrc = 512; mode = 0; dst = WO_KV; ntn = 8; }
          else if ((q -= 32) < 16) { src = p.xa_wo + (size_t)l * 256 * 1024; K = 256; Nsrc = 1024; mode = 0; dst = WO_O; ntn = 16; }
          else if ((q -= 16) < 352) { src = p.ffn_w13 + (size_t)l * 1024 * 5632; K = 1024; Nsrc = 5632; mode = 2; dst = WO_13; ntn = 88; }
          else if ((q -= 352) < 176) { src = p.ffn_w2 + (size_t)l * 2816 * 1024; K = 2816; Nsrc = 1024; mode = 0; dst = WO_2; ntn = 16; }
          else if ((q -= 176) < 32) { src = p.nsa_k_w1 + (size_t)l * 2048 * 256; K = 2048; Nsrc = 256; mode = 0; dst = WO_KW1; ntn = 4; }
          else { q -= 32; src = p.nsa_v_w1 + (size_t)l * 2048 * 256; K = 2048; Nsrc = 256; mode = 0; dst = WO_VW1; ntn = 4; }
          job_convert(src, K, Nsrc, WB + (size_t)l * W_LAYER + dst, mode, q % ntn, q / ntn, (float*)smem);
        } else {
          j -= NCONV;
          job_rmsnorm(p.x, p.norm_mix, Hb, p.out, j * 16);
        }
      }
    } else if (kind == 0) {
      const int NG = 128 * 27, NM = layer == 0 ? 2 * 8 * 4 : 0;
      while ((j = next_job(&ctr[ph], s_job)) < NG + NM) {
        if (j < NG) gemm_tile<0, 0>(Hb, 1024, WL + WO_IN, 1024, j / 27, j % 27, smem, cols, NC, nullptr, 0);
        else { int q = j - NG; int l = q >> 5, tm = (q >> 2) & 7, tn = q & 3;
          gemm_tile<0, 0>((const u16*)(PWS + OFF_MEMH) + (size_t)l * 1024 * 1024, 1024, WB + (size_t)l * W_LAYER + WO_KV, 1024, tm, tn, smem,
                          (u16*)(PWS + OFF_MEMKV) + (size_t)l * 1024 * 512, 512, nullptr, 0); }
      }
    } else if (kind == 1) {
      const int NP = 512, NM = layer == 0 ? 64 : 0;
      while ((j = next_job(&ctr[ph], s_job)) < NP + NM) {
        if (j < NP) job_prep(p, layer, j, smem); else job_memkv_post(p, j - NP, smem);
      }
    } else if (kind == 2) {
      const int ND = 512, NCG = 32, NML = 1024, NHG = 1024;
      while ((j = next_job(&ctr[ph], s_job)) < ND + NCG + NML + NHG) {
        if (j < ND) { if (sub & 1) job_dsa(p, layer, j & 3, 127 - (j >> 2), smem, 0); }
        else if ((j -= ND) < NCG) { if (sub & 2) {
          int kv = j >> 4, tm = (j >> 1) & 7, tn = j & 1;
          gemm_tile<3, 1>(cols, 0, WL + (kv ? WO_VW1 : WO_KW1), 2048, tm, tn, smem, (u16*)(PWS + OFF_HID) + kv * 256, 512,
                          (const float*)(PWS + OFF_BIAS1) + (layer * 2 + kv) * 256, kv ? C_VC : C_KC); }
        } else if ((j -= NCG) < NML) { if (sub & 4) job_ml_A(p, layer, j, smem); }
        else { if (sub & 8) job_hg_A(p, layer, j - NML, smem); }
      }
    } else if (kind == 3) {
      const int NS = 256, NC2 = 128;
      while ((j = next_job(&ctr[ph], s_job)) < 512 + 2 * NS + NC2) {
        if (j < 512) job_dsa(p, layer, j & 3, 127 - (j >> 2), smem, 1);
        else if ((j -= 512) < NS) job_ml_scan(p, j); else if (j < 2 * NS) job_hg_scan(p, j - NS); else job_cmp2(p, layer, j - 2 * NS, smem);
      }
    } else if (kind == 4) {
      const int NN = 512, NML = 1024, NHG = 1024;
      while ((j = next_job(&ctr[ph], s_job)) < 512 + NN + NML + NHG) {
        if (j < 512) { job_dsa(p, layer, j & 3, 127 - (j >> 2), smem, 2); continue; }
        j -= 512;
        if (j < NN) { if (sub & 1) job_nsa(p, layer, j & 3, 127 - (j >> 2), smem); }
        else if ((j -= NN) < NML) { if (sub & 2) job_ml_C(p, layer, j, smem); }
        else { if (sub & 4) job_hg_C(p, layer, j - NML, smem); }
      }
    } else if (kind == 5) {
      if (!(DBG_SKIP & 1)) while ((j = next_job(&ctr[ph], s_job)) < 128 * 8) gemm_tile<1, 0>(Hb, 1024, WL + WO_OUT, 1024, j >> 3, j & 7, smem, p.out, 1024, nullptr, 0, DBG_MK0, DBG_MK1);
    } else if (kind == 6 || kind == 10 || kind == 13) {
      if (kind == 13 && layer == 1) {   }
      else {
        const float* g = kind == 6 ? p.norm_xa + layer * 1024 : (kind == 10 ? p.norm_ffn + layer * 1024 : p.norm_mix + (layer + 1) * 1024);
        while ((j = next_job(&ctr[ph], s_job)) < 1024) job_rmsnorm(p.out, g, Hb, nullptr, j * 16);
      }
    } else if (kind == 7) {
      while ((j = next_job(&ctr[ph], s_job)) < 128 * 2) gemm_tile<0, 0>(Hb, 1024, WL + WO_Q, 1024, j >> 1, j & 1, smem, (u16*)(PWS + OFF_XQ), 256, nullptr, 0);
    } else if (kind == 8) {
      while ((j = next_job(&ctr[ph], s_job)) < 512) job_xattn(p, layer, j >> 7, (j >> 5) & 3, j & 31, smem);
    } else if (kind == 9) {
      if (!(DBG_SKIP & 2)) while ((j = next_job(&ctr[ph], s_job)) < 128 * 8) gemm_tile<1, 0>((const u16*)(PWS + OFF_XO), 256, WL + WO_O, 256, j >> 3, j & 7, smem, p.out, 1024, nullptr, 0);
    } else if (kind == 11) {
      while ((j = next_job(&ctr[ph], s_job)) < 128 * 44) gemm_tile<2, 0>(Hb, 1024, WL + WO_13, 1024, j / 44, j % 44, smem, (u16*)(PWS + OFF_G), DFF, nullptr, 0);
    } else if (kind == 12) {
      if (!(DBG_SKIP & 4)) while ((j = next_job(&ctr[ph], s_job)) < 128 * 8) gemm_tile<1, 0>((const u16*)(PWS + OFF_G), DFF, WL + WO_2, DFF, j >> 3, j & 7, smem, p.out, 1024, nullptr, 0);
    }
    if (ph2 + 1 < 2 * NPHASE) { if (p.use_cg) grid.sync(); else xcd_barrier(xb); }
  }
}

extern "C" void kernel_launch(void* const* d_in, const int* in_sizes, int n_in, void* d_out, int out_size, void* d_ws, size_t ws_size,
                              hipStream_t stream) {
  static int grid_blocks = 0;
  if (!grid_blocks) {
    int dev = 0, cus = 0, per_cu = 0;
    hipGetDevice(&dev);
    hipDeviceGetAttribute(&cus, hipDeviceAttributeMultiprocessorCount, dev);
    hipOccupancyMaxActiveBlocksPerMultiprocessor(&per_cu, fwd_megakernel, 256, 0);
    if (per_cu > 2) per_cu = 2;
    if (per_cu < 1) per_cu = 1;
    grid_blocks = cus * per_cu;
  }
  Params p{};
  const float** pp = (const float**)&p;
  for (int i = 0; i < 36; ++i) pp[i] = (const float*)d_in[i];
  p.out = (float*)d_out;
  p.ws = (char*)d_ws;
  p.use_cg = 0; p.pad_ = 0;
  hipMemsetAsync(d_ws, 0, 4096 + 16384, stream);
  void* args[] = {&p};
  hipError_t e = hipLaunchCooperativeKernel((void*)fwd_megakernel, dim3(grid_blocks), dim3(256), args, 0, stream);
  if (e != hipSuccess) fprintf(stderr, "cooperative launch failed: %s (grid %d)\n", hipGetErrorString(e), grid_blocks);
}
```
